# Optimizing an MI355X kernel written in HIP

```python
import jax, jax.numpy as jnp
from jax import lax
import numpy as np

D_MODEL = 4096
BATCH = 1
SEQ = 8192
DEPTH = 2

N_MIXERS = 2
HEAD_DIM = 128
N_GROUP_HEADS = D_MODEL // 256
GROUP_WIDTH = N_GROUP_HEADS * HEAD_DIM
DILATED_GROUPS = ((128, 1), (512, 4), (2048, 16))
BLOCK = 128
CONV_WIDTH = 3 * D_MODEL // 4
SHORT_CONV = 3
MEM_TOKENS = 256
MEM_HEADS = 4
MEM_HEAD_DIM = D_MODEL // 16
MEM_WIDTH = MEM_HEADS * MEM_HEAD_DIM
D_FF = 11008
ROPE_THETA = 10000.0
EPS = 1e-6
NEG_INF = -1e30

kernel_name = "hybrid_shortconv_dilated_swa_memxattn_convffn"


def rmsnorm(x, g):
    xf = x.astype(jnp.float32)
    y = xf * lax.rsqrt(jnp.mean(xf * xf, axis=-1, keepdims=True) + EPS)
    return (y * g.astype(jnp.float32)).astype(x.dtype)


def causal_dwconv3(u, w):
    up = jnp.pad(u, ((0, 0), (SHORT_CONV - 1, 0), (0, 0)))
    return w[0] * up[:, :-2] + w[1] * up[:, 1:-1] + w[2] * up[:, 2:]


def rope_tables(positions):
    half = HEAD_DIM // 2
    inv_freq = ROPE_THETA ** (-jnp.arange(half, dtype=jnp.float32) * 2.0 / HEAD_DIM)
    ang = positions.astype(jnp.float32)[..., None] * inv_freq
    return jnp.cos(ang)[:, :, None, None, :], jnp.sin(ang)[:, :, None, None, :]


def apply_rope(t, cos, sin):
    tf = t.astype(jnp.float32)
    t1, t2 = jnp.split(tf, 2, axis=-1)
    return jnp.concatenate([t1 * cos - t2 * sin, t2 * cos + t1 * sin], axis=-1).astype(t.dtype)


def memory_attend(q, mem_k, mem_v):
    B, S, _ = q.shape
    qh = q.reshape(B, S, MEM_HEADS, MEM_HEAD_DIM)
    s = jnp.einsum("bshe,bmhe->bhsm", qh, mem_k, preferred_element_type=jnp.float32) * (MEM_HEAD_DIM ** -0.5)
    p = jax.nn.softmax(s, axis=-1).astype(mem_v.dtype)
    o = jnp.einsum("bhsm,bmhe->bshe", p, mem_v)
    return o.reshape(B, S, MEM_WIDTH)


def dilated_window_attention(q, k, v, dilation, steps):
    B, S, H, Dh = q.shape
    L = S // dilation
    nb = -(-L // BLOCK)
    Lp = nb * BLOCK

    def blocks(t):
        t = t.reshape(B, L, dilation, H, Dh)
        t = jnp.pad(t, ((0, 0), (0, Lp - L), (0, 0), (0, 0), (0, 0)))
        return t.reshape(B, nb, BLOCK, dilation, H, Dh)

    def with_prev(t):
        prev = jnp.pad(t, ((0, 0), (1, 0), (0, 0), (0, 0), (0, 0), (0, 0)))[:, :-1]
        return jnp.concatenate([prev, t], axis=2)

    qb = blocks(q)
    kw = with_prev(blocks(k))
    vw = with_prev(blocks(v))
    s = jnp.einsum("bnqrhe,bnkrhe->bnrhqk", qb, kw, preferred_element_type=jnp.float32) * (Dh ** -0.5)
    qi = jnp.arange(BLOCK)[:, None]
    ki = jnp.arange(2 * BLOCK)[None, :]
    back = BLOCK + qi - ki
    blk = jnp.arange(nb)[:, None, None]
    valid = (back >= 0) & (back <= steps) & ((blk > 0) | (ki >= BLOCK))
    s = jnp.where(valid[None, :, None, None], s, NEG_INF)
    m = jnp.max(s, axis=-1, keepdims=True)
    p = jnp.exp(s - m)
    den = jnp.sum(p, axis=-1, keepdims=True)
    o = jnp.einsum("bnrhqk,bnkrhe->bnqrhe", (p / den).astype(v.dtype), vw)
    lse = (m + jnp.log(den))[..., 0]
    o = o.reshape(B, Lp, dilation, H, Dh)[:, :L].reshape(B, S, H, Dh)
    lse = lse.transpose(0, 1, 4, 2, 3).reshape(B, Lp, dilation, H)[:, :L].reshape(B, S, H)
    return o, lse


def short_conv_mixer(xn, w_in, conv_w, w_out, mem_k, mem_v):
    h = xn @ w_in
    b_gate = h[..., :CONV_WIDTH]
    c_gate = h[..., CONV_WIDTH:2 * CONV_WIDTH]
    u = h[..., 2 * CONV_WIDTH:3 * CONV_WIDTH]
    q_mem = h[..., 3 * CONV_WIDTH:]
    y = b_gate * causal_dwconv3(c_gate * u, conv_w)
    y_mem = memory_attend(q_mem, mem_k, mem_v)
    return jnp.concatenate([y, y_mem], axis=-1) @ w_out


def dilated_attention_mixer(xn, w_in, w_out, cos, sin, mem_k, mem_v):
    B, S, _ = xn.shape
    n_self = len(DILATED_GROUPS) * 3 * GROUP_WIDTH
    h = xn @ w_in
    qkv = h[..., :n_self].reshape(B, S, len(DILATED_GROUPS), 3, N_GROUP_HEADS, HEAD_DIM)
    q = apply_rope(qkv[:, :, :, 0], cos, sin)
    k = apply_rope(qkv[:, :, :, 1], cos, sin)
    v = qkv[:, :, :, 2]
    outs, lses = [], []
    for g, (window, dilation) in enumerate(DILATED_GROUPS):
        o, lse = dilated_window_attention(q[:, :, g], k[:, :, g], v[:, :, g], dilation, window // dilation)
        outs.append(o)
        lses.append(lse)
    alpha = jax.nn.softmax(jnp.stack(lses, axis=0), axis=0)
    merged = jnp.sum(alpha[..., None] * jnp.stack(outs, axis=0).astype(jnp.float32), axis=0)
    merged = merged.astype(xn.dtype).reshape(B, S, GROUP_WIDTH)
    y_mem = memory_attend(h[..., n_self:], mem_k, mem_v)
    return jnp.concatenate([merged, y_mem], axis=-1) @ w_out


def conv_ffn(xn, w_gate, w_up, conv_w, w_down):
    g = causal_dwconv3(xn @ w_gate, conv_w)
    return (jax.nn.silu(g) * (xn @ w_up)) @ w_down


def setup_inputs(seed: int = 0) -> dict:
    key = jax.random.key(seed)
    ks = jax.random.split(key, 20)
    f32 = jnp.float32
    n_a = (DEPTH + 1) // 2
    n_b = DEPTH // 2

    def w(k, shape, fan_in):
        return jax.random.normal(k, shape, f32) * (fan_in ** -0.5)

    def gain(k, shape):
        return 1.0 + 0.02 * jax.random.normal(k, shape, f32)

    x = jax.random.normal(ks[0], (BATCH, SEQ, D_MODEL), f32)
    mem = jax.random.normal(ks[1], (BATCH, MEM_TOKENS, D_MODEL), f32)
    offset = jax.random.randint(ks[2], (BATCH, 1), 0, 4096, dtype=jnp.int32)
    positions = offset + jnp.arange(SEQ, dtype=jnp.int32)[None, :]
    n_attn_in = len(DILATED_GROUPS) * 3 * GROUP_WIDTH + MEM_WIDTH
    return {
        "x": x,
        "mem": mem,
        "positions": positions,
        "g_mem": gain(ks[3], (D_MODEL,)),
        "w_mem_kv": w(ks[4], (D_MODEL, 2 * MEM_WIDTH), D_MODEL),
        "g_mix_pre": gain(ks[5], (DEPTH, D_MODEL)),
        "g_mix_post": gain(ks[6], (DEPTH, D_MODEL)),
        "g_ffn_pre": gain(ks[7], (DEPTH, D_MODEL)),
        "g_ffn_post": gain(ks[8], (DEPTH, D_MODEL)),
        "w_conv_in": w(ks[9], (n_a, D_MODEL, 3 * CONV_WIDTH + MEM_WIDTH), D_MODEL),
        "conv_mix_w": w(ks[10], (n_a, SHORT_CONV, CONV_WIDTH), SHORT_CONV),
        "w_conv_out": w(ks[11], (n_a, CONV_WIDTH + MEM_WIDTH, D_MODEL), CONV_WIDTH + MEM_WIDTH),
        "w_attn_in": w(ks[12], (n_b, D_MODEL, n_attn_in), D_MODEL),
        "w_attn_out": w(ks[13], (n_b, GROUP_WIDTH + MEM_WIDTH, D_MODEL), GROUP_WIDTH + MEM_WIDTH),
        "w_ffn_gate": w(ks[14], (DEPTH, D_MODEL, D_FF), D_MODEL),
        "w_ffn_up": w(ks[15], (DEPTH, D_MODEL, D_FF), D_MODEL),
        "conv_ffn_w": w(ks[16], (DEPTH, SHORT_CONV, D_FF), SHORT_CONV),
        "w_ffn_down": w(ks[17], (DEPTH, D_FF, D_MODEL), D_FF),
    }


def reference(x, mem, positions, g_mem, w_mem_kv, g_mix_pre, g_mix_post, g_ffn_pre, g_ffn_post,
              w_conv_in, conv_mix_w, w_conv_out, w_attn_in, w_attn_out,
              w_ffn_gate, w_ffn_up, conv_ffn_w, w_ffn_down):
    B = x.shape[0]
    kv = (rmsnorm(mem, g_mem) @ w_mem_kv).reshape(B, mem.shape[1], 2, MEM_HEADS, MEM_HEAD_DIM)
    mem_k, mem_v = kv[:, :, 0], kv[:, :, 1]
    cos, sin = rope_tables(positions)
    for i in range(DEPTH):
        j = i // N_MIXERS
        xn = rmsnorm(x, g_mix_pre[i])
        if i % N_MIXERS == 0:
            y = short_conv_mixer(xn, w_conv_in[j], conv_mix_w[j], w_conv_out[j], mem_k, mem_v)
        else:
            y = dilated_attention_mixer(xn, w_attn_in[j], w_attn_out[j], cos, sin, mem_k, mem_v)
        x = x + rmsnorm(y, g_mix_post[i])
        xn = rmsnorm(x, g_ffn_pre[i])
        y = conv_ffn(xn, w_ffn_gate[i], w_ffn_up[i], conv_ffn_w[i], w_ffn_down[i])
        x = x + rmsnorm(y, g_ffn_post[i])
    return x
```

```cpp
#include <hip/hip_runtime.h>
#include <cstdio>
#include <cstdint>

#define LAS __attribute__((address_space(3)))
#define GAS __attribute__((address_space(1)))
typedef unsigned short bf16_t;
typedef short bf16x8 __attribute__((ext_vector_type(8)));
typedef short s16x4 __attribute__((ext_vector_type(4)));
typedef float f32x4 __attribute__((ext_vector_type(4)));
typedef unsigned u32x4 __attribute__((ext_vector_type(4)));
typedef unsigned u32x2 __attribute__((ext_vector_type(2)));

constexpr int SEQ = 8192, DM = 4096, DFF = 11008, CW = 3072, MW = 1024, GW = 2048, NMEM = 256, NHEAD = 16, HDIM = 128;
constexpr int N_CI = 3 * CW + MW;
constexpr int N_AI = 9 * GW + MW;
constexpr int N_GU = 2 * DFF;
constexpr int K_CO = CW + MW;
constexpr int K_AO = GW + MW;
constexpr float EPS = 1e-6f;

#ifndef ONE_LAUNCH
#define ONE_LAUNCH 1
#endif
constexpr int NPHASE = 19;

constexpr size_t MiB = 1u << 20;
constexpr size_t WS_CTL = 0, CTL_ZERO_BYTES = 1 * MiB;
constexpr size_t WS_WKV = 1 * MiB;
constexpr size_t WS_WCI = WS_WKV + 16 * MiB;
constexpr size_t WS_WCO = WS_WCI + 80 * MiB;
constexpr size_t WS_WAI = WS_WCO + 32 * MiB;
constexpr size_t WS_WAO = WS_WAI + 152 * MiB;
constexpr size_t WS_WGU = WS_WAO + 24 * MiB;
constexpr size_t WS_WD  = WS_WGU + 2 * 172 * MiB;
constexpr size_t WS_XN  = WS_WD + 2 * 86 * MiB;
constexpr size_t WS_R   = WS_XN + 64 * MiB;
constexpr size_t WS_S   = WS_R + 344 * MiB;
constexpr size_t WS_MEMN = WS_S + 172 * MiB;
constexpr size_t WS_KV  = WS_MEMN + 2 * MiB;
constexpr size_t WS_COS = WS_KV + 1 * MiB;
constexpr size_t WS_SIN = WS_COS + 2 * MiB;
constexpr size_t WS_LSE = WS_SIN + 2 * MiB;
constexpr size_t WS_END = WS_LSE + 2 * MiB;
constexpr int CW_BAR = 4096;

constexpr int RING_BYTES = 131072;
constexpr int LDSCTL_OFF = 146432;
constexpr int LDS_BYTES = 147456;

__device__ __forceinline__ unsigned cvt_pk_bf16(float lo, float hi) { unsigned r; asm("v_cvt_pk_bf16_f32 %0, %1, %2" : "=v"(r) : "v"(lo), "v"(hi)); return r; }
__device__ __forceinline__ float bf_lo(unsigned w) { return __uint_as_float(w << 16); }
__device__ __forceinline__ float bf_hi(unsigned w) { return __uint_as_float(w & 0xffff0000u); }
__device__ __forceinline__ int fresh_lane() { int l; asm volatile("v_mbcnt_lo_u32_b32 %0, -1, 0\n\tv_mbcnt_hi_u32_b32 %0, -1, %0" : "=v"(l)); return l; }
__device__ __forceinline__ float wave_sum(float v) {
#pragma unroll
    for (int o = 1; o < 64; o <<= 1) v += __shfl_xor(v, o);
    return v;
}

__constant__ float INV_FREQ[64] = {
1.000000000e+00f, 8.659643531e-01f, 7.498942018e-01f, 6.493816376e-01f, 5.623413324e-01f, 4.869675338e-01f, 4.216965139e-01f, 3.651741147e-01f, 3.162277639e-01f, 2.738419771e-01f, 2.371373773e-01f, 2.053525001e-01f, 1.778279394e-01f, 1.539926529e-01f, 1.333521456e-01f, 1.154781953e-01f,
1.000000015e-01f, 8.659642935e-02f, 7.498942316e-02f, 6.493816525e-02f, 5.623413250e-02f, 4.869675264e-02f, 4.216964915e-02f, 3.651741147e-02f, 3.162277490e-02f, 2.738419548e-02f, 2.371373773e-02f, 2.053525113e-02f, 1.778279431e-02f, 1.539926510e-02f, 1.333521400e-02f, 1.154781971e-02f,
9.999999776e-03f, 8.659643121e-03f, 7.498942316e-03f, 6.493816152e-03f, 5.623413250e-03f, 4.869675264e-03f, 4.216964822e-03f, 3.651741194e-03f, 3.162277630e-03f, 2.738419687e-03f, 2.371373819e-03f, 2.053525066e-03f, 1.778279431e-03f, 1.539926510e-03f, 1.333521446e-03f, 1.154782018e-03f,
1.000000047e-03f, 8.659643354e-04f, 7.498941850e-04f, 6.493816036e-04f, 5.623413017e-04f, 4.869675322e-04f, 4.216965172e-04f, 3.651741135e-04f, 3.162277571e-04f, 2.738419571e-04f, 2.371373703e-04f, 2.053525095e-04f, 1.778279402e-04f, 1.539926598e-04f, 1.333521504e-04f, 1.154782003e-04f };

namespace pg8 {
constexpr int BM = 256, BK = 64, HALF = 128, HTB = HALF * BK * 2, STAGE_BYTES = 8 * HTB, NXCD = 8, WGM = 8;
__host__ __device__ __forceinline__ int lds_byte(int r, int c) { const int st = (r >> 4) * 2 + (c >> 5), rr = r & 15, cc = c & 31, ob = rr * 64 + cc * 2; return st * 1024 + (ob ^ (((ob >> 9) & 1) << 5)); }
__host__ __device__ __forceinline__ void stage_rc(int b, int& R, int& C) { const int st = b / 1024, sb = b % 1024, swz = sb ^ (((sb >> 9) & 1) << 5); R = (st >> 1) * 16 + swz / 64; C = (st & 1) * 32 + (swz % 64) / 2; }
__host__ __device__ __forceinline__ int perm32(int rho) { const int n = rho >> 4, i = rho & 15; return 8 * (i >> 2) + 4 * n + (i & 3); }

struct Unit { int pm, pn; };
struct Gemm { const bf16_t* A; const bf16_t* Bt; int K, lda, ldb; };

struct StaticOrder {
    int nM, nN, nwg, G, c;
    __host__ __device__ void init(int M, int N, int G_, int c_) { nM = M / BM; nN = N / BM; nwg = nM * nN; G = G_; c = c_; }
    __host__ __device__ bool next(int i, Unit& u) const {
        const long L = (long)i * G + c; if (L >= nwg) return false;
        int wgid = (int)L; { const int q = nwg / NXCD, r = nwg % NXCD, xcd = wgid % NXCD, off = wgid / NXCD; wgid = (xcd < r ? xcd * (q + 1) : r * (q + 1) + (xcd - r) * q) + off; }
        const int nig = WGM * nN, gid = wgid / nig, fm = gid * WGM, gsz = (nM - fm) < WGM ? (nM - fm) : WGM;
        u.pm = fm + ((wgid % nig) % gsz); u.pn = (wgid % nig) / gsz; return true;
    }
    __device__ __forceinline__ void a_ready(const Unit&) const {}
    __device__ __forceinline__ void done(const Unit&) const {}
};

struct EpiStore {
    static constexpr bool PERM = true, AFTER_DRAIN = false;
    bf16_t* O; int ldc;
    __device__ __forceinline__ void operator()(const f32x4 (&acc)[2][2][4][2], const Unit& u, int wr, int wc, int fr, int fq) const {
        const int row0 = u.pm * BM + wr * 64 + fr, col0 = u.pn * BM + wc * 32 + 8 * fq;
#pragma unroll
        for (int ai = 0; ai < 2; ++ai)
#pragma unroll
            for (int m = 0; m < 4; ++m) { bf16_t* rowp = O + (size_t)(row0 + ai * HALF + m * 16) * ldc + col0;
#pragma unroll
                for (int bj = 0; bj < 2; ++bj) { const f32x4 v0 = acc[ai][bj][m][0], v1 = acc[ai][bj][m][1];
                    u32x4 w; w.x = cvt_pk_bf16(v0[0], v0[1]); w.y = cvt_pk_bf16(v0[2], v0[3]); w.z = cvt_pk_bf16(v1[0], v1[1]); w.w = cvt_pk_bf16(v1[2], v1[3]);
                    *(u32x4*)(rowp + bj * HALF) = w; } }
    }
};
struct EpiRope {
    static constexpr bool PERM = true, AFTER_DRAIN = false;
    bf16_t* O; int ldc; const float* cosT; const float* sinT;
    __device__ __forceinline__ void operator()(const f32x4 (&acc)[2][2][4][2], const Unit& u, int wr, int wc, int fr, int fq) const {
        const int colt = u.pn * BM;
        const bool isqk = (colt < 9 * GW) && ((colt % (3 * GW)) < 2 * GW);
        const int row0 = u.pm * BM + wr * 64 + fr;
        if (!isqk) {
            const int col0 = colt + wc * 32 + 8 * fq;
#pragma unroll
            for (int ai = 0; ai < 2; ++ai)
#pragma unroll
                for (int m = 0; m < 4; ++m) { bf16_t* rowp = O + (size_t)(row0 + ai * HALF + m * 16) * ldc + col0;
#pragma unroll
                    for (int bj = 0; bj < 2; ++bj) { const f32x4 v0 = acc[ai][bj][m][0], v1 = acc[ai][bj][m][1];
                        u32x4 w; w.x = cvt_pk_bf16(v0[0], v0[1]); w.y = cvt_pk_bf16(v0[2], v0[3]); w.z = cvt_pk_bf16(v1[0], v1[1]); w.w = cvt_pk_bf16(v1[2], v1[3]);
                        *(u32x4*)(rowp + bj * HALF) = w; } }
        } else {
            const int x0 = wc * 32 + 8 * fq, hh = x0 >> 6, d0 = x0 & 63;
#pragma unroll
            for (int ai = 0; ai < 2; ++ai)
#pragma unroll
                for (int m = 0; m < 4; ++m) { const int row = row0 + ai * HALF + m * 16;
                    const f32x4 c0 = *(const f32x4*)(cosT + (size_t)row * 64 + d0), c1 = *(const f32x4*)(cosT + (size_t)row * 64 + d0 + 4);
                    const f32x4 s0 = *(const f32x4*)(sinT + (size_t)row * 64 + d0), s1 = *(const f32x4*)(sinT + (size_t)row * 64 + d0 + 4);
                    const f32x4 a0 = acc[ai][0][m][0], a1 = acc[ai][0][m][1], b0 = acc[ai][1][m][0], b1 = acc[ai][1][m][1];
                    const f32x4 o10 = a0 * c0 - b0 * s0, o11 = a1 * c1 - b1 * s1, o20 = b0 * c0 + a0 * s0, o21 = b1 * c1 + a1 * s1;
                    bf16_t* rowp = O + (size_t)row * ldc + colt + 128 * hh + d0;
                    u32x4 w; w.x = cvt_pk_bf16(o10[0], o10[1]); w.y = cvt_pk_bf16(o10[2], o10[3]); w.z = cvt_pk_bf16(o11[0], o11[1]); w.w = cvt_pk_bf16(o11[2], o11[3]);
                    *(u32x4*)(rowp) = w;
                    w.x = cvt_pk_bf16(o20[0], o20[1]); w.y = cvt_pk_bf16(o20[2], o20[3]); w.z = cvt_pk_bf16(o21[0], o21[1]); w.w = cvt_pk_bf16(o21[2], o21[3]);
                    *(u32x4*)(rowp + 64) = w;
                    asm volatile("" ::: "memory"); }
        }
    }
};

template <class Epi, class Sched, bool ALIGN_EPI>
__device__ __forceinline__ void gemm_phase(LAS unsigned char* lds, const Gemm g, const Sched& S, const Epi& E) {
    const int tid = threadIdx.x, wid = __builtin_amdgcn_readfirstlane(tid >> 6), lane = tid & 63, wr = wid >> 2, wc = wid & 3, fr = lane & 15, fq = lane >> 4;
    const int K = g.K, nt = K / BK;
    unsigned voffA[2], voffB[2];
#pragma unroll
    for (int i = 0; i < 2; ++i) { int R, C; stage_rc(tid * 16 + i * 8192, R, C); const int Rb = Epi::PERM ? ((R & ~31) + perm32(R & 31)) : R;
        voffA[i] = (unsigned)(R * g.lda + C) * 2u; voffB[i] = (unsigned)(Rb * g.ldb + C) * 2u; }
    const size_t kstep = (size_t)(BK * 2);
    const size_t hstepA = (size_t)HALF * g.lda * 2, hstepB = (size_t)HALF * g.ldb * 2;
    const size_t tstepA = 2 * hstepA, tstepB = 2 * hstepB;
    const unsigned ldsw = (unsigned)wid * 1024u;
    const int aoff = lds_byte(wr * 64 + fr, fq * 8), boff = lds_byte(wc * 32 + fr, fq * 8);
#define PG8_SA(b, h) (((b) * 2 + (h)) * HTB)
#define PG8_SB(b, h) ((4 + (b) * 2 + (h)) * HTB)
#define PG8_STAGE(bufoff, gbase, voff) do { _Pragma("unroll") for (int _i = 0; _i < 2; ++_i) \
        __builtin_amdgcn_global_load_lds((const unsigned*)((const char*)(gbase) + (voff)[_i]), (LAS unsigned*)(lds + (bufoff) + ldsw + _i * 8192), 16, 0, 0); } while (0)
#define PG8_LDA(dst, b, h) do { _Pragma("unroll") for (int m = 0; m < 4; ++m) _Pragma("unroll") for (int k = 0; k < 2; ++k) dst[m][k] = *(const LAS bf16x8*)(lds + PG8_SA(b, h) + aoff + m * 2048 + k * 1024); } while (0)
#define PG8_LDB(dst, b, h) do { _Pragma("unroll") for (int n = 0; n < 2; ++n) _Pragma("unroll") for (int k = 0; k < 2; ++k) dst[n][k] = *(const LAS bf16x8*)(lds + PG8_SB(b, h) + boff + n * 2048 + k * 1024); } while (0)
#define PG8_MMA(ai, bj, At, Bt) do { __builtin_amdgcn_s_setprio(1); _Pragma("unroll") for (int m = 0; m < 4; ++m) _Pragma("unroll") for (int n = 0; n < 2; ++n) _Pragma("unroll") for (int k = 0; k < 2; ++k) \
        acc[ai][bj][m][n] = __builtin_amdgcn_mfma_f32_16x16x32_bf16(Bt[n][k], At[m][k], acc[ai][bj][m][n], 0, 0, 0); __builtin_amdgcn_s_setprio(0); } while (0)
#define PG8_WAIT_V(n) asm volatile("s_waitcnt vmcnt(" #n ")" ::: "memory")
#define PG8_WAIT_L(n) asm volatile("s_waitcnt lgkmcnt(" #n ")" ::: "memory")
#define PG8_BAR __builtin_amdgcn_s_barrier()
#define PG8_SCHED __builtin_amdgcn_sched_barrier(0)
    Unit cur, nxt; int ui = 0;
    if (!S.next(0, cur)) return;
    f32x4 acc[2][2][4][2];
#pragma unroll
    for (int a = 0; a < 2; ++a)
#pragma unroll
        for (int b = 0; b < 2; ++b)
#pragma unroll
            for (int m = 0; m < 4; ++m)
#pragma unroll
                for (int n = 0; n < 2; ++n) acc[a][b][m][n] = (f32x4){0.f, 0.f, 0.f, 0.f};
    bf16x8 At[4][2], B0[2][2], B1[2][2];
    const char* cA = (const char*)g.A + (size_t)cur.pm * tstepA; const char* cB = (const char*)g.Bt + (size_t)cur.pn * tstepB;
    S.a_ready(cur);
    PG8_STAGE(PG8_SB(0, 0), cB, voffB); PG8_STAGE(PG8_SB(0, 1), cB + hstepB, voffB); PG8_STAGE(PG8_SA(0, 0), cA, voffA); PG8_STAGE(PG8_SA(0, 1), cA + hstepA, voffA);
    if (wr == 1) PG8_BAR;
    PG8_WAIT_V(2); PG8_BAR;
    PG8_STAGE(PG8_SB(1, 0), cB + kstep, voffB); PG8_STAGE(PG8_SA(1, 0), cA + kstep, voffA); PG8_STAGE(PG8_SB(1, 1), cB + hstepB + kstep, voffB);
    PG8_WAIT_V(6); PG8_BAR;
    for (;;) {
        const bool has_next = S.next(ui + 1, nxt);
        const char* nA = has_next ? (const char*)g.A + (size_t)nxt.pm * tstepA : cA; const char* nB = has_next ? (const char*)g.Bt + (size_t)nxt.pn * tstepB : cB;
        for (int t = 0; t < nt; t += 2) {
            const bool last = (t == nt - 2);
            const char* a1 = cA + (size_t)(t + 1) * kstep;
            const char* a2 = last ? nA : cA + (size_t)(t + 2) * kstep; const char* b2 = last ? nB : cB + (size_t)(t + 2) * kstep;
            const char* a3 = a2 + kstep; const char* b3 = b2 + kstep;
            if (last && has_next) S.a_ready(nxt);
            PG8_LDB(B0, 0, 0); PG8_LDB(B1, 0, 1); PG8_SCHED; PG8_LDA(At, 0, 0); PG8_STAGE(PG8_SA(1, 1), a1 + hstepA, voffA);
            PG8_WAIT_V(8); PG8_WAIT_L(0); PG8_BAR; PG8_MMA(0, 0, At, B0); PG8_MMA(0, 1, At, B1); PG8_BAR; PG8_SCHED;
            PG8_LDA(At, 0, 1); PG8_STAGE(PG8_SB(0, 0), b2, voffB); PG8_STAGE(PG8_SB(0, 1), b2 + hstepB, voffB); PG8_STAGE(PG8_SA(0, 0), a2, voffA);
            PG8_WAIT_V(8); PG8_WAIT_L(0); PG8_BAR; PG8_MMA(1, 0, At, B0); PG8_MMA(1, 1, At, B1); PG8_BAR; PG8_SCHED;
            PG8_LDB(B0, 1, 0); PG8_LDB(B1, 1, 1); PG8_SCHED; PG8_LDA(At, 1, 0); PG8_STAGE(PG8_SA(0, 1), a2 + hstepA, voffA);
            PG8_WAIT_V(8); PG8_WAIT_L(0); PG8_BAR; PG8_MMA(0, 0, At, B0); PG8_MMA(0, 1, At, B1); PG8_BAR; PG8_SCHED;
            PG8_LDA(At, 1, 1); PG8_STAGE(PG8_SB(1, 0), b3, voffB); PG8_STAGE(PG8_SB(1, 1), b3 + hstepB, voffB); PG8_STAGE(PG8_SA(1, 0), a3, voffA);
            PG8_WAIT_V(8); PG8_WAIT_L(0); PG8_BAR; PG8_MMA(1, 0, At, B0); PG8_MMA(1, 1, At, B1); PG8_BAR; PG8_SCHED;
        }
        if constexpr (ALIGN_EPI) { if (wr == 0) PG8_BAR; }
        E(acc, cur, wr, wc, fr, fq); S.done(cur);
        if (!has_next) break;
#pragma unroll
        for (int a = 0; a < 2; ++a)
#pragma unroll
            for (int b = 0; b < 2; ++b)
#pragma unroll
                for (int m = 0; m < 4; ++m)
#pragma unroll
                    for (int n = 0; n < 2; ++n) acc[a][b][m][n] = (f32x4){0.f, 0.f, 0.f, 0.f};
        cur = nxt; cA = nA; cB = nB; ++ui;
        if constexpr (ALIGN_EPI) { if (wr == 1) PG8_BAR; }
    }
    PG8_WAIT_V(0);
    if constexpr (!ALIGN_EPI) { if (wr == 0) PG8_BAR; }
    PG8_BAR;
#undef PG8_SA
#undef PG8_SB
#undef PG8_STAGE
#undef PG8_LDA
#undef PG8_LDB
#undef PG8_MMA
#undef PG8_WAIT_V
#undef PG8_WAIT_L
#undef PG8_BAR
#undef PG8_SCHED
}
}

#define XB_TMO      128
#define XB_XCNT(j)  (256  + 64 * (j))
#define XB_XSUB(j)  (1280 + 64 * (j))
#define XB_XGEN(j)  (2304 + 64 * (j))
#define XB_TOP      3328
#define XB_TOPGEN   3392
#define XCD_BAR_WORDS 3456
#define XB_SPIN_CAP (1u << 18)
__device__ __forceinline__ unsigned xb_ld(unsigned* p)              { return __hip_atomic_load(p, __ATOMIC_RELAXED, __HIP_MEMORY_SCOPE_AGENT); }
__device__ __forceinline__ unsigned xb_add(unsigned* p, unsigned v) { return __hip_atomic_fetch_add(p, v, __ATOMIC_RELAXED, __HIP_MEMORY_SCOPE_AGENT); }
__device__ __forceinline__ unsigned xb_xcc_id() { return (unsigned)__builtin_amdgcn_s_getreg((3 << 11) | 20) & 0xFu; }
#define XB_SPIN(cond, bar) do { unsigned _sp = 0; while (cond) { __builtin_amdgcn_s_sleep(1); \
    if ((++_sp & 255u) == 0u) { if (xb_ld(&(bar)[XB_TMO])) break; if (_sp > XB_SPIN_CAP) { atomicAdd(&(bar)[XB_TMO], 1u); break; } } } } while (0)
struct XcdBarrier { unsigned* bar; unsigned x; volatile LAS unsigned* st; };
__device__ __forceinline__ XcdBarrier xcd_barrier_post(unsigned* bar, volatile LAS unsigned* st) {
    XcdBarrier b; b.bar = bar; b.x = xb_xcc_id(); b.st = st;
    if (threadIdx.x == 0) (void)xb_add(&bar[XB_XCNT(b.x)], 1u);
    return b;
}
__device__ __forceinline__ void xcd_barrier_complete(unsigned* bar, unsigned x, unsigned& nloc, unsigned& nx) {
    const unsigned G = gridDim.x * gridDim.y * gridDim.z;
    unsigned sum, cnt, mine, sp = 0u;
    for (;;) {
        sum = 0u; cnt = 0u; mine = 0u;
#pragma unroll
        for (unsigned j = 0; j < 16; ++j) { const unsigned c = xb_ld(&bar[XB_XCNT(j)]); sum += c; cnt += (c > 0u) ? 1u : 0u; mine = (j == x) ? c : mine; }
        if (sum == G) break;
        __builtin_amdgcn_s_sleep(1);
        if ((++sp & 255u) == 0u) { if (xb_ld(&bar[XB_TMO])) break; if (sp > XB_SPIN_CAP) { atomicAdd(&bar[XB_TMO], 1u); break; } }
    }
    nloc = mine > 0u ? mine : 1u; nx = cnt > 0u ? cnt : 1u;
}
__device__ __forceinline__ void xcd_barrier(const XcdBarrier& b) {
    asm volatile("s_waitcnt vmcnt(0)" ::: "memory");
    __syncthreads();
    if (threadIdx.x == 0) {
        unsigned* bar = b.bar;
        __builtin_amdgcn_s_waitcnt(0);
        unsigned nloc = b.st[0], nx = b.st[1];
        if (nloc == 0u) { xcd_barrier_complete(bar, b.x, nloc, nx); b.st[0] = nloc; b.st[1] = nx; }
        const unsigned old = xb_add(&bar[XB_XSUB(b.x)], 1u);
        const unsigned gen = old / nloc;
        if (old + 1u == (gen + 1u) * nloc) {
            __builtin_amdgcn_fence(__ATOMIC_RELEASE, "agent");
            asm volatile("s_waitcnt vmcnt(0)" ::: "memory");
            const unsigned og = xb_add(&bar[XB_TOP], 1u);
            const unsigned tg = og / nx;
            if (og + 1u == (tg + 1u) * nx) xb_add(&bar[XB_TOPGEN], 1u);
            else XB_SPIN(xb_ld(&bar[XB_TOPGEN]) == tg, bar);
            __builtin_amdgcn_fence(__ATOMIC_ACQUIRE, "agent");
            xb_add(&bar[XB_XGEN(b.x)], 1u);
            asm volatile("s_waitcnt vmcnt(0)" ::: "memory");
        } else {
            XB_SPIN(xb_ld(&bar[XB_XGEN(b.x)]) == gen, bar);
            __builtin_amdgcn_fence(__ATOMIC_ACQUIRE, "agent");
            asm volatile("s_waitcnt vmcnt(0)" ::: "memory");
        }
    }
    __syncthreads();
}

template <bool QKPERM>
__device__ __forceinline__ void cvt_matrix(const float* W, int K, int N, bf16_t* WT, int row_off, LAS float* scr, int gw, int ngw, int lane) {
    const int nblk = N / 32, nitems = (K / 64) * nblk;
    for (int item = gw; item < nitems; item += ngw) {
        const int kb = item / nblk, nb = item % nblk, k0 = 64 * kb, n0 = 32 * nb;
#pragma unroll 8
        for (int i = 0; i < 32; ++i) { const int kk = 2 * i + (lane >> 5); scr[kk * 33 + (lane & 31)] = W[(size_t)(k0 + kk) * N + n0 + (lane & 31)]; }
        asm volatile("s_waitcnt lgkmcnt(0)" ::: "memory");
        int d0 = n0;
        if (QKPERM) { if (n0 < 9 * GW && (n0 % (3 * GW)) < 2 * GW) d0 = (n0 & ~0xC0) | ((n0 & 0x40) << 1) | ((n0 & 0x80) >> 1); }
        const int c = lane & 7;
#pragma unroll
        for (int j = 0; j < 4; ++j) { const int n = (lane >> 3) + 8 * j; const LAS float* s = scr + (8 * c) * 33 + n;
            u32x4 o; o.x = cvt_pk_bf16(s[0 * 33], s[1 * 33]); o.y = cvt_pk_bf16(s[2 * 33], s[3 * 33]); o.z = cvt_pk_bf16(s[4 * 33], s[5 * 33]); o.w = cvt_pk_bf16(s[6 * 33], s[7 * 33]);
            *(u32x4*)(WT + (size_t)(row_off + d0 + n) * K + k0 + 8 * c) = o; }
        asm volatile("s_waitcnt lgkmcnt(0)" ::: "memory");
    }
}
__device__ __forceinline__ void rms_row_to_bf16(const float* xrow, const float* g, bf16_t* orow, int) {
    const int lane = fresh_lane();
    const f32x4* xr = (const f32x4*)xrow + lane;
    f32x4 v[16]; float s = 0.f;
#pragma unroll
    for (int j = 0; j < 16; ++j) { v[j] = xr[64 * j]; s += (v[j].x * v[j].x + v[j].y * v[j].y) + (v[j].z * v[j].z + v[j].w * v[j].w); }
    const float rstd = 1.0f / sqrtf(wave_sum(s) * (1.f / DM) + EPS);
    const f32x4* gr = (const f32x4*)g + lane; u32x2* o8 = (u32x2*)orow + lane;
#pragma unroll
    for (int j = 0; j < 16; ++j) { const f32x4 gv = gr[64 * j]; u32x2 w; w.x = cvt_pk_bf16(v[j].x * rstd * gv.x, v[j].y * rstd * gv.y); w.y = cvt_pk_bf16(v[j].z * rstd * gv.z, v[j].w * rstd * gv.w); o8[64 * j] = w; }
}
__device__ __forceinline__ void norm_res_row(const float* xsrc, const bf16_t* yrow, const float* gpost, const float* gpre, float* xout, bf16_t* xn, int) {
    const int lane = fresh_lane();
    const u32x2* yr = (const u32x2*)yrow + lane; f32x4 y[16]; float s = 0.f;
#pragma unroll
    for (int j = 0; j < 16; ++j) { const u32x2 w = yr[64 * j]; y[j] = (f32x4){bf_lo(w.x), bf_hi(w.x), bf_lo(w.y), bf_hi(w.y)}; s += (y[j].x * y[j].x + y[j].y * y[j].y) + (y[j].z * y[j].z + y[j].w * y[j].w); }
    const float rstd = 1.0f / sqrtf(wave_sum(s) * (1.f / DM) + EPS);
    const f32x4* xr = (const f32x4*)xsrc + lane; const f32x4* gp = (const f32x4*)gpost + lane; f32x4* xo = (f32x4*)xout + lane; float s2 = 0.f;
#pragma unroll
    for (int j = 0; j < 16; ++j) { const f32x4 xv = xr[64 * j], gv = gp[64 * j]; y[j] = xv + y[j] * rstd * gv; xo[64 * j] = y[j]; s2 += (y[j].x * y[j].x + y[j].y * y[j].y) + (y[j].z * y[j].z + y[j].w * y[j].w); }
    if (xn) {
        const float rstd2 = 1.0f / sqrtf(wave_sum(s2) * (1.f / DM) + EPS);
        const f32x4* gr = (const f32x4*)gpre + lane; u32x2* o8 = (u32x2*)xn + lane;
#pragma unroll
        for (int j = 0; j < 16; ++j) { const f32x4 gv = gr[64 * j]; u32x2 w; w.x = cvt_pk_bf16(y[j].x * rstd2 * gv.x, y[j].y * rstd2 * gv.y); w.y = cvt_pk_bf16(y[j].z * rstd2 * gv.z, y[j].w * rstd2 * gv.w); o8[64 * j] = w; }
    }
}
__device__ __forceinline__ void unpack8(const u32x4 w, float (&f)[8]) { f[0] = bf_lo(w.x); f[1] = bf_hi(w.x); f[2] = bf_lo(w.y); f[3] = bf_hi(w.y); f[4] = bf_lo(w.z); f[5] = bf_hi(w.z); f[6] = bf_lo(w.w); f[7] = bf_hi(w.w); }
__device__ __forceinline__ u32x4 pack8f(const float (&f)[8]) { u32x4 w; w.x = cvt_pk_bf16(f[0], f[1]); w.y = cvt_pk_bf16(f[2], f[3]); w.z = cvt_pk_bf16(f[4], f[5]); w.w = cvt_pk_bf16(f[6], f[7]); return w; }

__device__ __forceinline__ void conv_gate_phase(const bf16_t* H, const float* cw  , bf16_t* A2  , int gtid, int nthreads) {
    constexpr int RB = 32, NCG = CW / 8, NIT = (SEQ / RB) * NCG;
    for (int it = gtid; it < NIT; it += nthreads) {
        const int cg = it % NCG, rb = it / NCG, c0 = cg * 8, t0 = rb * RB;
        float w0[8], w1[8], w2[8], m2[8], m1[8];
#pragma unroll
        for (int i = 0; i < 8; ++i) { w0[i] = cw[c0 + i]; w1[i] = cw[CW + c0 + i]; w2[i] = cw[2 * CW + c0 + i]; m2[i] = 0.f; m1[i] = 0.f; }
        if (t0 >= 2) {
            float a[8], b[8];
            unpack8(*(const u32x4*)(H + (size_t)(t0 - 2) * N_CI + CW + c0), a); unpack8(*(const u32x4*)(H + (size_t)(t0 - 2) * N_CI + 2 * CW + c0), b);
#pragma unroll
            for (int i = 0; i < 8; ++i) m2[i] = a[i] * b[i];
            unpack8(*(const u32x4*)(H + (size_t)(t0 - 1) * N_CI + CW + c0), a); unpack8(*(const u32x4*)(H + (size_t)(t0 - 1) * N_CI + 2 * CW + c0), b);
#pragma unroll
            for (int i = 0; i < 8; ++i) m1[i] = a[i] * b[i];
        }
#pragma unroll 4
        for (int r = 0; r < RB; ++r) {
            const bf16_t* hr = H + (size_t)(t0 + r) * N_CI + c0;
            float bg[8], cgt[8], uu[8], o[8];
            unpack8(*(const u32x4*)(hr), bg); unpack8(*(const u32x4*)(hr + CW), cgt); unpack8(*(const u32x4*)(hr + 2 * CW), uu);
#pragma unroll
            for (int i = 0; i < 8; ++i) { const float cu = cgt[i] * uu[i]; o[i] = bg[i] * (w0[i] * m2[i] + w1[i] * m1[i] + w2[i] * cu); m2[i] = m1[i]; m1[i] = cu; }
            *(u32x4*)(A2 + (size_t)(t0 + r) * K_CO + c0) = pack8f(o);
        }
    }
}
__device__ __forceinline__ void ffn_act_phase(const bf16_t* GU, const float* cw  , bf16_t* ACT  , int gtid, int nthreads) {
    constexpr int RB = 32, NCG = DFF / 8, NIT = (SEQ / RB) * NCG;
    for (int it = gtid; it < NIT; it += nthreads) {
        const int cg = it % NCG, rb = it / NCG, c0 = cg * 8, t0 = rb * RB;
        float w0[8], w1[8], w2[8], m2[8], m1[8];
#pragma unroll
        for (int i = 0; i < 8; ++i) { w0[i] = cw[c0 + i]; w1[i] = cw[DFF + c0 + i]; w2[i] = cw[2 * DFF + c0 + i]; m2[i] = 0.f; m1[i] = 0.f; }
        if (t0 >= 2) { unpack8(*(const u32x4*)(GU + (size_t)(t0 - 2) * N_GU + c0), m2); unpack8(*(const u32x4*)(GU + (size_t)(t0 - 1) * N_GU + c0), m1); }
#pragma unroll 4
        for (int r = 0; r < RB; ++r) {
            const bf16_t* hr = GU + (size_t)(t0 + r) * N_GU + c0;
            float gg[8], uu[8], o[8];
            unpack8(*(const u32x4*)(hr), gg); unpack8(*(const u32x4*)(hr + DFF), uu);
#pragma unroll
            for (int i = 0; i < 8; ++i) { const float gc = w0[i] * m2[i] + w1[i] * m1[i] + w2[i] * gg[i]; const float sg = gc / (1.0f + __expf(-gc)); o[i] = sg * uu[i]; m2[i] = m1[i]; m1[i] = gg[i]; }
            *(u32x4*)(ACT + (size_t)(t0 + r) * DFF + c0) = pack8f(o);
        }
    }
}
__device__ __forceinline__ void merge_phase(const bf16_t* OG  , const float* LSE  , bf16_t* A2  , int gtid, int nthreads) {
    constexpr int NIT = SEQ * (GW / 8);
    for (int it = gtid; it < NIT; it += nthreads) {
        const int ch = it % (GW / 8), t = it / (GW / 8), hd = ch >> 4;
        const float l0 = LSE[(size_t)(0 * 16 + hd) * SEQ + t];
        const float l1 = LSE[(size_t)(1 * 16 + hd) * SEQ + (t & 3) * (SEQ / 4) + (t >> 2)];
        const float l2 = LSE[(size_t)(2 * 16 + hd) * SEQ + (t & 15) * (SEQ / 16) + (t >> 4)];
        const float mx = fmaxf(l0, fmaxf(l1, l2));
        const float e0 = __expf(l0 - mx), e1 = __expf(l1 - mx), e2 = __expf(l2 - mx), inv = 1.0f / (e0 + e1 + e2);
        float a[8], b[8], c[8], o[8];
        unpack8(*(const u32x4*)(OG + (size_t)t * GW + ch * 8), a); unpack8(*(const u32x4*)(OG + (size_t)(SEQ + t) * GW + ch * 8), b); unpack8(*(const u32x4*)(OG + (size_t)(2 * SEQ + t) * GW + ch * 8), c);
#pragma unroll
        for (int i = 0; i < 8; ++i) o[i] = (e0 * a[i] + e1 * b[i] + e2 * c[i]) * inv;
        *(u32x4*)(A2 + (size_t)t * K_AO + ch * 8) = pack8f(o);
    }
}

template <int HD, int STR>
__device__ __forceinline__ void attn_load_tile(LAS unsigned char* dst, const bf16_t* src, long stride, int valid_from, int tid) {
    constexpr int CPR = HD / 8, PER = 256 * CPR / 512;
    u32x4 v[PER];
#pragma unroll
    for (int j = 0; j < PER; ++j) { const int idx = tid + 512 * j, row = idx / CPR, ch = idx % CPR;
        v[j] = (u32x4){0u, 0u, 0u, 0u}; if (row >= valid_from) v[j] = *(const u32x4*)(src + (long)row * stride + ch * 8); }
#pragma unroll
    for (int j = 0; j < PER; ++j) { const int idx = tid + 512 * j, row = idx / CPR, ch = idx % CPR; *(LAS u32x4*)(dst + row * STR + ch * 16) = v[j]; }
}
template <int HD, int NT, bool DIL>
__device__ __forceinline__ void attn_unit(LAS unsigned char* lds, const bf16_t* Qp, long qstride, const bf16_t* Kp, const bf16_t* Vp, long kvstride, int valid_from,
                                          bf16_t* Op, long ostride, float* lsep, float scale) {
    constexpr int KSTR = HD * 2 + 16, VSTR = HD * 2 + 32, NC = (NT + 1) / 2, NDT = HD / 16, NQC = HD / 32;
    constexpr bool BOTH = (256 * KSTR + 256 * VSTR) <= LDSCTL_OFF;
    const int tid = threadIdx.x, w = __builtin_amdgcn_readfirstlane(tid >> 6), lane = tid & 63, lq = lane & 15, g4 = lane >> 4;
    LAS unsigned char* Kl = lds; LAS unsigned char* Vl = BOTH ? lds + 256 * KSTR : lds;
    __syncthreads();
    attn_load_tile<HD, KSTR>(Kl, Kp, kvstride, valid_from, tid);
    if (BOTH) attn_load_tile<HD, VSTR>(Vl, Vp, kvstride, valid_from, tid);
    bf16x8 qf[NQC];
#pragma unroll
    for (int c = 0; c < NQC; ++c) qf[c] = *(const bf16x8*)(Qp + (long)(16 * w + lq) * qstride + 32 * c + 8 * g4);
    __syncthreads();
    const int jt0 = DIL ? w : 0;
    f32x4 s[NT];
#pragma unroll
    for (int j = 0; j < NT; ++j) { s[j] = (f32x4){0.f, 0.f, 0.f, 0.f}; const LAS unsigned char* kr = Kl + (16 * (jt0 + j) + lq) * KSTR + 16 * g4;
#pragma unroll
        for (int c = 0; c < NQC; ++c) { const bf16x8 kf = *(const LAS bf16x8*)(kr + 64 * c); s[j] = __builtin_amdgcn_mfma_f32_16x16x32_bf16(kf, qf[c], s[j], 0, 0, 0); } }
    if (!BOTH) { __syncthreads(); attn_load_tile<HD, VSTR>(Vl, Vp, kvstride, valid_from, tid); }
    const float NEG = -__builtin_inff();
    float mx = NEG;
    const int qi = 16 * w + lq;
#pragma unroll
    for (int j = 0; j < NT; ++j)
#pragma unroll
        for (int e = 0; e < 4; ++e) { if (DIL) { const int kr = 16 * (jt0 + j) + 4 * g4 + e; const bool ok = (kr >= qi) && (kr <= qi + 128) && (kr >= valid_from); s[j][e] = ok ? s[j][e] : NEG; } mx = fmaxf(mx, s[j][e]); }
    mx = fmaxf(mx, __shfl_xor(mx, 16)); mx = fmaxf(mx, __shfl_xor(mx, 32));
    const float c2 = scale * 1.4426950408889634f, mb = -mx * c2; float sum = 0.f;
#pragma unroll
    for (int j = 0; j < NT; ++j)
#pragma unroll
        for (int e = 0; e < 4; ++e) { const float p = __builtin_amdgcn_exp2f(fmaf(s[j][e], c2, mb)); s[j][e] = p; sum += p; }
    sum += __shfl_xor(sum, 16); sum += __shfl_xor(sum, 32);
    const float inv = 1.0f / sum;
    bf16x8 pf[NC];
#pragma unroll
    for (int cc = 0; cc < NC; ++cc) { u32x4 wv; wv.x = cvt_pk_bf16(s[2 * cc][0], s[2 * cc][1]); wv.y = cvt_pk_bf16(s[2 * cc][2], s[2 * cc][3]);
        if (2 * cc + 1 < NT) { wv.z = cvt_pk_bf16(s[(2 * cc + 1) % NT][0], s[(2 * cc + 1) % NT][1]); wv.w = cvt_pk_bf16(s[(2 * cc + 1) % NT][2], s[(2 * cc + 1) % NT][3]); } else { wv.z = 0u; wv.w = 0u; }
        pf[cc] = __builtin_bit_cast(bf16x8, wv); }
    if (!BOTH) __syncthreads();
    f32x4 o[NDT];
#pragma unroll
    for (int dt = 0; dt < NDT; ++dt) o[dt] = (f32x4){0.f, 0.f, 0.f, 0.f};
    const unsigned vbase = (unsigned)(size_t)Vl + (unsigned)((16 * jt0 + 4 * g4 + (lq >> 2)) * VSTR + (lq & 3) * 8);
#pragma unroll
    for (int cc = 0; cc < NC; ++cc) {
        const unsigned va = vbase + (unsigned)(cc * 32 * VSTR);
        constexpr int T1OFF = 16 * VSTR;
        const bool has1 = (2 * cc + 1 < NT);
#pragma unroll
        for (int d4 = 0; d4 < NDT; d4 += 4) {
            s16x4 a0, a1, a2, a3, b0, b1, b2, b3;
#define TRRD(dst, addr, off) asm volatile("ds_read_b64_tr_b16 %0, %1 offset:%2" : "=&v"(dst) : "v"(addr), "i"(off) : "memory")
            if (has1) {
                TRRD(a0, va, (d4 + 0) * 32); TRRD(b0, va, (d4 + 0) * 32 + T1OFF); TRRD(a1, va, (d4 + 1) * 32); TRRD(b1, va, (d4 + 1) * 32 + T1OFF);
                TRRD(a2, va, (d4 + 2) * 32); TRRD(b2, va, (d4 + 2) * 32 + T1OFF); TRRD(a3, va, (d4 + 3) * 32); TRRD(b3, va, (d4 + 3) * 32 + T1OFF);
            } else {
                TRRD(a0, va, (d4 + 0) * 32); TRRD(b0, va, (d4 + 0) * 32); TRRD(a1, va, (d4 + 1) * 32); TRRD(b1, va, (d4 + 1) * 32);
                TRRD(a2, va, (d4 + 2) * 32); TRRD(b2, va, (d4 + 2) * 32); TRRD(a3, va, (d4 + 3) * 32); TRRD(b3, va, (d4 + 3) * 32);
            }
#undef TRRD
            asm volatile("s_waitcnt lgkmcnt(0)" ::: "memory"); __builtin_amdgcn_sched_barrier(0);
            o[d4 + 0] = __builtin_amdgcn_mfma_f32_16x16x32_bf16((bf16x8){a0[0], a0[1], a0[2], a0[3], b0[0], b0[1], b0[2], b0[3]}, pf[cc], o[d4 + 0], 0, 0, 0);
            o[d4 + 1] = __builtin_amdgcn_mfma_f32_16x16x32_bf16((bf16x8){a1[0], a1[1], a1[2], a1[3], b1[0], b1[1], b1[2], b1[3]}, pf[cc], o[d4 + 1], 0, 0, 0);
            o[d4 + 2] = __builtin_amdgcn_mfma_f32_16x16x32_bf16((bf16x8){a2[0], a2[1], a2[2], a2[3], b2[0], b2[1], b2[2], b2[3]}, pf[cc], o[d4 + 2], 0, 0, 0);
            o[d4 + 3] = __builtin_amdgcn_mfma_f32_16x16x32_bf16((bf16x8){a3[0], a3[1], a3[2], a3[3], b3[0], b3[1], b3[2], b3[3]}, pf[cc], o[d4 + 3], 0, 0, 0);
        }
    }
    bf16_t* orow = Op + (long)qi * ostride + 4 * g4;
#pragma unroll
    for (int dt = 0; dt < NDT; ++dt) { u32x2 wv; wv.x = cvt_pk_bf16(o[dt][0] * inv, o[dt][1] * inv); wv.y = cvt_pk_bf16(o[dt][2] * inv, o[dt][3] * inv); *(u32x2*)(orow + 16 * dt) = wv; }
    if (lsep && g4 == 0) lsep[qi] = mx * scale + __logf(sum);
}

struct Args {
    const float* x; const float* mem; const int* pos; const float* g_mem; const float* w_mem_kv; const float* g_mix_pre; const float* g_mix_post; const float* g_ffn_pre; const float* g_ffn_post;
    const float* w_conv_in; const float* conv_mix_w; const float* w_conv_out; const float* w_attn_in; const float* w_attn_out; const float* w_ffn_gate; const float* w_ffn_up; const float* conv_ffn_w; const float* w_ffn_down;
    float* out; unsigned char* ws; int ph_lo, ph_hi;
};

__global__ void __launch_bounds__(512, 2) fwd_kernel(Args a) {
    extern __shared__ __attribute__((aligned(16))) unsigned char lds_raw[];
    LAS unsigned char* lds = (LAS unsigned char*)lds_raw;
    volatile LAS unsigned* MISC = (volatile LAS unsigned*)(lds + LDSCTL_OFF);
    const int tid = threadIdx.x, lane = tid & 63, wave = __builtin_amdgcn_readfirstlane(tid >> 6);
    const int G = gridDim.x, bx = blockIdx.x;
    const int gtid = bx * 512 + tid, nthreads = G * 512, gw = bx * 8 + wave, ngw = G * 8;
    unsigned char* ws = a.ws;
    unsigned* ctl = (unsigned*)(ws + WS_CTL);
    bf16_t* WKV = (bf16_t*)(ws + WS_WKV); bf16_t* WCI = (bf16_t*)(ws + WS_WCI); bf16_t* WCO = (bf16_t*)(ws + WS_WCO); bf16_t* WAI = (bf16_t*)(ws + WS_WAI); bf16_t* WAO = (bf16_t*)(ws + WS_WAO);
    bf16_t* WGU = (bf16_t*)(ws + WS_WGU); bf16_t* WD = (bf16_t*)(ws + WS_WD);
    bf16_t* XN = (bf16_t*)(ws + WS_XN); bf16_t* H = (bf16_t*)(ws + WS_R); bf16_t* GU = (bf16_t*)(ws + WS_R); bf16_t* Y = (bf16_t*)(ws + WS_R);
    bf16_t* ACT = (bf16_t*)(ws + WS_S); bf16_t* A2 = (bf16_t*)(ws + WS_S); bf16_t* OG = (bf16_t*)(ws + WS_S + 64 * MiB);
    bf16_t* MEMN = (bf16_t*)(ws + WS_MEMN); bf16_t* KV = (bf16_t*)(ws + WS_KV); float* COS = (float*)(ws + WS_COS); float* SIN = (float*)(ws + WS_SIN); float* LSE = (float*)(ws + WS_LSE);

    for (int u = tid; u < (LDS_BYTES - LDSCTL_OFF) / 4; u += 512) ((LAS unsigned*)(lds + LDSCTL_OFF))[u] = 0u;
    __syncthreads();
    XcdBarrier bar; bar.bar = ctl + CW_BAR; bar.x = 0; bar.st = nullptr;
    if (ONE_LAUNCH) bar = xcd_barrier_post(ctl + CW_BAR, MISC + 8);
    const int lo = a.ph_lo, hi = a.ph_hi;
#define IN(k) (lo <= (k) && (k) < hi)
#define SEAM(k) do { if (IN(k) && IN((k) + 1)) xcd_barrier(bar); } while (0)
    constexpr size_t SZ_GU = (size_t)N_GU * DM, SZ_D = (size_t)DM * DFF;

    if (IN(0)) {
        LAS float* scr = (LAS float*)(lds + wave * 16384);
        cvt_matrix<false>(a.w_mem_kv, DM, 2 * MW, WKV, 0, scr, gw, ngw, lane);
        for (int m = gw; m < NMEM; m += ngw) rms_row_to_bf16(a.mem + (size_t)m * DM, a.g_mem, MEMN + (size_t)m * DM, lane);
        for (int m = gw; m < SEQ; m += ngw) rms_row_to_bf16(a.x + (size_t)m * DM, a.g_mix_pre, XN + (size_t)m * DM, lane);
        for (int idx = gtid; idx < SEQ * 64; idx += nthreads) { const int t = idx >> 6, i = idx & 63;
            const float ang = (float)a.pos[t] * INV_FREQ[i];
            const double kq = rint((double)ang * 0.15915494309189535); double r = fma(-kq, 6.283185307179586, (double)ang); r = fma(-kq, 2.4492935982947064e-16, r);
            const float rf = (float)r; COS[idx] = cosf(rf); SIN[idx] = sinf(rf); }
    }
    SEAM(0);
    if (IN(1)) {
        if (bx < 8) {
            pg8::Gemm g{MEMN, WKV, DM, DM, DM}; pg8::StaticOrder S; S.init(NMEM, 2 * MW, 8, bx);
            pg8::EpiStore E{KV, 2 * MW};
            pg8::gemm_phase<pg8::EpiStore, pg8::StaticOrder, true>(lds, g, S, E);
        } else {
            LAS float* scr = (LAS float*)(lds + wave * 16384);
            const int cw_ = (bx - 8) * 8 + wave, ncw = (G - 8) * 8;
            cvt_matrix<false>(a.w_conv_in, DM, N_CI, WCI, 0, scr, cw_, ncw, lane);
            cvt_matrix<false>(a.w_conv_out, K_CO, DM, WCO, 0, scr, cw_, ncw, lane);
            cvt_matrix<false>(a.w_ffn_gate, DM, DFF, WGU, 0, scr, cw_, ncw, lane);
            cvt_matrix<false>(a.w_ffn_up, DM, DFF, WGU, DFF, scr, cw_, ncw, lane);
            cvt_matrix<false>(a.w_ffn_down, DFF, DM, WD, 0, scr, cw_, ncw, lane);
            cvt_matrix<true>(a.w_attn_in, DM, N_AI, WAI, 0, scr, cw_, ncw, lane);
            cvt_matrix<false>(a.w_attn_out, K_AO, DM, WAO, 0, scr, cw_, ncw, lane);
            cvt_matrix<false>(a.w_ffn_gate + SZ_D, DM, DFF, WGU + SZ_GU, 0, scr, cw_, ncw, lane);
            cvt_matrix<false>(a.w_ffn_up + SZ_D, DM, DFF, WGU + SZ_GU, DFF, scr, cw_, ncw, lane);
            cvt_matrix<false>(a.w_ffn_down + SZ_D, DFF, DM, WD + SZ_D, 0, scr, cw_, ncw, lane);
        }
    }
    SEAM(1);
    if (IN(2)) {
        pg8::Gemm g{XN, WCI, DM, DM, DM}; pg8::StaticOrder S; S.init(SEQ, N_CI, G, bx);
        pg8::EpiStore E{H, N_CI};
        pg8::gemm_phase<pg8::EpiStore, pg8::StaticOrder, true>(lds, g, S, E);
    }
    SEAM(2);
    if (IN(3)) {
        for (int u = bx; u < 4 * (SEQ / 128); u += G) { const int hd = u / (SEQ / 128), qb = u % (SEQ / 128);
            attn_unit<256, 16, false>(lds, H + (size_t)(128 * qb) * N_CI + 3 * CW + 256 * hd, N_CI, KV + 256 * hd, KV + MW + 256 * hd, 2 * MW, 0,
                                      A2 + (size_t)(128 * qb) * K_CO + CW + 256 * hd, K_CO, nullptr, 0.0625f); }
        conv_gate_phase(H, a.conv_mix_w, A2, gtid, nthreads);
    }
    SEAM(3);
    if (IN(4)) {
        pg8::Gemm g{A2, WCO, K_CO, K_CO, K_CO}; pg8::StaticOrder S; S.init(SEQ, DM, G, bx);
        pg8::EpiStore E{Y, DM};
        pg8::gemm_phase<pg8::EpiStore, pg8::StaticOrder, true>(lds, g, S, E);
    }
    SEAM(4);
    if (IN(5)) { for (int m = gw; m < SEQ; m += ngw) norm_res_row(a.x + (size_t)m * DM, Y + (size_t)m * DM, a.g_mix_post, a.g_ffn_pre, a.out + (size_t)m * DM, XN + (size_t)m * DM, lane); }
    SEAM(5);
    if (IN(6)) {
        pg8::Gemm g{XN, WGU, DM, DM, DM}; pg8::StaticOrder S; S.init(SEQ, N_GU, G, bx);
        pg8::EpiStore E{GU, N_GU};
        pg8::gemm_phase<pg8::EpiStore, pg8::StaticOrder, true>(lds, g, S, E);
    }
    SEAM(6);
    if (IN(7)) ffn_act_phase(GU, a.conv_ffn_w, ACT, gtid, nthreads);
    SEAM(7);
    if (IN(8)) {
        pg8::Gemm g{ACT, WD, DFF, DFF, DFF}; pg8::StaticOrder S; S.init(SEQ, DM, G, bx);
        pg8::EpiStore E{Y, DM};
        pg8::gemm_phase<pg8::EpiStore, pg8::StaticOrder, true>(lds, g, S, E);
    }
    SEAM(8);
    if (IN(9)) { for (int m = gw; m < SEQ; m += ngw) norm_res_row(a.out + (size_t)m * DM, Y + (size_t)m * DM, a.g_ffn_post, a.g_mix_pre + DM, a.out + (size_t)m * DM, XN + (size_t)m * DM, lane); }
    SEAM(9);
    if (IN(10)) {
        pg8::Gemm g{XN, WAI, DM, DM, DM}; pg8::StaticOrder S; S.init(SEQ, N_AI, G, bx);
        pg8::EpiRope E{H, N_AI, COS, SIN};
        pg8::gemm_phase<pg8::EpiRope, pg8::StaticOrder, true>(lds, g, S, E);
    }
    SEAM(10);
    if (IN(11)) {
        for (int u = bx; u < 3 * 16 * 64; u += G) {
            const int grp = u >> 10, rem = u & 1023, hd = rem >> 6, blk = rem & 63;
            const int dsh = 2 * grp, d = 1 << dsh, nbr = 64 >> dsh, r = blk / nbr, nb = blk % nbr;
            const long ts = (long)d * N_AI;
            const bf16_t* base = H + (size_t)r * N_AI + grp * (3 * GW) + hd * HDIM;
            const long p0 = 128L * nb;
            attn_unit<128, 9, true>(lds, base + p0 * ts, ts, base + GW + (p0 - 128) * ts, base + 2 * GW + (p0 - 128) * ts, ts, nb == 0 ? 128 : 0,
                                    OG + ((size_t)grp * SEQ + r) * GW + hd * HDIM + p0 * (long)d * GW, (long)d * GW,
                                    LSE + (size_t)(grp * 16 + hd) * SEQ + (size_t)r * (SEQ >> dsh) + p0, 0.08838834764831845f);
        }
        for (int u = bx; u < 4 * (SEQ / 128); u += G) { const int hd = u / (SEQ / 128), qb = u % (SEQ / 128);
            attn_unit<256, 16, false>(lds, H + (size_t)(128 * qb) * N_AI + 9 * GW + 256 * hd, N_AI, KV + 256 * hd, KV + MW + 256 * hd, 2 * MW, 0,
                                      A2 + (size_t)(128 * qb) * K_AO + GW + 256 * hd, K_AO, nullptr, 0.0625f); }
    }
    SEAM(11);
    if (IN(12)) merge_phase(OG, LSE, A2, gtid, nthreads);
    SEAM(12);
    if (IN(13)) {
        pg8::Gemm g{A2, WAO, K_AO, K_AO, K_AO}; pg8::StaticOrder S; S.init(SEQ, DM, G, bx);
        pg8::EpiStore E{Y, DM};
        pg8::gemm_phase<pg8::EpiStore, pg8::StaticOrder, true>(lds, g, S, E);
    }
    SEAM(13);
    if (IN(14)) { for (int m = gw; m < SEQ; m += ngw) norm_res_row(a.out + (size_t)m * DM, Y + (size_t)m * DM, a.g_mix_post + DM, a.g_ffn_pre + DM, a.out + (size_t)m * DM, XN + (size_t)m * DM, lane); }
    SEAM(14);
    if (IN(15)) {
        pg8::Gemm g{XN, WGU + SZ_GU, DM, DM, DM}; pg8::StaticOrder S; S.init(SEQ, N_GU, G, bx);
        pg8::EpiStore E{GU, N_GU};
        pg8::gemm_phase<pg8::EpiStore, pg8::StaticOrder, true>(lds, g, S, E);
    }
    SEAM(15);
    if (IN(16)) ffn_act_phase(GU, a.conv_ffn_w + 3 * DFF, ACT, gtid, nthreads);
    SEAM(16);
    if (IN(17)) {
        pg8::Gemm g{ACT, WD + SZ_D, DFF, DFF, DFF}; pg8::StaticOrder S; S.init(SEQ, DM, G, bx);
        pg8::EpiStore E{Y, DM};
        pg8::gemm_phase<pg8::EpiStore, pg8::StaticOrder, true>(lds, g, S, E);
    }
    SEAM(17);
    if (IN(18)) { for (int m = gw; m < SEQ; m += ngw) norm_res_row(a.out + (size_t)m * DM, Y + (size_t)m * DM, a.g_ffn_post + DM, nullptr, a.out + (size_t)m * DM, nullptr, lane); }
#undef IN
#undef SEAM
}

extern "C" void kernel_launch(void* const* d_in, const int* in_sizes, int n_in, void* d_out, int out_size, void* d_ws, size_t ws_size, hipStream_t stream) {
    static int grid = 0;
    if (grid == 0) {
        if (n_in != 18 || in_sizes[0] != SEQ * DM || out_size != SEQ * DM || ws_size < WS_END) { fprintf(stderr, "kernel_launch: unexpected shapes (n_in %d, in0 %d, out %d, ws %zu < %zu?)\n", n_in, n_in > 0 ? in_sizes[0] : -1, out_size, ws_size, (size_t)WS_END); grid = -1; return; }
        int dev = 0, cus = 0;
        if (hipGetDevice(&dev) != hipSuccess || hipDeviceGetAttribute(&cus, hipDeviceAttributeMultiprocessorCount, dev) != hipSuccess) { grid = -1; return; }
        if (hipFuncSetAttribute((const void*)fwd_kernel, hipFuncAttributeMaxDynamicSharedMemorySize, LDS_BYTES) != hipSuccess) { fprintf(stderr, "kernel_launch: hipFuncSetAttribute failed\n"); grid = -1; return; }
        int per_cu = 0;
        if (hipOccupancyMaxActiveBlocksPerMultiprocessor(&per_cu, (const void*)fwd_kernel, 512, LDS_BYTES) != hipSuccess || per_cu < 1) fprintf(stderr, "kernel_launch: occupancy query says %d\n", per_cu);
        (void)hipGetLastError();
        grid = cus;
        if (grid < 16) { fprintf(stderr, "kernel_launch: needs >= 16 CUs\n"); grid = -1; return; }
    }
    if (grid < 0) return;
    (void)hipMemsetAsync((char*)d_ws + WS_CTL, 0, CTL_ZERO_BYTES, stream);
    Args a{};
    a.x = (const float*)d_in[0]; a.mem = (const float*)d_in[1]; a.pos = (const int*)d_in[2]; a.g_mem = (const float*)d_in[3]; a.w_mem_kv = (const float*)d_in[4];
    a.g_mix_pre = (const float*)d_in[5]; a.g_mix_post = (const float*)d_in[6]; a.g_ffn_pre = (const float*)d_in[7]; a.g_ffn_post = (const float*)d_in[8];
    a.w_conv_in = (const float*)d_in[9]; a.conv_mix_w = (const float*)d_in[10]; a.w_conv_out = (const float*)d_in[11]; a.w_attn_in = (const float*)d_in[12]; a.w_attn_out = (const float*)d_in[13];
    a.w_ffn_gate = (const float*)d_in[14]; a.w_ffn_up = (const float*)d_in[15]; a.conv_ffn_w = (const float*)d_in[16]; a.w_ffn_down = (const float*)d_in[17];
    a.out = (float*)d_out; a.ws = (unsigned char*)d_ws;
#if ONE_LAUNCH
    a.ph_lo = 0; a.ph_hi = NPHASE;
    hipLaunchKernelGGL(fwd_kernel, dim3(grid), dim3(512), LDS_BYTES, stream, a);
#else
    for (int p = 0; p < NPHASE; ++p) { a.ph_lo = p; a.ph_hi = p + 1; hipLaunchKernelGGL(fwd_kernel, dim3(grid), dim3(512), LDS_BYTES, stream, a); }
#endif
}
```

```cpp
#include <hip/hip_runtime.h>
#include <cstdio>
#include <cstdint>

#define LAS __attribute__((address_space(3)))
#define GAS __attribute__((address_space(1)))
typedef unsigned short bf16_t;
typedef short bf16x8 __attribute__((ext_vector_type(8)));
typedef short s16x4 __attribute__((ext_vector_type(4)));
typedef float f32x4 __attribute__((ext_vector_type(4)));
typedef unsigned u32x4 __attribute__((ext_vector_type(4)));
typedef unsigned u32x2 __attribute__((ext_vector_type(2)));

constexpr int SEQ = 8192, DM = 4096, DFF = 11008, CW = 3072, MW = 1024, GW = 2048, NMEM = 256, NHEAD = 16, HDIM = 128;
constexpr int N_CI = 3 * CW + MW;
constexpr int N_AI = 9 * GW + MW;
constexpr int N_GU = 2 * DFF;
constexpr int K_CO = CW + MW;
constexpr int K_AO = GW + MW;
constexpr float EPS = 1e-6f;

#ifndef ONE_LAUNCH
#define ONE_LAUNCH 1
#endif
constexpr int NPHASE = 19;

constexpr size_t MiB = 1u << 20;
constexpr size_t WS_CTL = 0, CTL_ZERO_BYTES = 1 * MiB;
constexpr size_t WS_WKV = 1 * MiB;
constexpr size_t WS_WCI = WS_WKV + 16 * MiB;
constexpr size_t WS_WCO = WS_WCI + 80 * MiB;
constexpr size_t WS_WAI = WS_WCO + 32 * MiB;
constexpr size_t WS_WAO = WS_WAI + 152 * MiB;
constexpr size_t WS_WGU = WS_WAO + 24 * MiB;
constexpr size_t WS_WD  = WS_WGU + 2 * 172 * MiB;
constexpr size_t WS_XN  = WS_WD + 2 * 86 * MiB;
constexpr size_t WS_R   = WS_XN + 64 * MiB;
constexpr size_t WS_S   = WS_R + 344 * MiB;
constexpr size_t WS_MEMN = WS_S + 172 * MiB;
constexpr size_t WS_KV  = WS_MEMN + 2 * MiB;
constexpr size_t WS_COS = WS_KV + 1 * MiB;
constexpr size_t WS_SIN = WS_COS + 2 * MiB;
constexpr size_t WS_LSE = WS_SIN + 2 * MiB;
constexpr size_t WS_HALOG = WS_LSE + 2 * MiB;
constexpr size_t WS_FIRSTG = WS_HALOG + 3 * MiB;
constexpr size_t WS_FIRSTU = WS_FIRSTG + 3 * MiB;
constexpr size_t WS_END = WS_FIRSTU + 3 * MiB;
constexpr int CW_BAR = 4096;

constexpr int RING_BYTES = 131072;
constexpr int LDSCTL_OFF = 146432;
constexpr int LDS_BYTES = 147456;

__device__ __forceinline__ unsigned cvt_pk_bf16(float lo, float hi) { unsigned r; asm("v_cvt_pk_bf16_f32 %0, %1, %2" : "=v"(r) : "v"(lo), "v"(hi)); return r; }
__device__ __forceinline__ float bf_lo(unsigned w) { return __uint_as_float(w << 16); }
__device__ __forceinline__ float bf_hi(unsigned w) { return __uint_as_float(w & 0xffff0000u); }
__device__ __forceinline__ int fresh_lane() { int l; asm volatile("v_mbcnt_lo_u32_b32 %0, -1, 0\n\tv_mbcnt_hi_u32_b32 %0, -1, %0" : "=v"(l)); return l; }
__device__ __forceinline__ int fresh_tid() { int t = threadIdx.x; asm volatile("" : "+v"(t)); return t; }
__device__ __forceinline__ float wave_sum(float v) {
#pragma unroll
    for (int o = 1; o < 64; o <<= 1) v += __shfl_xor(v, o);
    return v;
}

__constant__ float INV_FREQ[64] = {
1.000000000e+00f, 8.659643531e-01f, 7.498942018e-01f, 6.493816376e-01f, 5.623413324e-01f, 4.869675338e-01f, 4.216965139e-01f, 3.651741147e-01f, 3.162277639e-01f, 2.738419771e-01f, 2.371373773e-01f, 2.053525001e-01f, 1.778279394e-01f, 1.539926529e-01f, 1.333521456e-01f, 1.154781953e-01f,
1.000000015e-01f, 8.659642935e-02f, 7.498942316e-02f, 6.493816525e-02f, 5.623413250e-02f, 4.869675264e-02f, 4.216964915e-02f, 3.651741147e-02f, 3.162277490e-02f, 2.738419548e-02f, 2.371373773e-02f, 2.053525113e-02f, 1.778279431e-02f, 1.539926510e-02f, 1.333521400e-02f, 1.154781971e-02f,
9.999999776e-03f, 8.659643121e-03f, 7.498942316e-03f, 6.493816152e-03f, 5.623413250e-03f, 4.869675264e-03f, 4.216964822e-03f, 3.651741194e-03f, 3.162277630e-03f, 2.738419687e-03f, 2.371373819e-03f, 2.053525066e-03f, 1.778279431e-03f, 1.539926510e-03f, 1.333521446e-03f, 1.154782018e-03f,
1.000000047e-03f, 8.659643354e-04f, 7.498941850e-04f, 6.493816036e-04f, 5.623413017e-04f, 4.869675322e-04f, 4.216965172e-04f, 3.651741135e-04f, 3.162277571e-04f, 2.738419571e-04f, 2.371373703e-04f, 2.053525095e-04f, 1.778279402e-04f, 1.539926598e-04f, 1.333521504e-04f, 1.154782003e-04f };

namespace pg8 {
constexpr int BM = 256, BK = 64, HALF = 128, HTB = HALF * BK * 2, STAGE_BYTES = 8 * HTB, NXCD = 8, WGM = 8;
__host__ __device__ __forceinline__ int lds_byte(int r, int c) { const int st = (r >> 4) * 2 + (c >> 5), rr = r & 15, cc = c & 31, ob = rr * 64 + cc * 2; return st * 1024 + (ob ^ (((ob >> 9) & 1) << 5)); }
__host__ __device__ __forceinline__ void stage_rc(int b, int& R, int& C) { const int st = b / 1024, sb = b % 1024, swz = sb ^ (((sb >> 9) & 1) << 5); R = (st >> 1) * 16 + swz / 64; C = (st & 1) * 32 + (swz % 64) / 2; }
__host__ __device__ __forceinline__ int perm32(int rho) { const int n = rho >> 4, i = rho & 15; return 8 * (i >> 2) + 4 * n + (i & 3); }

struct Unit { int pm, pn; };
struct SameTileOrder { int n;
    __device__ bool next(int i, Unit& u) const { if (i >= n) return false; u.pm = 0; u.pn = 0; return true; }
    __device__ __forceinline__ void a_ready(const Unit&) const {}
    __device__ __forceinline__ void done(const Unit&) const {} };
struct Gemm { const bf16_t* A; const bf16_t* Bt; int K, lda, ldb; };

struct StaticOrder {
    int nM, nN, nwg, G, c;
    __host__ __device__ void init(int M, int N, int G_, int c_) { nM = M / BM; nN = N / BM; nwg = nM * nN; G = G_; c = c_; }
    __host__ __device__ bool next(int i, Unit& u) const {
        const long L = (long)i * G + c; if (L >= nwg) return false;
        int wgid = (int)L; { const int q = nwg / NXCD, r = nwg % NXCD, xcd = wgid % NXCD, off = wgid / NXCD; wgid = (xcd < r ? xcd * (q + 1) : r * (q + 1) + (xcd - r) * q) + off; }
        const int nig = WGM * nN, gid = wgid / nig, fm = gid * WGM, gsz = (nM - fm) < WGM ? (nM - fm) : WGM;
        u.pm = fm + ((wgid % nig) % gsz); u.pn = (wgid % nig) / gsz; return true;
    }
    __device__ __forceinline__ void a_ready(const Unit&) const {}
    __device__ __forceinline__ void done(const Unit&) const {}
};

struct EpiStore {
    static constexpr bool PERM = true, AFTER_DRAIN = false;
    bf16_t* O; int ldc;
    __device__ __forceinline__ void operator()(const f32x4 (&acc)[2][2][4][2], const Unit& u, int wr, int wc, int fr, int fq) const {
        const int row0 = u.pm * BM + wr * 64 + fr, col0 = u.pn * BM + wc * 32 + 8 * fq;
#pragma unroll
        for (int ai = 0; ai < 2; ++ai)
#pragma unroll
            for (int m = 0; m < 4; ++m) { bf16_t* rowp = O + (size_t)(row0 + ai * HALF + m * 16) * ldc + col0;
#pragma unroll
                for (int bj = 0; bj < 2; ++bj) { const f32x4 v0 = acc[ai][bj][m][0], v1 = acc[ai][bj][m][1];
                    u32x4 w; w.x = cvt_pk_bf16(v0[0], v0[1]); w.y = cvt_pk_bf16(v0[2], v0[3]); w.z = cvt_pk_bf16(v1[0], v1[1]); w.w = cvt_pk_bf16(v1[2], v1[3]);
                    *(u32x4*)(rowp + bj * HALF) = w; } }
    }
};
struct EpiRope {
    static constexpr bool PERM = true, AFTER_DRAIN = false;
    bf16_t* O; int ldc; const float* cosT; const float* sinT;
    __device__ __forceinline__ void operator()(const f32x4 (&acc)[2][2][4][2], const Unit& u, int wr, int wc, int fr, int fq) const {
        const int colt = u.pn * BM;
        const bool isqk = (colt < 9 * GW) && ((colt % (3 * GW)) < 2 * GW);
        const int row0 = u.pm * BM + wr * 64 + fr;
        if (!isqk) {
            const int col0 = colt + wc * 32 + 8 * fq;
#pragma unroll
            for (int ai = 0; ai < 2; ++ai)
#pragma unroll
                for (int m = 0; m < 4; ++m) { bf16_t* rowp = O + (size_t)(row0 + ai * HALF + m * 16) * ldc + col0;
#pragma unroll
                    for (int bj = 0; bj < 2; ++bj) { const f32x4 v0 = acc[ai][bj][m][0], v1 = acc[ai][bj][m][1];
                        u32x4 w; w.x = cvt_pk_bf16(v0[0], v0[1]); w.y = cvt_pk_bf16(v0[2], v0[3]); w.z = cvt_pk_bf16(v1[0], v1[1]); w.w = cvt_pk_bf16(v1[2], v1[3]);
                        *(u32x4*)(rowp + bj * HALF) = w; } }
        } else {
            const int x0 = wc * 32 + 8 * fq, hh = x0 >> 6, d0 = x0 & 63;
#pragma unroll
            for (int ai = 0; ai < 2; ++ai)
#pragma unroll
                for (int m = 0; m < 4; ++m) { const int row = row0 + ai * HALF + m * 16;
                    const f32x4 c0 = *(const f32x4*)(cosT + (size_t)row * 64 + d0), c1 = *(const f32x4*)(cosT + (size_t)row * 64 + d0 + 4);
                    const f32x4 s0 = *(const f32x4*)(sinT + (size_t)row * 64 + d0), s1 = *(const f32x4*)(sinT + (size_t)row * 64 + d0 + 4);
                    const f32x4 a0 = acc[ai][0][m][0], a1 = acc[ai][0][m][1], b0 = acc[ai][1][m][0], b1 = acc[ai][1][m][1];
                    const f32x4 o10 = a0 * c0 - b0 * s0, o11 = a1 * c1 - b1 * s1, o20 = b0 * c0 + a0 * s0, o21 = b1 * c1 + a1 * s1;
                    bf16_t* rowp = O + (size_t)row * ldc + colt + 128 * hh + d0;
                    u32x4 w; w.x = cvt_pk_bf16(o10[0], o10[1]); w.y = cvt_pk_bf16(o10[2], o10[3]); w.z = cvt_pk_bf16(o11[0], o11[1]); w.w = cvt_pk_bf16(o11[2], o11[3]);
                    *(u32x4*)(rowp) = w;
                    w.x = cvt_pk_bf16(o20[0], o20[1]); w.y = cvt_pk_bf16(o20[2], o20[3]); w.z = cvt_pk_bf16(o21[0], o21[1]); w.w = cvt_pk_bf16(o21[2], o21[3]);
                    *(u32x4*)(rowp + 64) = w;
                    asm volatile("" ::: "memory"); }
        }
    }
};


__device__ __forceinline__ float dpp_ror1(float v) { return __builtin_bit_cast(float, __builtin_amdgcn_update_dpp(0, __builtin_bit_cast(int, v), 0x121, 0xf, 0xf, false)); }
__device__ __forceinline__ float dpp_ror2(float v) { return __builtin_bit_cast(float, __builtin_amdgcn_update_dpp(0, __builtin_bit_cast(int, v), 0x122, 0xf, 0xf, false)); }
struct EpiFfn {
    static constexpr bool PERM = true, AFTER_DRAIN = false;
    bf16_t* ACT; const float* cw; float* HALOG; float* FIRSTG; float* FIRSTU; LAS unsigned char* xl;
    __device__ __forceinline__ void operator()(const f32x4 (&acc)[2][2][4][2], const Unit& u, int wr, int wc, int fr, int fq) const {
        const int ch0 = u.pn * 128 + wc * 32 + 8 * fq;
        LAS f32x4* hl = (LAS f32x4*)xl;
        if (fr >= 14) {
#pragma unroll
            for (int ai = 0; ai < 2; ++ai) { const int idx = ((((ai * 2 + wr) * 4 + wc) * 2 + (fr - 14)) * 4 + fq) * 2; hl[idx] = acc[ai][0][3][0]; hl[idx + 1] = acc[ai][0][3][1]; }
        }
        float w0[8], w1[8], w2[8];
        { const f32x4 a0 = *(const f32x4*)(cw + ch0), a1 = *(const f32x4*)(cw + ch0 + 4), b0 = *(const f32x4*)(cw + DFF + ch0), b1 = *(const f32x4*)(cw + DFF + ch0 + 4), c0 = *(const f32x4*)(cw + 2 * DFF + ch0), c1 = *(const f32x4*)(cw + 2 * DFF + ch0 + 4);
#pragma unroll
          for (int i = 0; i < 4; ++i) { w0[i] = a0[i]; w0[4 + i] = a1[i]; w1[i] = b0[i]; w1[4 + i] = b1[i]; w2[i] = c0[i]; w2[4 + i] = c1[i]; } }
        asm volatile("s_waitcnt lgkmcnt(0)" ::: "memory"); __builtin_amdgcn_s_barrier(); asm volatile("" ::: "memory");
#pragma unroll
        for (int ai = 0; ai < 2; ++ai) {
            const bool ext = (wr == 0 && ai == 0);
            float x14[8], x15[8];
            if (ext) {
#pragma unroll
                for (int i = 0; i < 8; ++i) { x14[i] = 0.f; x15[i] = 0.f; }
            } else {
                const int sai = (wr == 1) ? ai : 0, swr = (wr == 1) ? 0 : 1;
                const int b = ((((sai * 2 + swr) * 4 + wc) * 2) * 4 + fq) * 2;
                const f32x4 p0 = hl[b], p1 = hl[b + 1], q0 = hl[b + 8], q1 = hl[b + 9];
#pragma unroll
                for (int i = 0; i < 4; ++i) { x14[i] = p0[i]; x14[4 + i] = p1[i]; x15[i] = q0[i]; x15[4 + i] = q1[i]; }
            }
            float r1p[8], r2p[8];
#pragma unroll
            for (int i = 0; i < 8; ++i) { r1p[i] = x15[i]; r2p[i] = (fr == 0) ? x14[i] : x15[i]; }
#pragma unroll
            for (int m = 0; m < 4; ++m) {
                float cur[8], up[8], o[8];
#pragma unroll
                for (int i = 0; i < 4; ++i) { cur[i] = acc[ai][0][m][0][i]; cur[4 + i] = acc[ai][0][m][1][i]; up[i] = acc[ai][1][m][0][i]; up[4 + i] = acc[ai][1][m][1][i]; }
                const int row = u.pm * BM + ai * HALF + wr * 64 + m * 16 + fr;
#pragma unroll
                for (int i = 0; i < 8; ++i) {
                    const float r1 = dpp_ror1(cur[i]), r2 = dpp_ror2(cur[i]);
                    const float p1 = (fr >= 1) ? r1 : r1p[i], p2 = (fr >= 2) ? r2 : r2p[i];
                    const float g = w0[i] * p2 + w1[i] * p1 + w2[i] * cur[i];
                    o[i] = g / (1.0f + __expf(-g)) * up[i];
                    r1p[i] = r1; r2p[i] = r2;
                }
                const bool first2 = ext && m == 0 && fr < 2 && u.pm > 0;
                if (!first2) {
                    u32x4 w; w.x = cvt_pk_bf16(o[0], o[1]); w.y = cvt_pk_bf16(o[2], o[3]); w.z = cvt_pk_bf16(o[4], o[5]); w.w = cvt_pk_bf16(o[6], o[7]);
                    *(u32x4*)(ACT + (size_t)row * DFF + ch0) = w;
                } else {
                    float* fg = FIRSTG + (size_t)(u.pm * 2 + fr) * DFF + ch0; float* fu = FIRSTU + (size_t)(u.pm * 2 + fr) * DFF + ch0;
                    *(f32x4*)fg = acc[ai][0][m][0]; *(f32x4*)(fg + 4) = acc[ai][0][m][1]; *(f32x4*)fu = acc[ai][1][m][0]; *(f32x4*)(fu + 4) = acc[ai][1][m][1];
                }
                if (ai == 1 && wr == 1 && m == 3 && fr >= 14) { float* hg = HALOG + (size_t)(u.pm * 2 + fr - 14) * DFF + ch0; *(f32x4*)hg = acc[ai][0][m][0]; *(f32x4*)(hg + 4) = acc[ai][0][m][1]; }
            }
        }
    }
};

template <class Epi, class Sched, bool ALIGN_EPI>
__device__ __forceinline__ void gemm_phase(LAS unsigned char* lds, const Gemm g, const Sched& S, const Epi& E) {
    const int tid = fresh_tid(), wid = __builtin_amdgcn_readfirstlane(tid >> 6), lane = tid & 63, wr = wid >> 2, wc = wid & 3, fr = lane & 15, fq = lane >> 4;
    const int K = g.K, nt = K / BK;
    unsigned voffA[2], voffB[2];
#pragma unroll
    for (int i = 0; i < 2; ++i) { int R, C; stage_rc(tid * 16 + i * 8192, R, C); const int Rb = Epi::PERM ? ((R & ~31) + perm32(R & 31)) : R;
        voffA[i] = (unsigned)(R * g.lda + C) * 2u; voffB[i] = (unsigned)(Rb * g.ldb + C) * 2u; }
    const size_t kstep = (size_t)(BK * 2);
    const size_t hstepA = (size_t)HALF * g.lda * 2, hstepB = (size_t)HALF * g.ldb * 2;
    const size_t tstepA = 2 * hstepA, tstepB = 2 * hstepB;
    const unsigned ldsw = (unsigned)wid * 1024u;
    const int aoff = lds_byte(wr * 64 + fr, fq * 8), boff = lds_byte(wc * 32 + fr, fq * 8);
#define PG8_SA(b, h) (((b) * 2 + (h)) * HTB)
#define PG8_SB(b, h) ((4 + (b) * 2 + (h)) * HTB)
#define PG8_STAGE(bufoff, gbase, voff) do { _Pragma("unroll") for (int _i = 0; _i < 2; ++_i) \
        __builtin_amdgcn_global_load_lds((const unsigned*)((const char*)(gbase) + (voff)[_i]), (LAS unsigned*)(lds + (bufoff) + ldsw + _i * 8192), 16, 0, 0); } while (0)
#define PG8_LDA(dst, b, h) do { _Pragma("unroll") for (int m = 0; m < 4; ++m) _Pragma("unroll") for (int k = 0; k < 2; ++k) dst[m][k] = *(const LAS bf16x8*)(lds + PG8_SA(b, h) + aoff + m * 2048 + k * 1024); } while (0)
#define PG8_LDB(dst, b, h) do { _Pragma("unroll") for (int n = 0; n < 2; ++n) _Pragma("unroll") for (int k = 0; k < 2; ++k) dst[n][k] = *(const LAS bf16x8*)(lds + PG8_SB(b, h) + boff + n * 2048 + k * 1024); } while (0)
#define PG8_MMA(ai, bj, At, Bt) do { __builtin_amdgcn_s_setprio(1); _Pragma("unroll") for (int m = 0; m < 4; ++m) _Pragma("unroll") for (int n = 0; n < 2; ++n) _Pragma("unroll") for (int k = 0; k < 2; ++k) \
        acc[ai][bj][m][n] = __builtin_amdgcn_mfma_f32_16x16x32_bf16(Bt[n][k], At[m][k], acc[ai][bj][m][n], 0, 0, 0); __builtin_amdgcn_s_setprio(0); } while (0)
#define PG8_WAIT_V(n) asm volatile("s_waitcnt vmcnt(" #n ")" ::: "memory")
#define PG8_WAIT_L(n) asm volatile("s_waitcnt lgkmcnt(" #n ")" ::: "memory")
#define PG8_BAR __builtin_amdgcn_s_barrier()
#define PG8_SCHED __builtin_amdgcn_sched_barrier(0)
    Unit cur, nxt; int ui = 0;
    if (!S.next(0, cur)) return;
    f32x4 acc[2][2][4][2];
#pragma unroll
    for (int a = 0; a < 2; ++a)
#pragma unroll
        for (int b = 0; b < 2; ++b)
#pragma unroll
            for (int m = 0; m < 4; ++m)
#pragma unroll
                for (int n = 0; n < 2; ++n) acc[a][b][m][n] = (f32x4){0.f, 0.f, 0.f, 0.f};
    bf16x8 At[4][2], B0[2][2], B1[2][2];
    const char* cA = (const char*)g.A + (size_t)cur.pm * tstepA; const char* cB = (const char*)g.Bt + (size_t)cur.pn * tstepB;
    S.a_ready(cur);
    PG8_STAGE(PG8_SB(0, 0), cB, voffB); PG8_STAGE(PG8_SB(0, 1), cB + hstepB, voffB); PG8_STAGE(PG8_SA(0, 0), cA, voffA); PG8_STAGE(PG8_SA(0, 1), cA + hstepA, voffA);
    if (wr == 1) PG8_BAR;
    PG8_WAIT_V(2); PG8_BAR;
    PG8_STAGE(PG8_SB(1, 0), cB + kstep, voffB); PG8_STAGE(PG8_SA(1, 0), cA + kstep, voffA); PG8_STAGE(PG8_SB(1, 1), cB + hstepB + kstep, voffB);
    PG8_WAIT_V(6); PG8_BAR;
    for (;;) {
        const bool has_next = S.next(ui + 1, nxt);
        const char* nA = has_next ? (const char*)g.A + (size_t)nxt.pm * tstepA : cA; const char* nB = has_next ? (const char*)g.Bt + (size_t)nxt.pn * tstepB : cB;
        for (int t = 0; t < nt; t += 2) {
            const bool last = (t == nt - 2);
            const char* a1 = cA + (size_t)(t + 1) * kstep;
            const char* a2 = last ? nA : cA + (size_t)(t + 2) * kstep; const char* b2 = last ? nB : cB + (size_t)(t + 2) * kstep;
            const char* a3 = a2 + kstep; const char* b3 = b2 + kstep;
            if (last && has_next) S.a_ready(nxt);
            PG8_LDB(B0, 0, 0); PG8_LDB(B1, 0, 1); PG8_SCHED; PG8_LDA(At, 0, 0); PG8_STAGE(PG8_SA(1, 1), a1 + hstepA, voffA);
            PG8_WAIT_V(8); PG8_WAIT_L(0); PG8_BAR; PG8_MMA(0, 0, At, B0); PG8_MMA(0, 1, At, B1); PG8_BAR; PG8_SCHED;
            PG8_LDA(At, 0, 1); PG8_STAGE(PG8_SB(0, 0), b2, voffB); PG8_STAGE(PG8_SB(0, 1), b2 + hstepB, voffB); PG8_STAGE(PG8_SA(0, 0), a2, voffA);
            PG8_WAIT_V(8); PG8_WAIT_L(0); PG8_BAR; PG8_MMA(1, 0, At, B0); PG8_MMA(1, 1, At, B1); PG8_BAR; PG8_SCHED;
            PG8_LDB(B0, 1, 0); PG8_LDB(B1, 1, 1); PG8_SCHED; PG8_LDA(At, 1, 0); PG8_STAGE(PG8_SA(0, 1), a2 + hstepA, voffA);
            PG8_WAIT_V(8); PG8_WAIT_L(0); PG8_BAR; PG8_MMA(0, 0, At, B0); PG8_MMA(0, 1, At, B1); PG8_BAR; PG8_SCHED;
            PG8_LDA(At, 1, 1); PG8_STAGE(PG8_SB(1, 0), b3, voffB); PG8_STAGE(PG8_SB(1, 1), b3 + hstepB, voffB); PG8_STAGE(PG8_SA(1, 0), a3, voffA);
            PG8_WAIT_V(8); PG8_WAIT_L(0); PG8_BAR; PG8_MMA(1, 0, At, B0); PG8_MMA(1, 1, At, B1); PG8_BAR; PG8_SCHED;
        }
        if constexpr (ALIGN_EPI) { if (wr == 0) PG8_BAR; }
        E(acc, cur, wr, wc, fr, fq); S.done(cur);
        if (!has_next) break;
#pragma unroll
        for (int a = 0; a < 2; ++a)
#pragma unroll
            for (int b = 0; b < 2; ++b)
#pragma unroll
                for (int m = 0; m < 4; ++m)
#pragma unroll
                    for (int n = 0; n < 2; ++n) acc[a][b][m][n] = (f32x4){0.f, 0.f, 0.f, 0.f};
        cur = nxt; cA = nA; cB = nB; ++ui;
        if constexpr (ALIGN_EPI) { if (wr == 1) PG8_BAR; }
    }
    PG8_WAIT_V(0);
    if constexpr (!ALIGN_EPI) { if (wr == 0) PG8_BAR; }
    PG8_BAR;
#undef PG8_SA
#undef PG8_SB
#undef PG8_STAGE
#undef PG8_LDA
#undef PG8_LDB
#undef PG8_MMA
#undef PG8_WAIT_V
#undef PG8_WAIT_L
#undef PG8_BAR
#undef PG8_SCHED
}
}

#define XB_TMO      128
#define XB_XCNT(j)  (256  + 64 * (j))
#define XB_XSUB(j)  (1280 + 64 * (j))
#define XB_XGEN(j)  (2304 + 64 * (j))
#define XB_TOP      3328
#define XB_TOPGEN   3392
#define XCD_BAR_WORDS 3456
#define XB_SPIN_CAP (1u << 18)
__device__ __forceinline__ unsigned xb_ld(unsigned* p)              { return __hip_atomic_load(p, __ATOMIC_RELAXED, __HIP_MEMORY_SCOPE_AGENT); }
__device__ __forceinline__ unsigned xb_add(unsigned* p, unsigned v) { return __hip_atomic_fetch_add(p, v, __ATOMIC_RELAXED, __HIP_MEMORY_SCOPE_AGENT); }
__device__ __forceinline__ unsigned xb_xcc_id() { return (unsigned)__builtin_amdgcn_s_getreg((3 << 11) | 20) & 0xFu; }
#define XB_SPIN(cond, bar) do { unsigned _sp = 0; while (cond) { __builtin_amdgcn_s_sleep(1); \
    if ((++_sp & 255u) == 0u) { if (xb_ld(&(bar)[XB_TMO])) break; if (_sp > XB_SPIN_CAP) { atomicAdd(&(bar)[XB_TMO], 1u); break; } } } } while (0)
struct XcdBarrier { unsigned* bar; unsigned x; volatile LAS unsigned* st; };
__device__ __forceinline__ XcdBarrier xcd_barrier_post(unsigned* bar, volatile LAS unsigned* st) {
    XcdBarrier b; b.bar = bar; b.x = xb_xcc_id(); b.st = st;
    if (threadIdx.x == 0) (void)xb_add(&bar[XB_XCNT(b.x)], 1u);
    return b;
}
__device__ __forceinline__ void xcd_barrier_complete(unsigned* bar, unsigned x, unsigned& nloc, unsigned& nx) {
    const unsigned G = gridDim.x * gridDim.y * gridDim.z;
    unsigned sum, cnt, mine, sp = 0u;
    for (;;) {
        sum = 0u; cnt = 0u; mine = 0u;
#pragma unroll
        for (unsigned j = 0; j < 16; ++j) { const unsigned c = xb_ld(&bar[XB_XCNT(j)]); sum += c; cnt += (c > 0u) ? 1u : 0u; mine = (j == x) ? c : mine; }
        if (sum == G) break;
        __builtin_amdgcn_s_sleep(1);
        if ((++sp & 255u) == 0u) { if (xb_ld(&bar[XB_TMO])) break; if (sp > XB_SPIN_CAP) { atomicAdd(&bar[XB_TMO], 1u); break; } }
    }
    nloc = mine > 0u ? mine : 1u; nx = cnt > 0u ? cnt : 1u;
}
__device__ __forceinline__ void xcd_barrier(const XcdBarrier& b) {
    asm volatile("s_waitcnt vmcnt(0)" ::: "memory");
    __syncthreads();
    if (threadIdx.x == 0) {
        unsigned* bar = b.bar;
        __builtin_amdgcn_s_waitcnt(0);
        unsigned nloc = b.st[0], nx = b.st[1];
        if (nloc == 0u) { xcd_barrier_complete(bar, b.x, nloc, nx); b.st[0] = nloc; b.st[1] = nx; }
        const unsigned old = xb_add(&bar[XB_XSUB(b.x)], 1u);
        const unsigned gen = old / nloc;
        if (old + 1u == (gen + 1u) * nloc) {
            __builtin_amdgcn_fence(__ATOMIC_RELEASE, "agent");
            asm volatile("s_waitcnt vmcnt(0)" ::: "memory");
            const unsigned og = xb_add(&bar[XB_TOP], 1u);
            const unsigned tg = og / nx;
            if (og + 1u == (tg + 1u) * nx) xb_add(&bar[XB_TOPGEN], 1u);
            else XB_SPIN(xb_ld(&bar[XB_TOPGEN]) == tg, bar);
            __builtin_amdgcn_fence(__ATOMIC_ACQUIRE, "agent");
            xb_add(&bar[XB_XGEN(b.x)], 1u);
            asm volatile("s_waitcnt vmcnt(0)" ::: "memory");
        } else {
            XB_SPIN(xb_ld(&bar[XB_XGEN(b.x)]) == gen, bar);
            __builtin_amdgcn_fence(__ATOMIC_ACQUIRE, "agent");
            asm volatile("s_waitcnt vmcnt(0)" ::: "memory");
        }
    }
    __syncthreads();
}

template <int MODE  >
__device__ __forceinline__ void cvt_matrix(const float* W, int K, int N, bf16_t* WT, int row_off, LAS float* scr, int gw, int ngw, int) {
    const int lane = fresh_lane();
    const int nblk = N / 32, nitems = (K / 64) * nblk;
    for (int item = gw; item < nitems; item += ngw) {
        const int kb = item / nblk, nb = item % nblk, k0 = 64 * kb, n0 = 32 * nb;
#pragma unroll 8
        for (int i = 0; i < 32; ++i) { const int kk = 2 * i + (lane >> 5); scr[kk * 33 + (lane & 31)] = W[(size_t)(k0 + kk) * N + n0 + (lane & 31)]; }
        asm volatile("s_waitcnt lgkmcnt(0)" ::: "memory");
        int d0 = n0;
        if (MODE == 1) { if (n0 < 9 * GW && (n0 % (3 * GW)) < 2 * GW) d0 = (n0 & ~0xC0) | ((n0 & 0x40) << 1) | ((n0 & 0x80) >> 1); }
        if (MODE == 2) d0 = (n0 >> 7) * 256 + (n0 & 127);
        if (MODE == 3) d0 = (n0 >> 7) * 256 + 128 + (n0 & 127);
        const int c = lane & 7;
#pragma unroll
        for (int j = 0; j < 4; ++j) { const int n = (lane >> 3) + 8 * j; const LAS float* s = scr + (8 * c) * 33 + n;
            u32x4 o; o.x = cvt_pk_bf16(s[0 * 33], s[1 * 33]); o.y = cvt_pk_bf16(s[2 * 33], s[3 * 33]); o.z = cvt_pk_bf16(s[4 * 33], s[5 * 33]); o.w = cvt_pk_bf16(s[6 * 33], s[7 * 33]);
            *(u32x4*)(WT + (size_t)(row_off + d0 + n) * K + k0 + 8 * c) = o; }
        asm volatile("s_waitcnt lgkmcnt(0)" ::: "memory");
    }
}
__device__ __forceinline__ void rms_row_to_bf16(const float* xrow, const float* g, bf16_t* orow, int) {
    const int lane = fresh_lane();
    const f32x4* xr = (const f32x4*)xrow + lane;
    f32x4 v[16]; float s = 0.f;
#pragma unroll
    for (int j = 0; j < 16; ++j) { v[j] = xr[64 * j]; s += (v[j].x * v[j].x + v[j].y * v[j].y) + (v[j].z * v[j].z + v[j].w * v[j].w); }
    const float rstd = 1.0f / sqrtf(wave_sum(s) * (1.f / DM) + EPS);
    const f32x4* gr = (const f32x4*)g + lane; u32x2* o8 = (u32x2*)orow + lane;
#pragma unroll
    for (int j = 0; j < 16; ++j) { const f32x4 gv = gr[64 * j]; u32x2 w; w.x = cvt_pk_bf16(v[j].x * rstd * gv.x, v[j].y * rstd * gv.y); w.y = cvt_pk_bf16(v[j].z * rstd * gv.z, v[j].w * rstd * gv.w); o8[64 * j] = w; }
}
__device__ __forceinline__ void norm_res_row(const float* xsrc, const bf16_t* yrow, const float* gpost, const float* gpre, float* xout, bf16_t* xn, int) {
    const int lane = fresh_lane();
    const u32x2* yr = (const u32x2*)yrow + lane; f32x4 y[16]; float s = 0.f;
#pragma unroll
    for (int j = 0; j < 16; ++j) { const u32x2 w = yr[64 * j]; y[j] = (f32x4){bf_lo(w.x), bf_hi(w.x), bf_lo(w.y), bf_hi(w.y)}; s += (y[j].x * y[j].x + y[j].y * y[j].y) + (y[j].z * y[j].z + y[j].w * y[j].w); }
    const float rstd = 1.0f / sqrtf(wave_sum(s) * (1.f / DM) + EPS);
    const f32x4* xr = (const f32x4*)xsrc + lane; const f32x4* gp = (const f32x4*)gpost + lane; f32x4* xo = (f32x4*)xout + lane; float s2 = 0.f;
#pragma unroll
    for (int j = 0; j < 16; ++j) { const f32x4 xv = xr[64 * j], gv = gp[64 * j]; y[j] = xv + y[j] * rstd * gv; xo[64 * j] = y[j]; s2 += (y[j].x * y[j].x + y[j].y * y[j].y) + (y[j].z * y[j].z + y[j].w * y[j].w); }
    if (xn) {
        const float rstd2 = 1.0f / sqrtf(wave_sum(s2) * (1.f / DM) + EPS);
        const f32x4* gr = (const f32x4*)gpre + lane; u32x2* o8 = (u32x2*)xn + lane;
#pragma unroll
        for (int j = 0; j < 16; ++j) { const f32x4 gv = gr[64 * j]; u32x2 w; w.x = cvt_pk_bf16(y[j].x * rstd2 * gv.x, y[j].y * rstd2 * gv.y); w.y = cvt_pk_bf16(y[j].z * rstd2 * gv.z, y[j].w * rstd2 * gv.w); o8[64 * j] = w; }
    }
}
__device__ __forceinline__ void unpack8(const u32x4 w, float (&f)[8]) { f[0] = bf_lo(w.x); f[1] = bf_hi(w.x); f[2] = bf_lo(w.y); f[3] = bf_hi(w.y); f[4] = bf_lo(w.z); f[5] = bf_hi(w.z); f[6] = bf_lo(w.w); f[7] = bf_hi(w.w); }
__device__ __forceinline__ u32x4 pack8f(const float (&f)[8]) { u32x4 w; w.x = cvt_pk_bf16(f[0], f[1]); w.y = cvt_pk_bf16(f[2], f[3]); w.z = cvt_pk_bf16(f[4], f[5]); w.w = cvt_pk_bf16(f[6], f[7]); return w; }

__device__ __forceinline__ void conv_gate_phase(const bf16_t* H, const float* cw  , bf16_t* A2  , int gtid, int nthreads) {
    constexpr int RB = 32, NCG = CW / 8, NIT = (SEQ / RB) * NCG;
    asm volatile("" : "+v"(gtid));
    for (int it = gtid; it < NIT; it += nthreads) {
        const int cg = it % NCG, rb = it / NCG, c0 = cg * 8, t0 = rb * RB;
        float w0[8], w1[8], w2[8], m2[8], m1[8];
#pragma unroll
        for (int i = 0; i < 8; ++i) { w0[i] = cw[c0 + i]; w1[i] = cw[CW + c0 + i]; w2[i] = cw[2 * CW + c0 + i]; m2[i] = 0.f; m1[i] = 0.f; }
        if (t0 >= 2) {
            float a[8], b[8];
            unpack8(*(const u32x4*)(H + (size_t)(t0 - 2) * N_CI + CW + c0), a); unpack8(*(const u32x4*)(H + (size_t)(t0 - 2) * N_CI + 2 * CW + c0), b);
#pragma unroll
            for (int i = 0; i < 8; ++i) m2[i] = a[i] * b[i];
            unpack8(*(const u32x4*)(H + (size_t)(t0 - 1) * N_CI + CW + c0), a); unpack8(*(const u32x4*)(H + (size_t)(t0 - 1) * N_CI + 2 * CW + c0), b);
#pragma unroll
            for (int i = 0; i < 8; ++i) m1[i] = a[i] * b[i];
        }
#pragma unroll 4
        for (int r = 0; r < RB; ++r) {
            const bf16_t* hr = H + (size_t)(t0 + r) * N_CI + c0;
            float bg[8], cgt[8], uu[8], o[8];
            unpack8(*(const u32x4*)(hr), bg); unpack8(*(const u32x4*)(hr + CW), cgt); unpack8(*(const u32x4*)(hr + 2 * CW), uu);
#pragma unroll
            for (int i = 0; i < 8; ++i) { const float cu = cgt[i] * uu[i]; o[i] = bg[i] * (w0[i] * m2[i] + w1[i] * m1[i] + w2[i] * cu); m2[i] = m1[i]; m1[i] = cu; }
            *(u32x4*)(A2 + (size_t)(t0 + r) * K_CO + c0) = pack8f(o);
        }
    }
}
__device__ __forceinline__ void ffn_fix_phase(const float* HALOG, const float* FIRSTG, const float* FIRSTU, const float* cw, bf16_t* ACT, int gtid, int nthreads) {
    constexpr int NC4 = DFF / 4, NIT = 31 * NC4;
    asm volatile("" : "+v"(gtid));
    for (int it = gtid; it < NIT; it += nthreads) {
        const int pm = 1 + it / NC4, c = (it % NC4) * 4;
        const f32x4 gm2 = *(const f32x4*)(HALOG + (size_t)((pm - 1) * 2 + 0) * DFF + c), gm1 = *(const f32x4*)(HALOG + (size_t)((pm - 1) * 2 + 1) * DFF + c);
        const f32x4 g0 = *(const f32x4*)(FIRSTG + (size_t)(pm * 2 + 0) * DFF + c), g1 = *(const f32x4*)(FIRSTG + (size_t)(pm * 2 + 1) * DFF + c);
        const f32x4 u0 = *(const f32x4*)(FIRSTU + (size_t)(pm * 2 + 0) * DFF + c), u1 = *(const f32x4*)(FIRSTU + (size_t)(pm * 2 + 1) * DFF + c);
        const f32x4 w0 = *(const f32x4*)(cw + c), w1 = *(const f32x4*)(cw + DFF + c), w2 = *(const f32x4*)(cw + 2 * DFF + c);
        float o0[4], o1[4];
#pragma unroll
        for (int i = 0; i < 4; ++i) { const float a = w0[i] * gm2[i] + w1[i] * gm1[i] + w2[i] * g0[i], b = w0[i] * gm1[i] + w1[i] * g0[i] + w2[i] * g1[i];
            o0[i] = a / (1.0f + __expf(-a)) * u0[i]; o1[i] = b / (1.0f + __expf(-b)) * u1[i]; }
        u32x2 w; w.x = cvt_pk_bf16(o0[0], o0[1]); w.y = cvt_pk_bf16(o0[2], o0[3]); *(u32x2*)(ACT + (size_t)(256 * pm) * DFF + c) = w;
        w.x = cvt_pk_bf16(o1[0], o1[1]); w.y = cvt_pk_bf16(o1[2], o1[3]); *(u32x2*)(ACT + (size_t)(256 * pm + 1) * DFF + c) = w;
    }
}
__device__ __forceinline__ void merge_phase(const bf16_t* OG  , const float* LSE  , bf16_t* A2  , int gtid, int nthreads) {
    constexpr int NIT = SEQ * (GW / 8);
    asm volatile("" : "+v"(gtid));
    for (int it = gtid; it < NIT; it += nthreads) {
        const int ch = it % (GW / 8), t = it / (GW / 8), hd = ch >> 4;
        const float l0 = LSE[(size_t)(0 * 16 + hd) * SEQ + t];
        const float l1 = LSE[(size_t)(1 * 16 + hd) * SEQ + (t & 3) * (SEQ / 4) + (t >> 2)];
        const float l2 = LSE[(size_t)(2 * 16 + hd) * SEQ + (t & 15) * (SEQ / 16) + (t >> 4)];
        const float mx = fmaxf(l0, fmaxf(l1, l2));
        const float e0 = __expf(l0 - mx), e1 = __expf(l1 - mx), e2 = __expf(l2 - mx), inv = 1.0f / (e0 + e1 + e2);
        float a[8], b[8], c[8], o[8];
        unpack8(*(const u32x4*)(OG + (size_t)t * GW + ch * 8), a); unpack8(*(const u32x4*)(OG + (size_t)(SEQ + t) * GW + ch * 8), b); unpack8(*(const u32x4*)(OG + (size_t)(2 * SEQ + t) * GW + ch * 8), c);
#pragma unroll
        for (int i = 0; i < 8; ++i) o[i] = (e0 * a[i] + e1 * b[i] + e2 * c[i]) * inv;
        *(u32x4*)(A2 + (size_t)t * K_AO + ch * 8) = pack8f(o);
    }
}

template <int HD, int STR>
__device__ __forceinline__ void attn_load_tile(LAS unsigned char* dst, const bf16_t* src, long stride, int valid_from, int tid) {
    constexpr int CPR = HD / 8, PER = 256 * CPR / 512;
    u32x4 v[PER];
#pragma unroll
    for (int j = 0; j < PER; ++j) { const int idx = tid + 512 * j, row = idx / CPR, ch = idx % CPR;
        v[j] = (u32x4){0u, 0u, 0u, 0u}; if (row >= valid_from) v[j] = *(const u32x4*)(src + (long)row * stride + ch * 8); }
#pragma unroll
    for (int j = 0; j < PER; ++j) { const int idx = tid + 512 * j, row = idx / CPR, ch = idx % CPR; *(LAS u32x4*)(dst + row * STR + ch * 16) = v[j]; }
}
template <int HD, int NT, bool DIL>
__device__ __forceinline__ void attn_unit(LAS unsigned char* lds, const bf16_t* Qp, long qstride, const bf16_t* Kp, const bf16_t* Vp, long kvstride, int valid_from,
                                          bf16_t* Op, long ostride, float* lsep, float scale) {
    constexpr int KSTR = HD * 2 + 16, VSTR = HD * 2 + 32, NC = (NT + 1) / 2, NDT = HD / 16, NQC = HD / 32;
    constexpr bool BOTH = (256 * KSTR + 256 * VSTR) <= LDSCTL_OFF;
    const int tid = fresh_tid(), w = __builtin_amdgcn_readfirstlane(tid >> 6), lane = tid & 63, lq = lane & 15, g4 = lane >> 4;
    LAS unsigned char* Kl = lds; LAS unsigned char* Vl = BOTH ? lds + 256 * KSTR : lds;
    __syncthreads();
    attn_load_tile<HD, KSTR>(Kl, Kp, kvstride, valid_from, tid);
    if (BOTH) attn_load_tile<HD, VSTR>(Vl, Vp, kvstride, valid_from, tid);
    bf16x8 qf[NQC];
#pragma unroll
    for (int c = 0; c < NQC; ++c) qf[c] = *(const bf16x8*)(Qp + (long)(16 * w + lq) * qstride + 32 * c + 8 * g4);
    __syncthreads();
    const int jt0 = DIL ? w : 0;
    f32x4 s[NT];
#pragma unroll
    for (int j = 0; j < NT; ++j) { s[j] = (f32x4){0.f, 0.f, 0.f, 0.f}; const LAS unsigned char* kr = Kl + (16 * (jt0 + j) + lq) * KSTR + 16 * g4;
#pragma unroll
        for (int c = 0; c < NQC; ++c) { const bf16x8 kf = *(const LAS bf16x8*)(kr + 64 * c); s[j] = __builtin_amdgcn_mfma_f32_16x16x32_bf16(kf, qf[c], s[j], 0, 0, 0); } }
    if (!BOTH) { __syncthreads(); attn_load_tile<HD, VSTR>(Vl, Vp, kvstride, valid_from, tid); }
    const float NEG = -__builtin_inff();
    float mx = NEG;
    const int qi = 16 * w + lq;
#pragma unroll
    for (int j = 0; j < NT; ++j)
#pragma unroll
        for (int e = 0; e < 4; ++e) { if (DIL) { const int kr = 16 * (jt0 + j) + 4 * g4 + e; const bool ok = (kr >= qi) && (kr <= qi + 128) && (kr >= valid_from); s[j][e] = ok ? s[j][e] : NEG; } mx = fmaxf(mx, s[j][e]); }
    mx = fmaxf(mx, __shfl_xor(mx, 16)); mx = fmaxf(mx, __shfl_xor(mx, 32));
    const float c2 = scale * 1.4426950408889634f, mb = -mx * c2; float sum = 0.f;
#pragma unroll
    for (int j = 0; j < NT; ++j)
#pragma unroll
        for (int e = 0; e < 4; ++e) { const float p = __builtin_amdgcn_exp2f(fmaf(s[j][e], c2, mb)); s[j][e] = p; sum += p; }
    sum += __shfl_xor(sum, 16); sum += __shfl_xor(sum, 32);
    const float inv = 1.0f / sum;
    bf16x8 pf[NC];
#pragma unroll
    for (int cc = 0; cc < NC; ++cc) { u32x4 wv; wv.x = cvt_pk_bf16(s[2 * cc][0], s[2 * cc][1]); wv.y = cvt_pk_bf16(s[2 * cc][2], s[2 * cc][3]);
        if (2 * cc + 1 < NT) { wv.z = cvt_pk_bf16(s[(2 * cc + 1) % NT][0], s[(2 * cc + 1) % NT][1]); wv.w = cvt_pk_bf16(s[(2 * cc + 1) % NT][2], s[(2 * cc + 1) % NT][3]); } else { wv.z = 0u; wv.w = 0u; }
        pf[cc] = __builtin_bit_cast(bf16x8, wv); }
    if (!BOTH) __syncthreads();
    f32x4 o[NDT];
#pragma unroll
    for (int dt = 0; dt < NDT; ++dt) o[dt] = (f32x4){0.f, 0.f, 0.f, 0.f};
    const unsigned vbase = (unsigned)(size_t)Vl + (unsigned)((16 * jt0 + 4 * g4 + (lq >> 2)) * VSTR + (lq & 3) * 8);
#pragma unroll
    for (int cc = 0; cc < NC; ++cc) {
        const unsigned va = vbase + (unsigned)(cc * 32 * VSTR);
        constexpr int T1OFF = 16 * VSTR;
        const bool has1 = (2 * cc + 1 < NT);
#pragma unroll
        for (int d4 = 0; d4 < NDT; d4 += 4) {
            s16x4 a0, a1, a2, a3, b0, b1, b2, b3;
#define TRRD(dst, addr, off) asm volatile("ds_read_b64_tr_b16 %0, %1 offset:%2" : "=&v"(dst) : "v"(addr), "i"(off) : "memory")
            if (has1) {
                TRRD(a0, va, (d4 + 0) * 32); TRRD(b0, va, (d4 + 0) * 32 + T1OFF); TRRD(a1, va, (d4 + 1) * 32); TRRD(b1, va, (d4 + 1) * 32 + T1OFF);
                TRRD(a2, va, (d4 + 2) * 32); TRRD(b2, va, (d4 + 2) * 32 + T1OFF); TRRD(a3, va, (d4 + 3) * 32); TRRD(b3, va, (d4 + 3) * 32 + T1OFF);
            } else {
                TRRD(a0, va, (d4 + 0) * 32); TRRD(b0, va, (d4 + 0) * 32); TRRD(a1, va, (d4 + 1) * 32); TRRD(b1, va, (d4 + 1) * 32);
                TRRD(a2, va, (d4 + 2) * 32); TRRD(b2, va, (d4 + 2) * 32); TRRD(a3, va, (d4 + 3) * 32); TRRD(b3, va, (d4 + 3) * 32);
            }
#undef TRRD
            asm volatile("s_waitcnt lgkmcnt(0)" ::: "memory"); __builtin_amdgcn_sched_barrier(0);
            o[d4 + 0] = __builtin_amdgcn_mfma_f32_16x16x32_bf16((bf16x8){a0[0], a0[1], a0[2], a0[3], b0[0], b0[1], b0[2], b0[3]}, pf[cc], o[d4 + 0], 0, 0, 0);
            o[d4 + 1] = __builtin_amdgcn_mfma_f32_16x16x32_bf16((bf16x8){a1[0], a1[1], a1[2], a1[3], b1[0], b1[1], b1[2], b1[3]}, pf[cc], o[d4 + 1], 0, 0, 0);
            o[d4 + 2] = __builtin_amdgcn_mfma_f32_16x16x32_bf16((bf16x8){a2[0], a2[1], a2[2], a2[3], b2[0], b2[1], b2[2], b2[3]}, pf[cc], o[d4 + 2], 0, 0, 0);
            o[d4 + 3] = __builtin_amdgcn_mfma_f32_16x16x32_bf16((bf16x8){a3[0], a3[1], a3[2], a3[3], b3[0], b3[1], b3[2], b3[3]}, pf[cc], o[d4 + 3], 0, 0, 0);
        }
    }
    bf16_t* orow = Op + (long)qi * ostride + 4 * g4;
#pragma unroll
    for (int dt = 0; dt < NDT; ++dt) { u32x2 wv; wv.x = cvt_pk_bf16(o[dt][0] * inv, o[dt][1] * inv); wv.y = cvt_pk_bf16(o[dt][2] * inv, o[dt][3] * inv); *(u32x2*)(orow + 16 * dt) = wv; }
    if (lsep && g4 == 0) lsep[qi] = mx * scale + __logf(sum);
}

struct Args {
    const float* x; const float* mem; const int* pos; const float* g_mem; const float* w_mem_kv; const float* g_mix_pre; const float* g_mix_post; const float* g_ffn_pre; const float* g_ffn_post;
    const float* w_conv_in; const float* conv_mix_w; const float* w_conv_out; const float* w_attn_in; const float* w_attn_out; const float* w_ffn_gate; const float* w_ffn_up; const float* conv_ffn_w; const float* w_ffn_down;
    float* out; unsigned char* ws; int ph_lo, ph_hi;
};

__global__ void __launch_bounds__(512, 2) fwd_kernel(Args a) {
    extern __shared__ __attribute__((aligned(16))) unsigned char lds_raw[];
    LAS unsigned char* lds = (LAS unsigned char*)lds_raw;
    volatile LAS unsigned* MISC = (volatile LAS unsigned*)(lds + LDSCTL_OFF);
    const int tid = threadIdx.x, lane = tid & 63, wave = __builtin_amdgcn_readfirstlane(tid >> 6);
    const int G = gridDim.x, bx = blockIdx.x;
    const int gtid = bx * 512 + tid, nthreads = G * 512, gw = bx * 8 + wave, ngw = G * 8;
    unsigned char* ws = a.ws;
    unsigned* ctl = (unsigned*)(ws + WS_CTL);
    bf16_t* WKV = (bf16_t*)(ws + WS_WKV); bf16_t* WCI = (bf16_t*)(ws + WS_WCI); bf16_t* WCO = (bf16_t*)(ws + WS_WCO); bf16_t* WAI = (bf16_t*)(ws + WS_WAI); bf16_t* WAO = (bf16_t*)(ws + WS_WAO);
    bf16_t* WGU = (bf16_t*)(ws + WS_WGU); bf16_t* WD = (bf16_t*)(ws + WS_WD);
    bf16_t* XN = (bf16_t*)(ws + WS_XN); bf16_t* H = (bf16_t*)(ws + WS_R); bf16_t* GU = (bf16_t*)(ws + WS_R); bf16_t* Y = (bf16_t*)(ws + WS_R);
    bf16_t* ACT = (bf16_t*)(ws + WS_S); bf16_t* A2 = (bf16_t*)(ws + WS_S); bf16_t* OG = (bf16_t*)(ws + WS_S + 64 * MiB);
    bf16_t* MEMN = (bf16_t*)(ws + WS_MEMN); bf16_t* KV = (bf16_t*)(ws + WS_KV); float* COS = (float*)(ws + WS_COS); float* SIN = (float*)(ws + WS_SIN); float* LSE = (float*)(ws + WS_LSE);
    float* HALOG = (float*)(ws + WS_HALOG); float* FIRSTG = (float*)(ws + WS_FIRSTG); float* FIRSTU = (float*)(ws + WS_FIRSTU);

    for (int u = tid; u < (LDS_BYTES - LDSCTL_OFF) / 4; u += 512) ((LAS unsigned*)(lds + LDSCTL_OFF))[u] = 0u;
    __syncthreads();
    XcdBarrier bar; bar.bar = ctl + CW_BAR; bar.x = 0; bar.st = nullptr;
    if (ONE_LAUNCH) bar = xcd_barrier_post(ctl + CW_BAR, MISC + 8);
    const int lo = a.ph_lo, hi = a.ph_hi;
#define IN(k) (lo <= (k) && (k) < hi)
#define SEAM(k) do { if (IN(k) && IN((k) + 1)) xcd_barrier(bar); } while (0)
    constexpr size_t SZ_GU = (size_t)N_GU * DM, SZ_D = (size_t)DM * DFF;

    if (IN(0)) {
        LAS float* scr = (LAS float*)(lds + wave * 16384);
        cvt_matrix<0>(a.w_mem_kv, DM, 2 * MW, WKV, 0, scr, gw, ngw, lane);
        for (int m = gw; m < NMEM; m += ngw) rms_row_to_bf16(a.mem + (size_t)m * DM, a.g_mem, MEMN + (size_t)m * DM, lane);
        for (int m = gw; m < SEQ; m += ngw) rms_row_to_bf16(a.x + (size_t)m * DM, a.g_mix_pre, XN + (size_t)m * DM, lane);
        for (int idx = gtid; idx < SEQ * 64; idx += nthreads) { const int t = idx >> 6, i = idx & 63;
            const float ang = (float)a.pos[t] * INV_FREQ[i];
            const double kq = rint((double)ang * 0.15915494309189535); double r = fma(-kq, 6.283185307179586, (double)ang); r = fma(-kq, 2.4492935982947064e-16, r);
            const float rf = (float)r; COS[idx] = cosf(rf); SIN[idx] = sinf(rf); }
    }
    SEAM(0);
    if (IN(1)) {
        if (bx < 8) {
            pg8::Gemm g{MEMN, WKV, DM, DM, DM}; pg8::StaticOrder S; S.init(NMEM, 2 * MW, 8, bx);
            pg8::EpiStore E{KV, 2 * MW};
            pg8::gemm_phase<pg8::EpiStore, pg8::StaticOrder, true>(lds, g, S, E);
        } else {
            LAS float* scr = (LAS float*)(lds + wave * 16384);
            const int cw_ = (bx - 8) * 8 + wave, ncw = (G - 8) * 8;
            cvt_matrix<0>(a.w_conv_in, DM, N_CI, WCI, 0, scr, cw_, ncw, lane);
            cvt_matrix<0>(a.w_conv_out, K_CO, DM, WCO, 0, scr, cw_, ncw, lane);
            cvt_matrix<2>(a.w_ffn_gate, DM, DFF, WGU, 0, scr, cw_, ncw, lane);
            cvt_matrix<3>(a.w_ffn_up, DM, DFF, WGU, 0, scr, cw_, ncw, lane);
            cvt_matrix<0>(a.w_ffn_down, DFF, DM, WD, 0, scr, cw_, ncw, lane);
            cvt_matrix<1>(a.w_attn_in, DM, N_AI, WAI, 0, scr, cw_, ncw, lane);
            cvt_matrix<0>(a.w_attn_out, K_AO, DM, WAO, 0, scr, cw_, ncw, lane);
            cvt_matrix<2>(a.w_ffn_gate + SZ_D, DM, DFF, WGU + SZ_GU, 0, scr, cw_, ncw, lane);
            cvt_matrix<3>(a.w_ffn_up + SZ_D, DM, DFF, WGU + SZ_GU, 0, scr, cw_, ncw, lane);
            cvt_matrix<0>(a.w_ffn_down + SZ_D, DFF, DM, WD + SZ_D, 0, scr, cw_, ncw, lane);
        }
    }
    SEAM(1);
    if (IN(2)) {
        pg8::Gemm g{XN, WCI, DM, DM, DM}; pg8::StaticOrder S; S.init(SEQ, N_CI, G, bx);
        pg8::EpiStore E{H, N_CI};
        pg8::gemm_phase<pg8::EpiStore, pg8::StaticOrder, true>(lds, g, S, E);
    }
    SEAM(2);
    if (IN(3)) {
        for (int u = bx; u < 4 * (SEQ / 128); u += G) { const int hd = u / (SEQ / 128), qb = u % (SEQ / 128);
            attn_unit<256, 16, false>(lds, H + (size_t)(128 * qb) * N_CI + 3 * CW + 256 * hd, N_CI, KV + 256 * hd, KV + MW + 256 * hd, 2 * MW, 0,
                                      A2 + (size_t)(128 * qb) * K_CO + CW + 256 * hd, K_CO, nullptr, 0.0625f); }
        conv_gate_phase(H, a.conv_mix_w, A2, gtid, nthreads);
    }
    SEAM(3);
    if (IN(4)) {
        pg8::Gemm g{A2, WCO, K_CO, K_CO, K_CO}; pg8::StaticOrder S; S.init(SEQ, DM, G, bx);
        pg8::EpiStore E{Y, DM};
        pg8::gemm_phase<pg8::EpiStore, pg8::StaticOrder, true>(lds, g, S, E);
    }
    SEAM(4);
    if (IN(5)) { for (int m = gw; m < SEQ; m += ngw) norm_res_row(a.x + (size_t)m * DM, Y + (size_t)m * DM, a.g_mix_post, a.g_ffn_pre, a.out + (size_t)m * DM, XN + (size_t)m * DM, lane); }
    SEAM(5);
    if (IN(6)) {
        pg8::Gemm g{XN, WGU, DM, DM, DM}; pg8::StaticOrder S; S.init(SEQ, N_GU, G, bx);
        pg8::EpiFfn E{ACT, a.conv_ffn_w, HALOG, FIRSTG, FIRSTU, lds + RING_BYTES};
        pg8::gemm_phase<pg8::EpiFfn, pg8::StaticOrder, true>(lds, g, S, E);
    }
    SEAM(6);
    if (IN(7)) ffn_fix_phase(HALOG, FIRSTG, FIRSTU, a.conv_ffn_w, ACT, gtid, nthreads);
    SEAM(7);
    if (IN(8)) {
        pg8::Gemm g{ACT, WD, DFF, DFF, DFF}; pg8::StaticOrder S; S.init(SEQ, DM, G, bx);
        pg8::EpiStore E{Y, DM};
        pg8::gemm_phase<pg8::EpiStore, pg8::StaticOrder, true>(lds, g, S, E);
    }
    SEAM(8);
    if (IN(9)) { for (int m = gw; m < SEQ; m += ngw) norm_res_row(a.out + (size_t)m * DM, Y + (size_t)m * DM, a.g_ffn_post, a.g_mix_pre + DM, a.out + (size_t)m * DM, XN + (size_t)m * DM, lane); }
    SEAM(9);
    if (IN(10)) {
        pg8::Gemm g{XN, WAI, DM, DM, DM}; pg8::StaticOrder S; S.init(SEQ, N_AI, G, bx);
        pg8::EpiRope E{H, N_AI, COS, SIN};
        pg8::gemm_phase<pg8::EpiRope, pg8::StaticOrder, true>(lds, g, S, E);
    }
    SEAM(10);
    if (IN(11)) {
        for (int u = bx; u < 3 * 16 * 64; u += G) {
            const int grp = u >> 10, rem = u & 1023, hd = rem >> 6, blk = rem & 63;
            const int dsh = 2 * grp, d = 1 << dsh, nbr = 64 >> dsh, r = blk / nbr, nb = blk % nbr;
            const long ts = (long)d * N_AI;
            const bf16_t* base = H + (size_t)r * N_AI + grp * (3 * GW) + hd * HDIM;
            const long p0 = 128L * nb;
            attn_unit<128, 9, true>(lds, base + p0 * ts, ts, base + GW + (p0 - 128) * ts, base + 2 * GW + (p0 - 128) * ts, ts, nb == 0 ? 128 : 0,
                                    OG + ((size_t)grp * SEQ + r) * GW + hd * HDIM + p0 * (long)d * GW, (long)d * GW,
                                    LSE + (size_t)(grp * 16 + hd) * SEQ + (size_t)r * (SEQ >> dsh) + p0, 0.08838834764831845f);
        }
        for (int u = bx; u < 4 * (SEQ / 128); u += G) { const int hd = u / (SEQ / 128), qb = u % (SEQ / 128);
            attn_unit<256, 16, false>(lds, H + (size_t)(128 * qb) * N_AI + 9 * GW + 256 * hd, N_AI, KV + 256 * hd, KV + MW + 256 * hd, 2 * MW, 0,
                                      A2 + (size_t)(128 * qb) * K_AO + GW + 256 * hd, K_AO, nullptr, 0.0625f); }
    }
    SEAM(11);
    if (IN(12)) merge_phase(OG, LSE, A2, gtid, nthreads);
    SEAM(12);
    if (IN(13)) {
        pg8::Gemm g{A2, WAO, K_AO, K_AO, K_AO}; pg8::StaticOrder S; S.init(SEQ, DM, G, bx);
        pg8::EpiStore E{Y, DM};
        pg8::gemm_phase<pg8::EpiStore, pg8::StaticOrder, true>(lds, g, S, E);
    }
    SEAM(13);
    if (IN(14)) { for (int m = gw; m < SEQ; m += ngw) norm_res_row(a.out + (size_t)m * DM, Y + (size_t)m * DM, a.g_mix_post + DM, a.g_ffn_pre + DM, a.out + (size_t)m * DM, XN + (size_t)m * DM, lane); }
    SEAM(14);
    if (IN(15)) {
        pg8::Gemm g{XN, WGU + SZ_GU, DM, DM, DM}; pg8::StaticOrder S; S.init(SEQ, N_GU, G, bx);
        pg8::EpiFfn E{ACT, a.conv_ffn_w + 3 * DFF, HALOG, FIRSTG, FIRSTU, lds + RING_BYTES};
        pg8::gemm_phase<pg8::EpiFfn, pg8::StaticOrder, true>(lds, g, S, E);
    }
    SEAM(15);
    if (IN(16)) ffn_fix_phase(HALOG, FIRSTG, FIRSTU, a.conv_ffn_w + 3 * DFF, ACT, gtid, nthreads);
    SEAM(16);
    if (IN(17)) {
        pg8::Gemm g{ACT, WD + SZ_D, DFF, DFF, DFF}; pg8::StaticOrder S; S.init(SEQ, DM, G, bx);
        pg8::EpiStore E{Y, DM};
        pg8::gemm_phase<pg8::EpiStore, pg8::StaticOrder, true>(lds, g, S, E);
    }
    SEAM(17);
    if (IN(18)) { for (int m = gw; m < SEQ; m += ngw) norm_res_row(a.out + (size_t)m * DM, Y + (size_t)m * DM, a.g_ffn_post + DM, nullptr, a.out + (size_t)m * DM, nullptr, lane); }

#ifdef PROBE
    xcd_barrier(bar);
#if PROBE == 1
    { LAS float* scr = (LAS float*)(lds + wave * 16384);
      if (bx >= 8) { const int cw_ = (bx - 8) * 8 + wave, ncw = (G - 8) * 8;
            cvt_matrix<0>(a.w_conv_in, DM, N_CI, WCI, 0, scr, cw_, ncw, lane);
            cvt_matrix<0>(a.w_conv_out, K_CO, DM, WCO, 0, scr, cw_, ncw, lane);
            cvt_matrix<2>(a.w_ffn_gate, DM, DFF, WGU, 0, scr, cw_, ncw, lane);
            cvt_matrix<3>(a.w_ffn_up, DM, DFF, WGU, 0, scr, cw_, ncw, lane);
            cvt_matrix<0>(a.w_ffn_down, DFF, DM, WD, 0, scr, cw_, ncw, lane);
            cvt_matrix<1>(a.w_attn_in, DM, N_AI, WAI, 0, scr, cw_, ncw, lane);
            cvt_matrix<0>(a.w_attn_out, K_AO, DM, WAO, 0, scr, cw_, ncw, lane);
            cvt_matrix<2>(a.w_ffn_gate + SZ_D, DM, DFF, WGU + SZ_GU, 0, scr, cw_, ncw, lane);
            cvt_matrix<3>(a.w_ffn_up + SZ_D, DM, DFF, WGU + SZ_GU, 0, scr, cw_, ncw, lane);
            cvt_matrix<0>(a.w_ffn_down + SZ_D, DFF, DM, WD + SZ_D, 0, scr, cw_, ncw, lane); } }
#elif PROBE == 8
    { pg8::Gemm g{ACT, WD, DFF, DFF, DFF}; pg8::StaticOrder S; S.init(SEQ, DM, G, bx);
      pg8::EpiStore E{Y, DM};
      pg8::gemm_phase<pg8::EpiStore, pg8::StaticOrder, true>(lds, g, S, E); }
#elif PROBE == 4
    { pg8::Gemm g{A2, WCO, K_CO, K_CO, K_CO}; pg8::StaticOrder S; S.init(SEQ, DM, G, bx);
      pg8::EpiStore E{Y, DM};
      pg8::gemm_phase<pg8::EpiStore, pg8::StaticOrder, true>(lds, g, S, E); }
#elif PROBE == 40
    { pg8::Gemm g{A2, WCO, K_CO, K_CO, K_CO}; pg8::SameTileOrder S; S.n = 2;
      pg8::EpiStore E{Y, DM};
      pg8::gemm_phase<pg8::EpiStore, pg8::SameTileOrder, true>(lds, g, S, E); }
#elif PROBE == 6
    { pg8::Gemm g{XN, WGU, DM, DM, DM}; pg8::StaticOrder S; S.init(SEQ, N_GU, G, bx);
      pg8::EpiFfn E{ACT, a.conv_ffn_w, HALOG, FIRSTG, FIRSTU, lds + RING_BYTES};
      pg8::gemm_phase<pg8::EpiFfn, pg8::StaticOrder, true>(lds, g, S, E); }
#elif PROBE == 5
    { float* scratch_x = (float*)(ws + WS_S);
      for (int m = gw; m < SEQ; m += ngw) norm_res_row(a.x + (size_t)m * DM, Y + (size_t)m * DM, a.g_mix_post, a.g_ffn_pre, scratch_x + (size_t)m * DM, XN + (size_t)m * DM, lane); }
#elif PROBE == 3
    { for (int u = bx; u < 4 * (SEQ / 128); u += G) { const int hd = u / (SEQ / 128), qb = u % (SEQ / 128);
            attn_unit<256, 16, false>(lds, H + (size_t)(128 * qb) * N_CI + 3 * CW + 256 * hd, N_CI, KV + 256 * hd, KV + MW + 256 * hd, 2 * MW, 0,
                                      A2 + (size_t)(128 * qb) * K_CO + CW + 256 * hd, K_CO, nullptr, 0.0625f); }
        conv_gate_phase(H, a.conv_mix_w, A2, gtid, nthreads); }
#elif PROBE == 11
    { for (int u = bx; u < 3 * 16 * 64; u += G) {
            const int grp = u >> 10, rem = u & 1023, hd = rem >> 6, blk = rem & 63;
            const int dsh = 2 * grp, d = 1 << dsh, nbr = 64 >> dsh, r = blk / nbr, nb = blk % nbr;
            const long ts = (long)d * N_AI;
            const bf16_t* base = H + (size_t)r * N_AI + grp * (3 * GW) + hd * HDIM;
            const long p0 = 128L * nb;
            attn_unit<128, 9, true>(lds, base + p0 * ts, ts, base + GW + (p0 - 128) * ts, base + 2 * GW + (p0 - 128) * ts, ts, nb == 0 ? 128 : 0,
                                    OG + ((size_t)grp * SEQ + r) * GW + hd * HDIM + p0 * (long)d * GW, (long)d * GW,
                                    LSE + (size_t)(grp * 16 + hd) * SEQ + (size_t)r * (SEQ >> dsh) + p0, 0.08838834764831845f);
        } }
#endif
#endif
#undef IN
#undef SEAM
}

extern "C" void kernel_launch(void* const* d_in, const int* in_sizes, int n_in, void* d_out, int out_size, void* d_ws, size_t ws_size, hipStream_t stream) {
    static int grid = 0;
    if (grid == 0) {
        if (n_in != 18 || in_sizes[0] != SEQ * DM || out_size != SEQ * DM || ws_size < WS_END) { fprintf(stderr, "kernel_launch: unexpected shapes (n_in %d, in0 %d, out %d, ws %zu < %zu?)\n", n_in, n_in > 0 ? in_sizes[0] : -1, out_size, ws_size, (size_t)WS_END); grid = -1; return; }
        int dev = 0, cus = 0;
        if (hipGetDevice(&dev) != hipSuccess || hipDeviceGetAttribute(&cus, hipDeviceAttributeMultiprocessorCount, dev) != hipSuccess) { grid = -1; return; }
        if (hipFuncSetAttribute((const void*)fwd_kernel, hipFuncAttributeMaxDynamicSharedMemorySize, LDS_BYTES) != hipSuccess) { fprintf(stderr, "kernel_launch: hipFuncSetAttribute failed\n"); grid = -1; return; }
        int per_cu = 0;
        if (hipOccupancyMaxActiveBlocksPerMultiprocessor(&per_cu, (const void*)fwd_kernel, 512, LDS_BYTES) != hipSuccess || per_cu < 1) fprintf(stderr, "kernel_launch: occupancy query says %d\n", per_cu);
        (void)hipGetLastError();
        grid = cus;
        if (grid < 16) { fprintf(stderr, "kernel_launch: needs >= 16 CUs\n"); grid = -1; return; }
    }
    if (grid < 0) return;
    (void)hipMemsetAsync((char*)d_ws + WS_CTL, 0, CTL_ZERO_BYTES, stream);
    Args a{};
    a.x = (const float*)d_in[0]; a.mem = (const float*)d_in[1]; a.pos = (const int*)d_in[2]; a.g_mem = (const float*)d_in[3]; a.w_mem_kv = (const float*)d_in[4];
    a.g_mix_pre = (const float*)d_in[5]; a.g_mix_post = (const float*)d_in[6]; a.g_ffn_pre = (const float*)d_in[7]; a.g_ffn_post = (const float*)d_in[8];
    a.w_conv_in = (const float*)d_in[9]; a.conv_mix_w = (const float*)d_in[10]; a.w_conv_out = (const float*)d_in[11]; a.w_attn_in = (const float*)d_in[12]; a.w_attn_out = (const float*)d_in[13];
    a.w_ffn_gate = (const float*)d_in[14]; a.w_ffn_up = (const float*)d_in[15]; a.conv_ffn_w = (const float*)d_in[16]; a.w_ffn_down = (const float*)d_in[17];
    a.out = (float*)d_out; a.ws = (unsigned char*)d_ws;
#if ONE_LAUNCH
    a.ph_lo = 0; a.ph_hi = NPHASE;
    hipLaunchKernelGGL(fwd_kernel, dim3(grid), dim3(512), LDS_BYTES, stream, a);
#else
    for (int p = 0; p < NPHASE; ++p) { a.ph_lo = p; a.ph_hi = p + 1; hipLaunchKernelGGL(fwd_kernel, dim3(grid), dim3(512), LDS_BYTES, stream, a); }
#endif
}
```

```cpp
#include <hip/hip_runtime.h>
#include <cstdio>
#include <cstdint>

#define LAS __attribute__((address_space(3)))
#define GAS __attribute__((address_space(1)))
typedef unsigned short bf16_t;
typedef short bf16x8 __attribute__((ext_vector_type(8)));
typedef short s16x4 __attribute__((ext_vector_type(4)));
typedef float f32x4 __attribute__((ext_vector_type(4)));
typedef unsigned u32x4 __attribute__((ext_vector_type(4)));
typedef unsigned u32x2 __attribute__((ext_vector_type(2)));

constexpr int SEQ = 8192, DM = 4096, DFF = 11008, CW = 3072, MW = 1024, GW = 2048, NMEM = 256, NHEAD = 16, HDIM = 128;
constexpr int N_CI = 3 * CW + MW;
constexpr int N_AI = 9 * GW + MW;
constexpr int N_GU = 2 * DFF;
constexpr int K_CO = CW + MW;
constexpr int K_AO = GW + MW;
constexpr float EPS = 1e-6f;

#ifndef ONE_LAUNCH
#define ONE_LAUNCH 1
#endif
constexpr int NPHASE = 19;

constexpr size_t MiB = 1u << 20;
constexpr size_t WS_CTL = 0, CTL_ZERO_BYTES = 1 * MiB;
constexpr size_t WS_WKV = 1 * MiB;
constexpr size_t WS_WCI = WS_WKV + 16 * MiB;
constexpr size_t WS_WCO = WS_WCI + 80 * MiB;
constexpr size_t WS_WAI = WS_WCO + 32 * MiB;
constexpr size_t WS_WAO = WS_WAI + 152 * MiB;
constexpr size_t WS_WGU = WS_WAO + 24 * MiB;
constexpr size_t WS_WD  = WS_WGU + 2 * 172 * MiB;
constexpr size_t WS_XN  = WS_WD + 2 * 86 * MiB;
constexpr size_t WS_R   = WS_XN + 64 * MiB;
constexpr size_t WS_S   = WS_R + 344 * MiB;
constexpr size_t WS_MEMN = WS_S + 172 * MiB;
constexpr size_t WS_KV  = WS_MEMN + 2 * MiB;
constexpr size_t WS_COS = WS_KV + 1 * MiB;
constexpr size_t WS_SIN = WS_COS + 2 * MiB;
constexpr size_t WS_LSE = WS_SIN + 2 * MiB;
constexpr size_t WS_HALOG = WS_LSE + 2 * MiB;
constexpr size_t WS_FIRSTG = WS_HALOG + 3 * MiB;
constexpr size_t WS_FIRSTU = WS_FIRSTG + 3 * MiB;
constexpr size_t WS_END = WS_FIRSTU + 3 * MiB;
constexpr int CW_BAR = 4096;

constexpr int RING_BYTES = 131072;
constexpr int LDSCTL_OFF = 146432;
constexpr int LDS_BYTES = 147456;

__device__ __forceinline__ unsigned cvt_pk_bf16(float lo, float hi) { unsigned r; asm("v_cvt_pk_bf16_f32 %0, %1, %2" : "=v"(r) : "v"(lo), "v"(hi)); return r; }
__device__ __forceinline__ float bf_lo(unsigned w) { return __uint_as_float(w << 16); }
__device__ __forceinline__ float bf_hi(unsigned w) { return __uint_as_float(w & 0xffff0000u); }
__device__ __forceinline__ int fresh_lane() { int l; asm volatile("v_mbcnt_lo_u32_b32 %0, -1, 0\n\tv_mbcnt_hi_u32_b32 %0, -1, %0" : "=v"(l)); return l; }
__device__ __forceinline__ int fresh_tid() { int t = threadIdx.x; asm volatile("" : "+v"(t)); return t; }
__device__ __forceinline__ float wave_sum(float v) {
#pragma unroll
    for (int o = 1; o < 64; o <<= 1) v += __shfl_xor(v, o);
    return v;
}

__constant__ float INV_FREQ[64] = {
1.000000000e+00f, 8.659643531e-01f, 7.498942018e-01f, 6.493816376e-01f, 5.623413324e-01f, 4.869675338e-01f, 4.216965139e-01f, 3.651741147e-01f, 3.162277639e-01f, 2.738419771e-01f, 2.371373773e-01f, 2.053525001e-01f, 1.778279394e-01f, 1.539926529e-01f, 1.333521456e-01f, 1.154781953e-01f,
1.000000015e-01f, 8.659642935e-02f, 7.498942316e-02f, 6.493816525e-02f, 5.623413250e-02f, 4.869675264e-02f, 4.216964915e-02f, 3.651741147e-02f, 3.162277490e-02f, 2.738419548e-02f, 2.371373773e-02f, 2.053525113e-02f, 1.778279431e-02f, 1.539926510e-02f, 1.333521400e-02f, 1.154781971e-02f,
9.999999776e-03f, 8.659643121e-03f, 7.498942316e-03f, 6.493816152e-03f, 5.623413250e-03f, 4.869675264e-03f, 4.216964822e-03f, 3.651741194e-03f, 3.162277630e-03f, 2.738419687e-03f, 2.371373819e-03f, 2.053525066e-03f, 1.778279431e-03f, 1.539926510e-03f, 1.333521446e-03f, 1.154782018e-03f,
1.000000047e-03f, 8.659643354e-04f, 7.498941850e-04f, 6.493816036e-04f, 5.623413017e-04f, 4.869675322e-04f, 4.216965172e-04f, 3.651741135e-04f, 3.162277571e-04f, 2.738419571e-04f, 2.371373703e-04f, 2.053525095e-04f, 1.778279402e-04f, 1.539926598e-04f, 1.333521504e-04f, 1.154782003e-04f };

namespace pg8 {
constexpr int BM = 256, BK = 64, HALF = 128, HTB = HALF * BK * 2, STAGE_BYTES = 8 * HTB, NXCD = 8, WGM = 8;
__host__ __device__ __forceinline__ int lds_byte(int r, int c) { const int st = (r >> 4) * 2 + (c >> 5), rr = r & 15, cc = c & 31, ob = rr * 64 + cc * 2; return st * 1024 + (ob ^ (((ob >> 9) & 1) << 5)); }
__host__ __device__ __forceinline__ void stage_rc(int b, int& R, int& C) { const int st = b / 1024, sb = b % 1024, swz = sb ^ (((sb >> 9) & 1) << 5); R = (st >> 1) * 16 + swz / 64; C = (st & 1) * 32 + (swz % 64) / 2; }
__host__ __device__ __forceinline__ int perm32(int rho) { const int n = rho >> 4, i = rho & 15; return 8 * (i >> 2) + 4 * n + (i & 3); }

struct Unit { int pm, pn; };
struct SameTileOrder { int n;
    __device__ bool next(int i, Unit& u) const { if (i >= n) return false; u.pm = 0; u.pn = 0; return true; }
    __device__ __forceinline__ void a_ready(const Unit&) const {}
    __device__ __forceinline__ void done(const Unit&) const {} };
struct Gemm { const bf16_t* A; const bf16_t* Bt; int K, lda, ldb; };

struct StaticOrder {
    int nM, nN, nwg, G, c;
    __host__ __device__ void init(int M, int N, int G_, int c_) { nM = M / BM; nN = N / BM; nwg = nM * nN; G = G_; c = c_; }
    __host__ __device__ bool next(int i, Unit& u) const {
        const long L = (long)i * G + c; if (L >= nwg) return false;
        int wgid = (int)L; { const int q = nwg / NXCD, r = nwg % NXCD, xcd = wgid % NXCD, off = wgid / NXCD; wgid = (xcd < r ? xcd * (q + 1) : r * (q + 1) + (xcd - r) * q) + off; }
        const int nig = WGM * nN, gid = wgid / nig, fm = gid * WGM, gsz = (nM - fm) < WGM ? (nM - fm) : WGM;
        u.pm = fm + ((wgid % nig) % gsz); u.pn = (wgid % nig) / gsz; return true;
    }
    __device__ __forceinline__ void a_ready(const Unit&) const {}
    __device__ __forceinline__ void done(const Unit&) const {}
};

struct EpiStore {
    static constexpr bool PERM = true, AFTER_DRAIN = false;
    bf16_t* O; int ldc;
    __device__ __forceinline__ void operator()(const f32x4 (&acc)[2][2][4][2], const Unit& u, int wr, int wc, int fr, int fq) const {
        const int row0 = u.pm * BM + wr * 64 + fr, col0 = u.pn * BM + wc * 32 + 8 * fq;
#pragma unroll
        for (int ai = 0; ai < 2; ++ai)
#pragma unroll
            for (int m = 0; m < 4; ++m) { bf16_t* rowp = O + (size_t)(row0 + ai * HALF + m * 16) * ldc + col0;
#pragma unroll
                for (int bj = 0; bj < 2; ++bj) { const f32x4 v0 = acc[ai][bj][m][0], v1 = acc[ai][bj][m][1];
                    u32x4 w; w.x = cvt_pk_bf16(v0[0], v0[1]); w.y = cvt_pk_bf16(v0[2], v0[3]); w.z = cvt_pk_bf16(v1[0], v1[1]); w.w = cvt_pk_bf16(v1[2], v1[3]);
                    *(u32x4*)(rowp + bj * HALF) = w; } }
    }
};
struct EpiQKV {
    static constexpr bool PERM = true, AFTER_DRAIN = false;
    bf16_t* QKVL; bf16_t* QM; const float* cosT; const float* sinT;
    __device__ __forceinline__ void operator()(const f32x4 (&acc)[2][2][4][2], const Unit& u, int wr, int wc, int fr, int fq) const {
        const int colt = u.pn * BM;
        const int row0 = u.pm * BM + wr * 64 + fr;
        if (colt >= 9 * GW) {
            const int col0 = colt - 9 * GW + wc * 32 + 8 * fq;
#pragma unroll
            for (int ai = 0; ai < 2; ++ai)
#pragma unroll
                for (int m = 0; m < 4; ++m) { bf16_t* rowp = QM + (size_t)(row0 + ai * HALF + m * 16) * MW + col0;
#pragma unroll
                    for (int bj = 0; bj < 2; ++bj) { const f32x4 v0 = acc[ai][bj][m][0], v1 = acc[ai][bj][m][1];
                        u32x4 w; w.x = cvt_pk_bf16(v0[0], v0[1]); w.y = cvt_pk_bf16(v0[2], v0[3]); w.z = cvt_pk_bf16(v1[0], v1[1]); w.w = cvt_pk_bf16(v1[2], v1[3]);
                        *(u32x4*)(rowp + bj * HALF) = w; } }
        } else {
            const int g = colt / (3 * GW), rem = colt % (3 * GW), part = rem / GW, hd0 = (rem % GW) / HDIM, dsh = 2 * g, dm1 = (1 << dsh) - 1;
            bf16_t* slab0 = QKVL + (size_t)((g * 3 + part) * NHEAD + hd0) * SEQ * HDIM;
            if (part == 2) {
#pragma unroll
                for (int ai = 0; ai < 2; ++ai)
#pragma unroll
                    for (int m = 0; m < 4; ++m) { const int row = row0 + ai * HALF + m * 16; const int rp = ((row & dm1) << (13 - dsh)) + (row >> dsh);
#pragma unroll
                        for (int bj = 0; bj < 2; ++bj) { const f32x4 v0 = acc[ai][bj][m][0], v1 = acc[ai][bj][m][1];
                            u32x4 w; w.x = cvt_pk_bf16(v0[0], v0[1]); w.y = cvt_pk_bf16(v0[2], v0[3]); w.z = cvt_pk_bf16(v1[0], v1[1]); w.w = cvt_pk_bf16(v1[2], v1[3]);
                            *(u32x4*)(slab0 + ((size_t)bj * SEQ + rp) * HDIM + wc * 32 + 8 * fq) = w; } }
            } else {
                const int x0 = wc * 32 + 8 * fq, hh = x0 >> 6, d0 = x0 & 63;
#pragma unroll
                for (int ai = 0; ai < 2; ++ai)
#pragma unroll
                    for (int m = 0; m < 4; ++m) { const int row = row0 + ai * HALF + m * 16; const int rp = ((row & dm1) << (13 - dsh)) + (row >> dsh);
                        const f32x4 c0 = *(const f32x4*)(cosT + (size_t)row * 64 + d0), c1 = *(const f32x4*)(cosT + (size_t)row * 64 + d0 + 4);
                        const f32x4 s0 = *(const f32x4*)(sinT + (size_t)row * 64 + d0), s1 = *(const f32x4*)(sinT + (size_t)row * 64 + d0 + 4);
                        const f32x4 a0 = acc[ai][0][m][0], a1 = acc[ai][0][m][1], b0 = acc[ai][1][m][0], b1 = acc[ai][1][m][1];
                        const f32x4 o10 = a0 * c0 - b0 * s0, o11 = a1 * c1 - b1 * s1, o20 = b0 * c0 + a0 * s0, o21 = b1 * c1 + a1 * s1;
                        bf16_t* rowp = slab0 + ((size_t)hh * SEQ + rp) * HDIM + d0;
                        u32x4 w; w.x = cvt_pk_bf16(o10[0], o10[1]); w.y = cvt_pk_bf16(o10[2], o10[3]); w.z = cvt_pk_bf16(o11[0], o11[1]); w.w = cvt_pk_bf16(o11[2], o11[3]);
                        *(u32x4*)(rowp) = w;
                        w.x = cvt_pk_bf16(o20[0], o20[1]); w.y = cvt_pk_bf16(o20[2], o20[3]); w.z = cvt_pk_bf16(o21[0], o21[1]); w.w = cvt_pk_bf16(o21[2], o21[3]);
                        *(u32x4*)(rowp + 64) = w;
                        asm volatile("" ::: "memory"); }
            }
        }
    }
};
__device__ __forceinline__ float dpp_ror1(float v) { return __builtin_bit_cast(float, __builtin_amdgcn_update_dpp(0, __builtin_bit_cast(int, v), 0x121, 0xf, 0xf, false)); }
__device__ __forceinline__ float dpp_ror2(float v) { return __builtin_bit_cast(float, __builtin_amdgcn_update_dpp(0, __builtin_bit_cast(int, v), 0x122, 0xf, 0xf, false)); }
struct EpiFfn {
    static constexpr bool PERM = true, AFTER_DRAIN = false;
    bf16_t* ACT; const float* cw; float* HALOG; float* FIRSTG; float* FIRSTU; LAS unsigned char* xl;
    __device__ __forceinline__ void operator()(const f32x4 (&acc)[2][2][4][2], const Unit& u, int wr, int wc, int fr, int fq) const {
        const int ch0 = u.pn * 128 + wc * 32 + 8 * fq;
        LAS f32x4* hl = (LAS f32x4*)xl;
        if (fr >= 14) {
#pragma unroll
            for (int ai = 0; ai < 2; ++ai) { const int idx = ((((ai * 2 + wr) * 4 + wc) * 2 + (fr - 14)) * 4 + fq) * 2; hl[idx] = acc[ai][0][3][0]; hl[idx + 1] = acc[ai][0][3][1]; }
        }
        float w0[8], w1[8], w2[8];
        { const f32x4 a0 = *(const f32x4*)(cw + ch0), a1 = *(const f32x4*)(cw + ch0 + 4), b0 = *(const f32x4*)(cw + DFF + ch0), b1 = *(const f32x4*)(cw + DFF + ch0 + 4), c0 = *(const f32x4*)(cw + 2 * DFF + ch0), c1 = *(const f32x4*)(cw + 2 * DFF + ch0 + 4);
#pragma unroll
          for (int i = 0; i < 4; ++i) { w0[i] = a0[i]; w0[4 + i] = a1[i]; w1[i] = b0[i]; w1[4 + i] = b1[i]; w2[i] = c0[i]; w2[4 + i] = c1[i]; } }
        asm volatile("s_waitcnt lgkmcnt(0)" ::: "memory"); __builtin_amdgcn_s_barrier(); asm volatile("" ::: "memory");
#pragma unroll
        for (int ai = 0; ai < 2; ++ai) {
            const bool ext = (wr == 0 && ai == 0);
            float x14[8], x15[8];
            if (ext) {
#pragma unroll
                for (int i = 0; i < 8; ++i) { x14[i] = 0.f; x15[i] = 0.f; }
            } else {
                const int sai = (wr == 1) ? ai : 0, swr = (wr == 1) ? 0 : 1;
                const int b = ((((sai * 2 + swr) * 4 + wc) * 2) * 4 + fq) * 2;
                const f32x4 p0 = hl[b], p1 = hl[b + 1], q0 = hl[b + 8], q1 = hl[b + 9];
#pragma unroll
                for (int i = 0; i < 4; ++i) { x14[i] = p0[i]; x14[4 + i] = p1[i]; x15[i] = q0[i]; x15[4 + i] = q1[i]; }
            }
            float r1p[8], r2p[8];
#pragma unroll
            for (int i = 0; i < 8; ++i) { r1p[i] = x15[i]; r2p[i] = (fr == 0) ? x14[i] : x15[i]; }
#pragma unroll
            for (int m = 0; m < 4; ++m) {
                float cur[8], up[8], o[8];
#pragma unroll
                for (int i = 0; i < 4; ++i) { cur[i] = acc[ai][0][m][0][i]; cur[4 + i] = acc[ai][0][m][1][i]; up[i] = acc[ai][1][m][0][i]; up[4 + i] = acc[ai][1][m][1][i]; }
                const int row = u.pm * BM + ai * HALF + wr * 64 + m * 16 + fr;
#pragma unroll
                for (int i = 0; i < 8; ++i) {
                    const float r1 = dpp_ror1(cur[i]), r2 = dpp_ror2(cur[i]);
                    const float p1 = (fr >= 1) ? r1 : r1p[i], p2 = (fr >= 2) ? r2 : r2p[i];
                    const float g = w0[i] * p2 + w1[i] * p1 + w2[i] * cur[i];
                    o[i] = g / (1.0f + __expf(-g)) * up[i];
                    r1p[i] = r1; r2p[i] = r2;
                }
                const bool first2 = ext && m == 0 && fr < 2 && u.pm > 0;
                if (!first2) {
                    u32x4 w; w.x = cvt_pk_bf16(o[0], o[1]); w.y = cvt_pk_bf16(o[2], o[3]); w.z = cvt_pk_bf16(o[4], o[5]); w.w = cvt_pk_bf16(o[6], o[7]);
                    *(u32x4*)(ACT + (size_t)row * DFF + ch0) = w;
                } else {
                    float* fg = FIRSTG + (size_t)(u.pm * 2 + fr) * DFF + ch0; float* fu = FIRSTU + (size_t)(u.pm * 2 + fr) * DFF + ch0;
                    *(f32x4*)fg = acc[ai][0][m][0]; *(f32x4*)(fg + 4) = acc[ai][0][m][1]; *(f32x4*)fu = acc[ai][1][m][0]; *(f32x4*)(fu + 4) = acc[ai][1][m][1];
                }
                if (ai == 1 && wr == 1 && m == 3 && fr >= 14) { float* hg = HALOG + (size_t)(u.pm * 2 + fr - 14) * DFF + ch0; *(f32x4*)hg = acc[ai][0][m][0]; *(f32x4*)(hg + 4) = acc[ai][0][m][1]; }
            }
        }
    }
};

template <class Epi, class Sched, bool ALIGN_EPI>
__device__ __forceinline__ void gemm_phase(LAS unsigned char* lds, const Gemm g, const Sched& S, const Epi& E) {
    const int tid = fresh_tid(), wid = __builtin_amdgcn_readfirstlane(tid >> 6), lane = tid & 63, wr = wid >> 2, wc = wid & 3, fr = lane & 15, fq = lane >> 4;
    const int K = g.K, nt = K / BK;
    unsigned voffA[2], voffB[2];
#pragma unroll
    for (int i = 0; i < 2; ++i) { int R, C; stage_rc(tid * 16 + i * 8192, R, C); const int Rb = Epi::PERM ? ((R & ~31) + perm32(R & 31)) : R;
        voffA[i] = (unsigned)(R * g.lda + C) * 2u; voffB[i] = (unsigned)(Rb * g.ldb + C) * 2u; }
    const size_t kstep = (size_t)(BK * 2);
    const size_t hstepA = (size_t)HALF * g.lda * 2, hstepB = (size_t)HALF * g.ldb * 2;
    const size_t tstepA = 2 * hstepA, tstepB = 2 * hstepB;
    const unsigned ldsw = (unsigned)wid * 1024u;
    const int aoff = lds_byte(wr * 64 + fr, fq * 8), boff = lds_byte(wc * 32 + fr, fq * 8);
#define PG8_SA(b, h) (((b) * 2 + (h)) * HTB)
#define PG8_SB(b, h) ((4 + (b) * 2 + (h)) * HTB)
#define PG8_STAGE(bufoff, gbase, voff) do { _Pragma("unroll") for (int _i = 0; _i < 2; ++_i) \
        __builtin_amdgcn_global_load_lds((const unsigned*)((const char*)(gbase) + (voff)[_i]), (LAS unsigned*)(lds + (bufoff) + ldsw + _i * 8192), 16, 0, 0); } while (0)
#define PG8_LDA(dst, b, h) do { _Pragma("unroll") for (int m = 0; m < 4; ++m) _Pragma("unroll") for (int k = 0; k < 2; ++k) dst[m][k] = *(const LAS bf16x8*)(lds + PG8_SA(b, h) + aoff + m * 2048 + k * 1024); } while (0)
#define PG8_LDB(dst, b, h) do { _Pragma("unroll") for (int n = 0; n < 2; ++n) _Pragma("unroll") for (int k = 0; k < 2; ++k) dst[n][k] = *(const LAS bf16x8*)(lds + PG8_SB(b, h) + boff + n * 2048 + k * 1024); } while (0)
#define PG8_MMA(ai, bj, At, Bt) do { __builtin_amdgcn_s_setprio(1); _Pragma("unroll") for (int m = 0; m < 4; ++m) _Pragma("unroll") for (int n = 0; n < 2; ++n) _Pragma("unroll") for (int k = 0; k < 2; ++k) \
        acc[ai][bj][m][n] = __builtin_amdgcn_mfma_f32_16x16x32_bf16(Bt[n][k], At[m][k], acc[ai][bj][m][n], 0, 0, 0); __builtin_amdgcn_s_setprio(0); } while (0)
#define PG8_WAIT_V(n) asm volatile("s_waitcnt vmcnt(" #n ")" ::: "memory")
#define PG8_WAIT_L(n) asm volatile("s_waitcnt lgkmcnt(" #n ")" ::: "memory")
#define PG8_BAR __builtin_amdgcn_s_barrier()
#define PG8_SCHED __builtin_amdgcn_sched_barrier(0)
    Unit cur, nxt; int ui = 0;
    if (!S.next(0, cur)) return;
    f32x4 acc[2][2][4][2];
#pragma unroll
    for (int a = 0; a < 2; ++a)
#pragma unroll
        for (int b = 0; b < 2; ++b)
#pragma unroll
            for (int m = 0; m < 4; ++m)
#pragma unroll
                for (int n = 0; n < 2; ++n) acc[a][b][m][n] = (f32x4){0.f, 0.f, 0.f, 0.f};
    bf16x8 At[4][2], B0[2][2], B1[2][2];
    const char* cA = (const char*)g.A + (size_t)cur.pm * tstepA; const char* cB = (const char*)g.Bt + (size_t)cur.pn * tstepB;
    S.a_ready(cur);
    PG8_STAGE(PG8_SB(0, 0), cB, voffB); PG8_STAGE(PG8_SB(0, 1), cB + hstepB, voffB); PG8_STAGE(PG8_SA(0, 0), cA, voffA); PG8_STAGE(PG8_SA(0, 1), cA + hstepA, voffA);
    if (wr == 1) PG8_BAR;
    PG8_WAIT_V(2); PG8_BAR;
    PG8_STAGE(PG8_SB(1, 0), cB + kstep, voffB); PG8_STAGE(PG8_SA(1, 0), cA + kstep, voffA); PG8_STAGE(PG8_SB(1, 1), cB + hstepB + kstep, voffB);
    PG8_WAIT_V(6); PG8_BAR;
    for (;;) {
        const bool has_next = S.next(ui + 1, nxt);
        const char* nA = has_next ? (const char*)g.A + (size_t)nxt.pm * tstepA : cA; const char* nB = has_next ? (const char*)g.Bt + (size_t)nxt.pn * tstepB : cB;
        for (int t = 0; t < nt; t += 2) {
            const bool last = (t == nt - 2);
            const char* a1 = cA + (size_t)(t + 1) * kstep;
            const char* a2 = last ? nA : cA + (size_t)(t + 2) * kstep; const char* b2 = last ? nB : cB + (size_t)(t + 2) * kstep;
            const char* a3 = a2 + kstep; const char* b3 = b2 + kstep;
            if (last && has_next) S.a_ready(nxt);
            PG8_LDB(B0, 0, 0); PG8_LDB(B1, 0, 1); PG8_SCHED; PG8_LDA(At, 0, 0); PG8_STAGE(PG8_SA(1, 1), a1 + hstepA, voffA);
            PG8_WAIT_V(8); PG8_WAIT_L(0); PG8_BAR; PG8_MMA(0, 0, At, B0); PG8_MMA(0, 1, At, B1); PG8_BAR; PG8_SCHED;
            PG8_LDA(At, 0, 1); PG8_STAGE(PG8_SB(0, 0), b2, voffB); PG8_STAGE(PG8_SB(0, 1), b2 + hstepB, voffB); PG8_STAGE(PG8_SA(0, 0), a2, voffA);
            PG8_WAIT_V(8); PG8_WAIT_L(0); PG8_BAR; PG8_MMA(1, 0, At, B0); PG8_MMA(1, 1, At, B1); PG8_BAR; PG8_SCHED;
            PG8_LDB(B0, 1, 0); PG8_LDB(B1, 1, 1); PG8_SCHED; PG8_LDA(At, 1, 0); PG8_STAGE(PG8_SA(0, 1), a2 + hstepA, voffA);
            PG8_WAIT_V(8); PG8_WAIT_L(0); PG8_BAR; PG8_MMA(0, 0, At, B0); PG8_MMA(0, 1, At, B1); PG8_BAR; PG8_SCHED;
            PG8_LDA(At, 1, 1); PG8_STAGE(PG8_SB(1, 0), b3, voffB); PG8_STAGE(PG8_SB(1, 1), b3 + hstepB, voffB); PG8_STAGE(PG8_SA(1, 0), a3, voffA);
            PG8_WAIT_V(8); PG8_WAIT_L(0); PG8_BAR; PG8_MMA(1, 0, At, B0); PG8_MMA(1, 1, At, B1); PG8_BAR; PG8_SCHED;
        }
        if constexpr (ALIGN_EPI) { if (wr == 0) PG8_BAR; }
        E(acc, cur, wr, wc, fr, fq); S.done(cur);
        if (!has_next) break;
#pragma unroll
        for (int a = 0; a < 2; ++a)
#pragma unroll
            for (int b = 0; b < 2; ++b)
#pragma unroll
                for (int m = 0; m < 4; ++m)
#pragma unroll
                    for (int n = 0; n < 2; ++n) acc[a][b][m][n] = (f32x4){0.f, 0.f, 0.f, 0.f};
        cur = nxt; cA = nA; cB = nB; ++ui;
        if constexpr (ALIGN_EPI) { if (wr == 1) PG8_BAR; }
    }
    PG8_WAIT_V(0);
    if constexpr (!ALIGN_EPI) { if (wr == 0) PG8_BAR; }
    PG8_BAR;
#undef PG8_SA
#undef PG8_SB
#undef PG8_STAGE
#undef PG8_LDA
#undef PG8_LDB
#undef PG8_MMA
#undef PG8_WAIT_V
#undef PG8_WAIT_L
#undef PG8_BAR
#undef PG8_SCHED
}
}

#define XB_TMO      128
#define XB_XCNT(j)  (256  + 64 * (j))
#define XB_XSUB(j)  (1280 + 64 * (j))
#define XB_XGEN(j)  (2304 + 64 * (j))
#define XB_TOP      3328
#define XB_TOPGEN   3392
#define XCD_BAR_WORDS 3456
#define XB_SPIN_CAP (1u << 18)
__device__ __forceinline__ unsigned xb_ld(unsigned* p)              { return __hip_atomic_load(p, __ATOMIC_RELAXED, __HIP_MEMORY_SCOPE_AGENT); }
__device__ __forceinline__ unsigned xb_add(unsigned* p, unsigned v) { return __hip_atomic_fetch_add(p, v, __ATOMIC_RELAXED, __HIP_MEMORY_SCOPE_AGENT); }
__device__ __forceinline__ unsigned xb_xcc_id() { return (unsigned)__builtin_amdgcn_s_getreg((3 << 11) | 20) & 0xFu; }
#define XB_SPIN(cond, bar) do { unsigned _sp = 0; while (cond) { __builtin_amdgcn_s_sleep(1); \
    if ((++_sp & 255u) == 0u) { if (xb_ld(&(bar)[XB_TMO])) break; if (_sp > XB_SPIN_CAP) { atomicAdd(&(bar)[XB_TMO], 1u); break; } } } } while (0)
struct XcdBarrier { unsigned* bar; unsigned x; volatile LAS unsigned* st; };
__device__ __forceinline__ XcdBarrier xcd_barrier_post(unsigned* bar, volatile LAS unsigned* st) {
    XcdBarrier b; b.bar = bar; b.x = xb_xcc_id(); b.st = st;
    if (threadIdx.x == 0) (void)xb_add(&bar[XB_XCNT(b.x)], 1u);
    return b;
}
__device__ __forceinline__ void xcd_barrier_complete(unsigned* bar, unsigned x, unsigned& nloc, unsigned& nx) {
    const unsigned G = gridDim.x * gridDim.y * gridDim.z;
    unsigned sum, cnt, mine, sp = 0u;
    for (;;) {
        sum = 0u; cnt = 0u; mine = 0u;
#pragma unroll
        for (unsigned j = 0; j < 16; ++j) { const unsigned c = xb_ld(&bar[XB_XCNT(j)]); sum += c; cnt += (c > 0u) ? 1u : 0u; mine = (j == x) ? c : mine; }
        if (sum == G) break;
        __builtin_amdgcn_s_sleep(1);
        if ((++sp & 255u) == 0u) { if (xb_ld(&bar[XB_TMO])) break; if (sp > XB_SPIN_CAP) { atomicAdd(&bar[XB_TMO], 1u); break; } }
    }
    nloc = mine > 0u ? mine : 1u; nx = cnt > 0u ? cnt : 1u;
}
__device__ __forceinline__ void xcd_barrier(const XcdBarrier& b) {
    asm volatile("s_waitcnt vmcnt(0)" ::: "memory");
    __syncthreads();
    if (threadIdx.x == 0) {
        unsigned* bar = b.bar;
        __builtin_amdgcn_s_waitcnt(0);
        unsigned nloc = b.st[0], nx = b.st[1];
        if (nloc == 0u) { xcd_barrier_complete(bar, b.x, nloc, nx); b.st[0] = nloc; b.st[1] = nx; }
        const unsigned old = xb_add(&bar[XB_XSUB(b.x)], 1u);
        const unsigned gen = old / nloc;
        if (old + 1u == (gen + 1u) * nloc) {
            __builtin_amdgcn_fence(__ATOMIC_RELEASE, "agent");
            asm volatile("s_waitcnt vmcnt(0)" ::: "memory");
            const unsigned og = xb_add(&bar[XB_TOP], 1u);
            const unsigned tg = og / nx;
            if (og + 1u == (tg + 1u) * nx) xb_add(&bar[XB_TOPGEN], 1u);
            else XB_SPIN(xb_ld(&bar[XB_TOPGEN]) == tg, bar);
            __builtin_amdgcn_fence(__ATOMIC_ACQUIRE, "agent");
            xb_add(&bar[XB_XGEN(b.x)], 1u);
            asm volatile("s_waitcnt vmcnt(0)" ::: "memory");
        } else {
            XB_SPIN(xb_ld(&bar[XB_XGEN(b.x)]) == gen, bar);
            __builtin_amdgcn_fence(__ATOMIC_ACQUIRE, "agent");
            asm volatile("s_waitcnt vmcnt(0)" ::: "memory");
        }
    }
    __syncthreads();
}

template <int MODE  >
__device__ __forceinline__ void cvt_matrix(const float* W, int K, int N, bf16_t* WT, int row_off, LAS float* scr, int gw, int ngw, int) {
    const int lane = fresh_lane();
    const int nblk = N / 32, nitems = (K / 64) * nblk;
    for (int item = gw; item < nitems; item += ngw) {
        const int kb = item / nblk, nb = item % nblk, k0 = 64 * kb, n0 = 32 * nb;
#pragma unroll 8
        for (int i = 0; i < 32; ++i) { const int kk = 2 * i + (lane >> 5); scr[kk * 33 + (lane & 31)] = W[(size_t)(k0 + kk) * N + n0 + (lane & 31)]; }
        asm volatile("s_waitcnt lgkmcnt(0)" ::: "memory");
        int d0 = n0;
        if (MODE == 1) { if (n0 < 9 * GW && (n0 % (3 * GW)) < 2 * GW) d0 = (n0 & ~0xC0) | ((n0 & 0x40) << 1) | ((n0 & 0x80) >> 1); }
        if (MODE == 2) d0 = (n0 >> 7) * 256 + (n0 & 127);
        if (MODE == 3) d0 = (n0 >> 7) * 256 + 128 + (n0 & 127);
        const int c = lane & 7;
#pragma unroll
        for (int j = 0; j < 4; ++j) { const int n = (lane >> 3) + 8 * j; const LAS float* s = scr + (8 * c) * 33 + n;
            u32x4 o; o.x = cvt_pk_bf16(s[0 * 33], s[1 * 33]); o.y = cvt_pk_bf16(s[2 * 33], s[3 * 33]); o.z = cvt_pk_bf16(s[4 * 33], s[5 * 33]); o.w = cvt_pk_bf16(s[6 * 33], s[7 * 33]);
            *(u32x4*)(WT + (size_t)(row_off + d0 + n) * K + k0 + 8 * c) = o; }
        asm volatile("s_waitcnt lgkmcnt(0)" ::: "memory");
    }
}
__device__ __forceinline__ void rms_row_to_bf16(const float* xrow, const float* g, bf16_t* orow, int) {
    const int lane = fresh_lane();
    const f32x4* xr = (const f32x4*)xrow + lane;
    f32x4 v[16]; float s = 0.f;
#pragma unroll
    for (int j = 0; j < 16; ++j) { v[j] = xr[64 * j]; s += (v[j].x * v[j].x + v[j].y * v[j].y) + (v[j].z * v[j].z + v[j].w * v[j].w); }
    const float rstd = 1.0f / sqrtf(wave_sum(s) * (1.f / DM) + EPS);
    const f32x4* gr = (const f32x4*)g + lane; u32x2* o8 = (u32x2*)orow + lane;
#pragma unroll
    for (int j = 0; j < 16; ++j) { const f32x4 gv = gr[64 * j]; u32x2 w; w.x = cvt_pk_bf16(v[j].x * rstd * gv.x, v[j].y * rstd * gv.y); w.y = cvt_pk_bf16(v[j].z * rstd * gv.z, v[j].w * rstd * gv.w); o8[64 * j] = w; }
}
__device__ __forceinline__ void norm_res_row(const float* xsrc, const bf16_t* yrow, const float* gpost, const float* gpre, float* xout, bf16_t* xn, int) {
    const int lane = fresh_lane();
    const u32x2* yr = (const u32x2*)yrow + lane; f32x4 y[16]; float s = 0.f;
#pragma unroll
    for (int j = 0; j < 16; ++j) { const u32x2 w = yr[64 * j]; y[j] = (f32x4){bf_lo(w.x), bf_hi(w.x), bf_lo(w.y), bf_hi(w.y)}; s += (y[j].x * y[j].x + y[j].y * y[j].y) + (y[j].z * y[j].z + y[j].w * y[j].w); }
    const float rstd = 1.0f / sqrtf(wave_sum(s) * (1.f / DM) + EPS);
    const f32x4* xr = (const f32x4*)xsrc + lane; const f32x4* gp = (const f32x4*)gpost + lane; f32x4* xo = (f32x4*)xout + lane; float s2 = 0.f;
#pragma unroll
    for (int j = 0; j < 16; ++j) { const f32x4 xv = xr[64 * j], gv = gp[64 * j]; y[j] = xv + y[j] * rstd * gv; xo[64 * j] = y[j]; s2 += (y[j].x * y[j].x + y[j].y * y[j].y) + (y[j].z * y[j].z + y[j].w * y[j].w); }
    if (xn) {
        const float rstd2 = 1.0f / sqrtf(wave_sum(s2) * (1.f / DM) + EPS);
        const f32x4* gr = (const f32x4*)gpre + lane; u32x2* o8 = (u32x2*)xn + lane;
#pragma unroll
        for (int j = 0; j < 16; ++j) { const f32x4 gv = gr[64 * j]; u32x2 w; w.x = cvt_pk_bf16(y[j].x * rstd2 * gv.x, y[j].y * rstd2 * gv.y); w.y = cvt_pk_bf16(y[j].z * rstd2 * gv.z, y[j].w * rstd2 * gv.w); o8[64 * j] = w; }
    }
}
__device__ __forceinline__ void unpack8(const u32x4 w, float (&f)[8]) { f[0] = bf_lo(w.x); f[1] = bf_hi(w.x); f[2] = bf_lo(w.y); f[3] = bf_hi(w.y); f[4] = bf_lo(w.z); f[5] = bf_hi(w.z); f[6] = bf_lo(w.w); f[7] = bf_hi(w.w); }
__device__ __forceinline__ u32x4 pack8f(const float (&f)[8]) { u32x4 w; w.x = cvt_pk_bf16(f[0], f[1]); w.y = cvt_pk_bf16(f[2], f[3]); w.z = cvt_pk_bf16(f[4], f[5]); w.w = cvt_pk_bf16(f[6], f[7]); return w; }

__device__ __forceinline__ void conv_gate_phase(const bf16_t* H, const float* cw  , bf16_t* A2  , int gtid, int nthreads) {
    constexpr int RB = 32, NCG = CW / 8, NIT = (SEQ / RB) * NCG;
    asm volatile("" : "+v"(gtid));
    for (int it = gtid; it < NIT; it += nthreads) {
        const int cg = it % NCG, rb = it / NCG, c0 = cg * 8, t0 = rb * RB;
        float w0[8], w1[8], w2[8], m2[8], m1[8];
#pragma unroll
        for (int i = 0; i < 8; ++i) { w0[i] = cw[c0 + i]; w1[i] = cw[CW + c0 + i]; w2[i] = cw[2 * CW + c0 + i]; m2[i] = 0.f; m1[i] = 0.f; }
        if (t0 >= 2) {
            float a[8], b[8];
            unpack8(*(const u32x4*)(H + (size_t)(t0 - 2) * N_CI + CW + c0), a); unpack8(*(const u32x4*)(H + (size_t)(t0 - 2) * N_CI + 2 * CW + c0), b);
#pragma unroll
            for (int i = 0; i < 8; ++i) m2[i] = a[i] * b[i];
            unpack8(*(const u32x4*)(H + (size_t)(t0 - 1) * N_CI + CW + c0), a); unpack8(*(const u32x4*)(H + (size_t)(t0 - 1) * N_CI + 2 * CW + c0), b);
#pragma unroll
            for (int i = 0; i < 8; ++i) m1[i] = a[i] * b[i];
        }
#pragma unroll 4
        for (int r = 0; r < RB; ++r) {
            const bf16_t* hr = H + (size_t)(t0 + r) * N_CI + c0;
            float bg[8], cgt[8], uu[8], o[8];
            unpack8(*(const u32x4*)(hr), bg); unpack8(*(const u32x4*)(hr + CW), cgt); unpack8(*(const u32x4*)(hr + 2 * CW), uu);
#pragma unroll
            for (int i = 0; i < 8; ++i) { const float cu = cgt[i] * uu[i]; o[i] = bg[i] * (w0[i] * m2[i] + w1[i] * m1[i] + w2[i] * cu); m2[i] = m1[i]; m1[i] = cu; }
            *(u32x4*)(A2 + (size_t)(t0 + r) * K_CO + c0) = pack8f(o);
        }
    }
}
__device__ __forceinline__ void ffn_fix_phase(const float* HALOG, const float* FIRSTG, const float* FIRSTU, const float* cw, bf16_t* ACT, int gtid, int nthreads) {
    constexpr int NC4 = DFF / 4, NIT = 31 * NC4;
    asm volatile("" : "+v"(gtid));
    for (int it = gtid; it < NIT; it += nthreads) {
        const int pm = 1 + it / NC4, c = (it % NC4) * 4;
        const f32x4 gm2 = *(const f32x4*)(HALOG + (size_t)((pm - 1) * 2 + 0) * DFF + c), gm1 = *(const f32x4*)(HALOG + (size_t)((pm - 1) * 2 + 1) * DFF + c);
        const f32x4 g0 = *(const f32x4*)(FIRSTG + (size_t)(pm * 2 + 0) * DFF + c), g1 = *(const f32x4*)(FIRSTG + (size_t)(pm * 2 + 1) * DFF + c);
        const f32x4 u0 = *(const f32x4*)(FIRSTU + (size_t)(pm * 2 + 0) * DFF + c), u1 = *(const f32x4*)(FIRSTU + (size_t)(pm * 2 + 1) * DFF + c);
        const f32x4 w0 = *(const f32x4*)(cw + c), w1 = *(const f32x4*)(cw + DFF + c), w2 = *(const f32x4*)(cw + 2 * DFF + c);
        float o0[4], o1[4];
#pragma unroll
        for (int i = 0; i < 4; ++i) { const float a = w0[i] * gm2[i] + w1[i] * gm1[i] + w2[i] * g0[i], b = w0[i] * gm1[i] + w1[i] * g0[i] + w2[i] * g1[i];
            o0[i] = a / (1.0f + __expf(-a)) * u0[i]; o1[i] = b / (1.0f + __expf(-b)) * u1[i]; }
        u32x2 w; w.x = cvt_pk_bf16(o0[0], o0[1]); w.y = cvt_pk_bf16(o0[2], o0[3]); *(u32x2*)(ACT + (size_t)(256 * pm) * DFF + c) = w;
        w.x = cvt_pk_bf16(o1[0], o1[1]); w.y = cvt_pk_bf16(o1[2], o1[3]); *(u32x2*)(ACT + (size_t)(256 * pm + 1) * DFF + c) = w;
    }
}
__device__ __forceinline__ void merge_phase(const bf16_t* OG  , const float* LSE  , bf16_t* A2  , int gtid, int nthreads) {
    constexpr int NIT = SEQ * (GW / 8);
    asm volatile("" : "+v"(gtid));
    for (int it = gtid; it < NIT; it += nthreads) {
        const int ch = it % (GW / 8), t = it / (GW / 8), hd = ch >> 4, d8 = (ch & 15) * 8;
        const int r0 = t, r1 = (t & 3) * (SEQ / 4) + (t >> 2), r2 = (t & 15) * (SEQ / 16) + (t >> 4);
        const float l0 = LSE[(size_t)(0 * 16 + hd) * SEQ + r0], l1 = LSE[(size_t)(1 * 16 + hd) * SEQ + r1], l2 = LSE[(size_t)(2 * 16 + hd) * SEQ + r2];
        const float mx = fmaxf(l0, fmaxf(l1, l2));
        const float e0 = __expf(l0 - mx), e1 = __expf(l1 - mx), e2 = __expf(l2 - mx), inv = 1.0f / (e0 + e1 + e2);
        float a[8], b[8], c[8], o[8];
        unpack8(*(const u32x4*)(OG + ((size_t)(0 * 16 + hd) * SEQ + r0) * HDIM + d8), a); unpack8(*(const u32x4*)(OG + ((size_t)(1 * 16 + hd) * SEQ + r1) * HDIM + d8), b); unpack8(*(const u32x4*)(OG + ((size_t)(2 * 16 + hd) * SEQ + r2) * HDIM + d8), c);
#pragma unroll
        for (int i = 0; i < 8; ++i) o[i] = (e0 * a[i] + e1 * b[i] + e2 * c[i]) * inv;
        *(u32x4*)(A2 + (size_t)t * K_AO + ch * 8) = pack8f(o);
    }
}

template <int HD, int STR>
__device__ __forceinline__ void attn_load_tile(LAS unsigned char* dst, const bf16_t* src, long stride, int valid_from, int tid) {
    constexpr int CPR = HD / 8, PER = 256 * CPR / 512;
    u32x4 v[PER];
#pragma unroll
    for (int j = 0; j < PER; ++j) { const int idx = tid + 512 * j, row = idx / CPR, ch = idx % CPR;
        v[j] = (u32x4){0u, 0u, 0u, 0u}; if (row >= valid_from) v[j] = *(const u32x4*)(src + (long)row * stride + ch * 8); }
#pragma unroll
    for (int j = 0; j < PER; ++j) { const int idx = tid + 512 * j, row = idx / CPR, ch = idx % CPR; *(LAS u32x4*)(dst + row * STR + ch * 16) = v[j]; }
}
template <int HD, int NT, bool DIL>
__device__ __forceinline__ void attn_unit(LAS unsigned char* lds, const bf16_t* Qp, long qstride, const bf16_t* Kp, const bf16_t* Vp, long kvstride, int valid_from,
                                          bf16_t* Op, long ostride, float* lsep, float scale) {
    constexpr int KSTR = HD * 2 + 16, VSTR = HD * 2 + 32, NC = (NT + 1) / 2, NDT = HD / 16, NQC = HD / 32;
    constexpr bool BOTH = (256 * KSTR + 256 * VSTR) <= LDSCTL_OFF;
    const int tid = fresh_tid(), w = __builtin_amdgcn_readfirstlane(tid >> 6), lane = tid & 63, lq = lane & 15, g4 = lane >> 4;
    LAS unsigned char* Kl = lds; LAS unsigned char* Vl = BOTH ? lds + 256 * KSTR : lds;
    __syncthreads();
    attn_load_tile<HD, KSTR>(Kl, Kp, kvstride, valid_from, tid);
    if (BOTH) attn_load_tile<HD, VSTR>(Vl, Vp, kvstride, valid_from, tid);
    bf16x8 qf[NQC];
#pragma unroll
    for (int c = 0; c < NQC; ++c) qf[c] = *(const bf16x8*)(Qp + (long)(16 * w + lq) * qstride + 32 * c + 8 * g4);
    __syncthreads();
    const int jt0 = DIL ? w : 0;
    f32x4 s[NT];
#pragma unroll
    for (int j = 0; j < NT; ++j) { s[j] = (f32x4){0.f, 0.f, 0.f, 0.f}; const LAS unsigned char* kr = Kl + (16 * (jt0 + j) + lq) * KSTR + 16 * g4;
#pragma unroll
        for (int c = 0; c < NQC; ++c) { const bf16x8 kf = *(const LAS bf16x8*)(kr + 64 * c); s[j] = __builtin_amdgcn_mfma_f32_16x16x32_bf16(kf, qf[c], s[j], 0, 0, 0); } }
    if (!BOTH) { __syncthreads(); attn_load_tile<HD, VSTR>(Vl, Vp, kvstride, valid_from, tid); }
    const float NEG = -__builtin_inff();
    float mx = NEG;
    const int qi = 16 * w + lq;
#pragma unroll
    for (int j = 0; j < NT; ++j)
#pragma unroll
        for (int e = 0; e < 4; ++e) { if (DIL) { const int kr = 16 * (jt0 + j) + 4 * g4 + e; const bool ok = (kr >= qi) && (kr <= qi + 128) && (kr >= valid_from); s[j][e] = ok ? s[j][e] : NEG; } mx = fmaxf(mx, s[j][e]); }
    mx = fmaxf(mx, __shfl_xor(mx, 16)); mx = fmaxf(mx, __shfl_xor(mx, 32));
    const float c2 = scale * 1.4426950408889634f, mb = -mx * c2; float sum = 0.f;
#pragma unroll
    for (int j = 0; j < NT; ++j)
#pragma unroll
        for (int e = 0; e < 4; ++e) { const float p = __builtin_amdgcn_exp2f(fmaf(s[j][e], c2, mb)); s[j][e] = p; sum += p; }
    sum += __shfl_xor(sum, 16); sum += __shfl_xor(sum, 32);
    const float inv = 1.0f / sum;
    bf16x8 pf[NC];
#pragma unroll
    for (int cc = 0; cc < NC; ++cc) { u32x4 wv; wv.x = cvt_pk_bf16(s[2 * cc][0], s[2 * cc][1]); wv.y = cvt_pk_bf16(s[2 * cc][2], s[2 * cc][3]);
        if (2 * cc + 1 < NT) { wv.z = cvt_pk_bf16(s[(2 * cc + 1) % NT][0], s[(2 * cc + 1) % NT][1]); wv.w = cvt_pk_bf16(s[(2 * cc + 1) % NT][2], s[(2 * cc + 1) % NT][3]); } else { wv.z = 0u; wv.w = 0u; }
        pf[cc] = __builtin_bit_cast(bf16x8, wv); }
    if (!BOTH) __syncthreads();
    f32x4 o[NDT];
#pragma unroll
    for (int dt = 0; dt < NDT; ++dt) o[dt] = (f32x4){0.f, 0.f, 0.f, 0.f};
    const unsigned vbase = (unsigned)(size_t)Vl + (unsigned)((16 * jt0 + 4 * g4 + (lq >> 2)) * VSTR + (lq & 3) * 8);
#pragma unroll
    for (int cc = 0; cc < NC; ++cc) {
        const unsigned va = vbase + (unsigned)(cc * 32 * VSTR);
        constexpr int T1OFF = 16 * VSTR;
        const bool has1 = (2 * cc + 1 < NT);
#pragma unroll
        for (int d4 = 0; d4 < NDT; d4 += 4) {
            s16x4 a0, a1, a2, a3, b0, b1, b2, b3;
#define TRRD(dst, addr, off) asm volatile("ds_read_b64_tr_b16 %0, %1 offset:%2" : "=&v"(dst) : "v"(addr), "i"(off) : "memory")
            if (has1) {
                TRRD(a0, va, (d4 + 0) * 32); TRRD(b0, va, (d4 + 0) * 32 + T1OFF); TRRD(a1, va, (d4 + 1) * 32); TRRD(b1, va, (d4 + 1) * 32 + T1OFF);
                TRRD(a2, va, (d4 + 2) * 32); TRRD(b2, va, (d4 + 2) * 32 + T1OFF); TRRD(a3, va, (d4 + 3) * 32); TRRD(b3, va, (d4 + 3) * 32 + T1OFF);
            } else {
                TRRD(a0, va, (d4 + 0) * 32); TRRD(b0, va, (d4 + 0) * 32); TRRD(a1, va, (d4 + 1) * 32); TRRD(b1, va, (d4 + 1) * 32);
                TRRD(a2, va, (d4 + 2) * 32); TRRD(b2, va, (d4 + 2) * 32); TRRD(a3, va, (d4 + 3) * 32); TRRD(b3, va, (d4 + 3) * 32);
            }
#undef TRRD
            asm volatile("s_waitcnt lgkmcnt(0)" ::: "memory"); __builtin_amdgcn_sched_barrier(0);
            o[d4 + 0] = __builtin_amdgcn_mfma_f32_16x16x32_bf16((bf16x8){a0[0], a0[1], a0[2], a0[3], b0[0], b0[1], b0[2], b0[3]}, pf[cc], o[d4 + 0], 0, 0, 0);
            o[d4 + 1] = __builtin_amdgcn_mfma_f32_16x16x32_bf16((bf16x8){a1[0], a1[1], a1[2], a1[3], b1[0], b1[1], b1[2], b1[3]}, pf[cc], o[d4 + 1], 0, 0, 0);
            o[d4 + 2] = __builtin_amdgcn_mfma_f32_16x16x32_bf16((bf16x8){a2[0], a2[1], a2[2], a2[3], b2[0], b2[1], b2[2], b2[3]}, pf[cc], o[d4 + 2], 0, 0, 0);
            o[d4 + 3] = __builtin_amdgcn_mfma_f32_16x16x32_bf16((bf16x8){a3[0], a3[1], a3[2], a3[3], b3[0], b3[1], b3[2], b3[3]}, pf[cc], o[d4 + 3], 0, 0, 0);
        }
    }
    bf16_t* orow = Op + (long)qi * ostride + 4 * g4;
#pragma unroll
    for (int dt = 0; dt < NDT; ++dt) { u32x2 wv; wv.x = cvt_pk_bf16(o[dt][0] * inv, o[dt][1] * inv); wv.y = cvt_pk_bf16(o[dt][2] * inv, o[dt][3] * inv); *(u32x2*)(orow + 16 * dt) = wv; }
    if (lsep && g4 == 0) lsep[qi] = mx * scale + __logf(sum);
}


__device__ __forceinline__ void attn_dil_unit(LAS unsigned char* lds, const bf16_t* Qs, const bf16_t* Ks, const bf16_t* Vs, int valid_from, bf16_t* Os, float* lsep, float scale) {
    constexpr int NT = 9, NC = 5, NDT = 8;
    const int tid = fresh_tid(), w = __builtin_amdgcn_readfirstlane(tid >> 6), lane = tid & 63, lq = lane & 15, g4 = lane >> 4;
    LAS unsigned char* Kl = lds; LAS unsigned char* Vl = lds + 65536;
    __syncthreads();
#pragma unroll
    for (int i = 0; i < 8; ++i) { const int row = 32 * w + 4 * i + g4;
        __builtin_amdgcn_global_load_lds((const unsigned*)(Ks + (size_t)row * HDIM + ((lq ^ (row & 15)) << 3)), (LAS unsigned*)(Kl + (w * 8 + i) * 1024), 16, 0, 0);
        __builtin_amdgcn_global_load_lds((const unsigned*)(Vs + (size_t)row * HDIM + ((lq ^ ((row & 7) << 1)) << 3)), (LAS unsigned*)(Vl + (w * 8 + i) * 1024), 16, 0, 0); }
    bf16x8 qf[4];
#pragma unroll
    for (int c = 0; c < 4; ++c) qf[c] = *(const bf16x8*)(Qs + (size_t)(16 * w + lq) * HDIM + 32 * c + 8 * g4);
    asm volatile("s_waitcnt vmcnt(0)" ::: "memory");
    __syncthreads();
    f32x4 s[NT];
    { unsigned ko[4];
#pragma unroll
      for (int c = 0; c < 4; ++c) ko[c] = (unsigned)(((4 * c + g4) ^ lq) << 4);
      const LAS unsigned char* kb = Kl + (16 * w + lq) * 256;
#pragma unroll
      for (int j = 0; j < NT; ++j) { s[j] = (f32x4){0.f, 0.f, 0.f, 0.f};
#pragma unroll
        for (int c = 0; c < 4; ++c) { const bf16x8 kf = *(const LAS bf16x8*)(kb + j * 4096 + ko[c]); s[j] = __builtin_amdgcn_mfma_f32_16x16x32_bf16(kf, qf[c], s[j], 0, 0, 0); } } }
    const float NEG = -__builtin_inff();
    float mx = NEG;
    const int qi = 16 * w + lq;
#pragma unroll
    for (int j = 0; j < NT; ++j)
#pragma unroll
        for (int e = 0; e < 4; ++e) { const int kr = 16 * (w + j) + 4 * g4 + e; const bool ok = (kr >= qi) && (kr <= qi + 128) && (kr >= valid_from); s[j][e] = ok ? s[j][e] : NEG; mx = fmaxf(mx, s[j][e]); }
    mx = fmaxf(mx, __shfl_xor(mx, 16)); mx = fmaxf(mx, __shfl_xor(mx, 32));
    const float c2 = scale * 1.4426950408889634f, mb = -mx * c2; float sum = 0.f;
#pragma unroll
    for (int j = 0; j < NT; ++j)
#pragma unroll
        for (int e = 0; e < 4; ++e) { const float p = __builtin_amdgcn_exp2f(fmaf(s[j][e], c2, mb)); s[j][e] = p; sum += p; }
    sum += __shfl_xor(sum, 16); sum += __shfl_xor(sum, 32);
    const float inv = 1.0f / sum;
    bf16x8 pf[NC];
#pragma unroll
    for (int cc = 0; cc < NC; ++cc) { u32x4 wv; wv.x = cvt_pk_bf16(s[2 * cc][0], s[2 * cc][1]); wv.y = cvt_pk_bf16(s[2 * cc][2], s[2 * cc][3]);
        if (2 * cc + 1 < NT) { wv.z = cvt_pk_bf16(s[(2 * cc + 1) % NT][0], s[(2 * cc + 1) % NT][1]); wv.w = cvt_pk_bf16(s[(2 * cc + 1) % NT][2], s[(2 * cc + 1) % NT][3]); } else { wv.z = 0u; wv.w = 0u; }
        pf[cc] = __builtin_bit_cast(bf16x8, wv); }
    f32x4 o[NDT];
#pragma unroll
    for (int dt = 0; dt < NDT; ++dt) o[dt] = (f32x4){0.f, 0.f, 0.f, 0.f};
    const int q4 = lq >> 2, p4 = lq & 3, kx = ((4 * g4 + q4) & 7) << 5;
    const unsigned vb = (unsigned)(size_t)Vl + (unsigned)((16 * w + 4 * g4 + q4) * 256 + ((p4 >> 1) << 4) + ((p4 & 1) << 3));
    unsigned va[NDT];
#pragma unroll
    for (int dt = 0; dt < NDT; ++dt) va[dt] = vb + (unsigned)((dt << 5) ^ kx);
#define TRRD(dst, addr, off) asm volatile("ds_read_b64_tr_b16 %0, %1 offset:%2" : "=&v"(dst) : "v"(addr), "i"(off) : "memory")
#pragma unroll
    for (int cc = 0; cc < NC; ++cc) {
        const int o0 = cc * 32 * 256, o1 = (2 * cc + 1 < NT) ? o0 + 16 * 256 : o0;
#pragma unroll
        for (int d4 = 0; d4 < NDT; d4 += 4) {
            s16x4 a0, a1, a2, a3, b0, b1, b2, b3;
            if (cc == 0) { TRRD(a0, va[d4 + 0], 0 * 8192); TRRD(b0, va[d4 + 0], 0 * 8192 + 4096); TRRD(a1, va[d4 + 1], 0 * 8192); TRRD(b1, va[d4 + 1], 0 * 8192 + 4096); TRRD(a2, va[d4 + 2], 0 * 8192); TRRD(b2, va[d4 + 2], 0 * 8192 + 4096); TRRD(a3, va[d4 + 3], 0 * 8192); TRRD(b3, va[d4 + 3], 0 * 8192 + 4096); }
            if (cc == 1) { TRRD(a0, va[d4 + 0], 1 * 8192); TRRD(b0, va[d4 + 0], 1 * 8192 + 4096); TRRD(a1, va[d4 + 1], 1 * 8192); TRRD(b1, va[d4 + 1], 1 * 8192 + 4096); TRRD(a2, va[d4 + 2], 1 * 8192); TRRD(b2, va[d4 + 2], 1 * 8192 + 4096); TRRD(a3, va[d4 + 3], 1 * 8192); TRRD(b3, va[d4 + 3], 1 * 8192 + 4096); }
            if (cc == 2) { TRRD(a0, va[d4 + 0], 2 * 8192); TRRD(b0, va[d4 + 0], 2 * 8192 + 4096); TRRD(a1, va[d4 + 1], 2 * 8192); TRRD(b1, va[d4 + 1], 2 * 8192 + 4096); TRRD(a2, va[d4 + 2], 2 * 8192); TRRD(b2, va[d4 + 2], 2 * 8192 + 4096); TRRD(a3, va[d4 + 3], 2 * 8192); TRRD(b3, va[d4 + 3], 2 * 8192 + 4096); }
            if (cc == 3) { TRRD(a0, va[d4 + 0], 3 * 8192); TRRD(b0, va[d4 + 0], 3 * 8192 + 4096); TRRD(a1, va[d4 + 1], 3 * 8192); TRRD(b1, va[d4 + 1], 3 * 8192 + 4096); TRRD(a2, va[d4 + 2], 3 * 8192); TRRD(b2, va[d4 + 2], 3 * 8192 + 4096); TRRD(a3, va[d4 + 3], 3 * 8192); TRRD(b3, va[d4 + 3], 3 * 8192 + 4096); }
            if (cc == 4) { TRRD(a0, va[d4 + 0], 4 * 8192); TRRD(b0, va[d4 + 0], 4 * 8192); TRRD(a1, va[d4 + 1], 4 * 8192); TRRD(b1, va[d4 + 1], 4 * 8192); TRRD(a2, va[d4 + 2], 4 * 8192); TRRD(b2, va[d4 + 2], 4 * 8192); TRRD(a3, va[d4 + 3], 4 * 8192); TRRD(b3, va[d4 + 3], 4 * 8192); }
            (void)o0; (void)o1;
            asm volatile("s_waitcnt lgkmcnt(0)" ::: "memory"); __builtin_amdgcn_sched_barrier(0);
            o[d4 + 0] = __builtin_amdgcn_mfma_f32_16x16x32_bf16((bf16x8){a0[0], a0[1], a0[2], a0[3], b0[0], b0[1], b0[2], b0[3]}, pf[cc], o[d4 + 0], 0, 0, 0);
            o[d4 + 1] = __builtin_amdgcn_mfma_f32_16x16x32_bf16((bf16x8){a1[0], a1[1], a1[2], a1[3], b1[0], b1[1], b1[2], b1[3]}, pf[cc], o[d4 + 1], 0, 0, 0);
            o[d4 + 2] = __builtin_amdgcn_mfma_f32_16x16x32_bf16((bf16x8){a2[0], a2[1], a2[2], a2[3], b2[0], b2[1], b2[2], b2[3]}, pf[cc], o[d4 + 2], 0, 0, 0);
            o[d4 + 3] = __builtin_amdgcn_mfma_f32_16x16x32_bf16((bf16x8){a3[0], a3[1], a3[2], a3[3], b3[0], b3[1], b3[2], b3[3]}, pf[cc], o[d4 + 3], 0, 0, 0);
        }
    }
#undef TRRD
    bf16_t* orow = Os + (size_t)qi * HDIM + 4 * g4;
#pragma unroll
    for (int dt = 0; dt < NDT; ++dt) { u32x2 wv; wv.x = cvt_pk_bf16(o[dt][0] * inv, o[dt][1] * inv); wv.y = cvt_pk_bf16(o[dt][2] * inv, o[dt][3] * inv); *(u32x2*)(orow + 16 * dt) = wv; }
    if (g4 == 0) lsep[qi] = mx * scale + __logf(sum);
}

struct Args {
    const float* x; const float* mem; const int* pos; const float* g_mem; const float* w_mem_kv; const float* g_mix_pre; const float* g_mix_post; const float* g_ffn_pre; const float* g_ffn_post;
    const float* w_conv_in; const float* conv_mix_w; const float* w_conv_out; const float* w_attn_in; const float* w_attn_out; const float* w_ffn_gate; const float* w_ffn_up; const float* conv_ffn_w; const float* w_ffn_down;
    float* out; unsigned char* ws; int ph_lo, ph_hi;
};

__global__ void __launch_bounds__(512, 2) fwd_kernel(Args a) {
    extern __shared__ __attribute__((aligned(16))) unsigned char lds_raw[];
    LAS unsigned char* lds = (LAS unsigned char*)lds_raw;
    volatile LAS unsigned* MISC = (volatile LAS unsigned*)(lds + LDSCTL_OFF);
    const int tid = threadIdx.x, lane = tid & 63, wave = __builtin_amdgcn_readfirstlane(tid >> 6);
    const int G = gridDim.x, bx = blockIdx.x;
    const int gtid = bx * 512 + tid, nthreads = G * 512, gw = bx * 8 + wave, ngw = G * 8;
    unsigned char* ws = a.ws;
    unsigned* ctl = (unsigned*)(ws + WS_CTL);
    bf16_t* WKV = (bf16_t*)(ws + WS_WKV); bf16_t* WCI = (bf16_t*)(ws + WS_WCI); bf16_t* WCO = (bf16_t*)(ws + WS_WCO); bf16_t* WAI = (bf16_t*)(ws + WS_WAI); bf16_t* WAO = (bf16_t*)(ws + WS_WAO);
    bf16_t* WGU = (bf16_t*)(ws + WS_WGU); bf16_t* WD = (bf16_t*)(ws + WS_WD);
    bf16_t* XN = (bf16_t*)(ws + WS_XN); bf16_t* H = (bf16_t*)(ws + WS_R); bf16_t* GU = (bf16_t*)(ws + WS_R); bf16_t* Y = (bf16_t*)(ws + WS_R);
    bf16_t* QKVL = (bf16_t*)(ws + WS_R); bf16_t* QM = (bf16_t*)(ws + WS_R + 288 * MiB);
    bf16_t* ACT = (bf16_t*)(ws + WS_S); bf16_t* A2 = (bf16_t*)(ws + WS_S); bf16_t* OG = (bf16_t*)(ws + WS_S + 64 * MiB);
    bf16_t* MEMN = (bf16_t*)(ws + WS_MEMN); bf16_t* KV = (bf16_t*)(ws + WS_KV); float* COS = (float*)(ws + WS_COS); float* SIN = (float*)(ws + WS_SIN); float* LSE = (float*)(ws + WS_LSE);
    float* HALOG = (float*)(ws + WS_HALOG); float* FIRSTG = (float*)(ws + WS_FIRSTG); float* FIRSTU = (float*)(ws + WS_FIRSTU);

    for (int u = tid; u < (LDS_BYTES - LDSCTL_OFF) / 4; u += 512) ((LAS unsigned*)(lds + LDSCTL_OFF))[u] = 0u;
    __syncthreads();
    XcdBarrier bar; bar.bar = ctl + CW_BAR; bar.x = 0; bar.st = nullptr;
    if (ONE_LAUNCH) bar = xcd_barrier_post(ctl + CW_BAR, MISC + 8);
    const int lo = a.ph_lo, hi = a.ph_hi;
#define IN(k) (lo <= (k) && (k) < hi)
#define SEAM(k) do { if (IN(k) && IN((k) + 1)) xcd_barrier(bar); } while (0)
    constexpr size_t SZ_GU = (size_t)N_GU * DM, SZ_D = (size_t)DM * DFF;

    if (IN(0)) {
        LAS float* scr = (LAS float*)(lds + wave * 16384);
        cvt_matrix<0>(a.w_mem_kv, DM, 2 * MW, WKV, 0, scr, gw, ngw, lane);
        for (int m = gw; m < NMEM; m += ngw) rms_row_to_bf16(a.mem + (size_t)m * DM, a.g_mem, MEMN + (size_t)m * DM, lane);
        for (int m = gw; m < SEQ; m += ngw) rms_row_to_bf16(a.x + (size_t)m * DM, a.g_mix_pre, XN + (size_t)m * DM, lane);
        for (int idx = gtid; idx < SEQ * 64; idx += nthreads) { const int t = idx >> 6, i = idx & 63;
            const float ang = (float)a.pos[t] * INV_FREQ[i];
            const double kq = rint((double)ang * 0.15915494309189535); double r = fma(-kq, 6.283185307179586, (double)ang); r = fma(-kq, 2.4492935982947064e-16, r);
            const float rf = (float)r; COS[idx] = cosf(rf); SIN[idx] = sinf(rf); }
    }
    SEAM(0);
    if (IN(1)) {
        if (bx < 8) {
            pg8::Gemm g{MEMN, WKV, DM, DM, DM}; pg8::StaticOrder S; S.init(NMEM, 2 * MW, 8, bx);
            pg8::EpiStore E{KV, 2 * MW};
            pg8::gemm_phase<pg8::EpiStore, pg8::StaticOrder, true>(lds, g, S, E);
        } else {
            LAS float* scr = (LAS float*)(lds + wave * 16384);
            const int cw_ = (bx - 8) * 8 + wave, ncw = (G - 8) * 8;
            cvt_matrix<0>(a.w_conv_in, DM, N_CI, WCI, 0, scr, cw_, ncw, lane);
            cvt_matrix<0>(a.w_conv_out, K_CO, DM, WCO, 0, scr, cw_, ncw, lane);
            cvt_matrix<2>(a.w_ffn_gate, DM, DFF, WGU, 0, scr, cw_, ncw, lane);
            cvt_matrix<3>(a.w_ffn_up, DM, DFF, WGU, 0, scr, cw_, ncw, lane);
            cvt_matrix<0>(a.w_ffn_down, DFF, DM, WD, 0, scr, cw_, ncw, lane);
            cvt_matrix<1>(a.w_attn_in, DM, N_AI, WAI, 0, scr, cw_, ncw, lane);
            cvt_matrix<0>(a.w_attn_out, K_AO, DM, WAO, 0, scr, cw_, ncw, lane);
            cvt_matrix<2>(a.w_ffn_gate + SZ_D, DM, DFF, WGU + SZ_GU, 0, scr, cw_, ncw, lane);
            cvt_matrix<3>(a.w_ffn_up + SZ_D, DM, DFF, WGU + SZ_GU, 0, scr, cw_, ncw, lane);
            cvt_matrix<0>(a.w_ffn_down + SZ_D, DFF, DM, WD + SZ_D, 0, scr, cw_, ncw, lane);
        }
    }
    SEAM(1);
    if (IN(2)) {
        pg8::Gemm g{XN, WCI, DM, DM, DM}; pg8::StaticOrder S; S.init(SEQ, N_CI, G, bx);
        pg8::EpiStore E{H, N_CI};
        pg8::gemm_phase<pg8::EpiStore, pg8::StaticOrder, true>(lds, g, S, E);
    }
    SEAM(2);
    if (IN(3)) {
        for (int u = bx; u < 4 * (SEQ / 128); u += G) { const int hd = u / (SEQ / 128), qb = u % (SEQ / 128);
            attn_unit<256, 16, false>(lds, H + (size_t)(128 * qb) * N_CI + 3 * CW + 256 * hd, N_CI, KV + 256 * hd, KV + MW + 256 * hd, 2 * MW, 0,
                                      A2 + (size_t)(128 * qb) * K_CO + CW + 256 * hd, K_CO, nullptr, 0.0625f); }
        conv_gate_phase(H, a.conv_mix_w, A2, gtid, nthreads);
    }
    SEAM(3);
    if (IN(4)) {
        pg8::Gemm g{A2, WCO, K_CO, K_CO, K_CO}; pg8::StaticOrder S; S.init(SEQ, DM, G, bx);
        pg8::EpiStore E{Y, DM};
        pg8::gemm_phase<pg8::EpiStore, pg8::StaticOrder, true>(lds, g, S, E);
    }
    SEAM(4);
    if (IN(5)) { for (int m = gw; m < SEQ; m += ngw) norm_res_row(a.x + (size_t)m * DM, Y + (size_t)m * DM, a.g_mix_post, a.g_ffn_pre, a.out + (size_t)m * DM, XN + (size_t)m * DM, lane); }
    SEAM(5);
    if (IN(6)) {
        pg8::Gemm g{XN, WGU, DM, DM, DM}; pg8::StaticOrder S; S.init(SEQ, N_GU, G, bx);
        pg8::EpiFfn E{ACT, a.conv_ffn_w, HALOG, FIRSTG, FIRSTU, lds + RING_BYTES};
        pg8::gemm_phase<pg8::EpiFfn, pg8::StaticOrder, true>(lds, g, S, E);
    }
    SEAM(6);
    if (IN(7)) ffn_fix_phase(HALOG, FIRSTG, FIRSTU, a.conv_ffn_w, ACT, gtid, nthreads);
    SEAM(7);
    if (IN(8)) {
        pg8::Gemm g{ACT, WD, DFF, DFF, DFF}; pg8::StaticOrder S; S.init(SEQ, DM, G, bx);
        pg8::EpiStore E{Y, DM};
        pg8::gemm_phase<pg8::EpiStore, pg8::StaticOrder, true>(lds, g, S, E);
    }
    SEAM(8);
    if (IN(9)) { for (int m = gw; m < SEQ; m += ngw) norm_res_row(a.out + (size_t)m * DM, Y + (size_t)m * DM, a.g_ffn_post, a.g_mix_pre + DM, a.out + (size_t)m * DM, XN + (size_t)m * DM, lane); }
    SEAM(9);
    if (IN(10)) {
        pg8::Gemm g{XN, WAI, DM, DM, DM}; pg8::StaticOrder S; S.init(SEQ, N_AI, G, bx);
        pg8::EpiQKV E{QKVL, QM, COS, SIN};
        pg8::gemm_phase<pg8::EpiQKV, pg8::StaticOrder, true>(lds, g, S, E);
    }
    SEAM(10);
    if (IN(11)) {
        const int per = (3 * 16 * 64 + G - 1) / G;
        for (int k = 0; k < per; ++k) {
            const int u = bx * per + k; if (u >= 3 * 16 * 64) break;
            const int grp = u >> 10, rem = u & 1023, hd = rem >> 6, blk = rem & 63;
            const int dsh = 2 * grp, nbr = 64 >> dsh, r = blk / nbr, nb = blk % nbr;
            const size_t rowq = (size_t)r * (SEQ >> dsh) + 128 * nb;
            const bf16_t* qs = QKVL + ((size_t)((grp * 3 + 0) * NHEAD + hd) * SEQ + rowq) * HDIM;
            const bf16_t* ks = QKVL + ((size_t)((grp * 3 + 1) * NHEAD + hd) * SEQ + rowq) * HDIM - 128 * HDIM;
            const bf16_t* vs = QKVL + ((size_t)((grp * 3 + 2) * NHEAD + hd) * SEQ + rowq) * HDIM - 128 * HDIM;
            attn_dil_unit(lds, qs, ks, vs, nb == 0 ? 128 : 0, OG + ((size_t)(grp * NHEAD + hd) * SEQ + rowq) * HDIM, LSE + (size_t)(grp * NHEAD + hd) * SEQ + rowq, 0.08838834764831845f);
        }
        for (int u = bx; u < 4 * (SEQ / 128); u += G) { const int hd = u / (SEQ / 128), qb = u % (SEQ / 128);
            attn_unit<256, 16, false>(lds, QM + (size_t)(128 * qb) * MW + 256 * hd, MW, KV + 256 * hd, KV + MW + 256 * hd, 2 * MW, 0,
                                      A2 + (size_t)(128 * qb) * K_AO + GW + 256 * hd, K_AO, nullptr, 0.0625f); }
    }
    SEAM(11);
    if (IN(12)) merge_phase(OG, LSE, A2, gtid, nthreads);
    SEAM(12);
    if (IN(13)) {
        pg8::Gemm g{A2, WAO, K_AO, K_AO, K_AO}; pg8::StaticOrder S; S.init(SEQ, DM, G, bx);
        pg8::EpiStore E{Y, DM};
        pg8::gemm_phase<pg8::EpiStore, pg8::StaticOrder, true>(lds, g, S, E);
    }
    SEAM(13);
    if (IN(14)) { for (int m = gw; m < SEQ; m += ngw) norm_res_row(a.out + (size_t)m * DM, Y + (size_t)m * DM, a.g_mix_post + DM, a.g_ffn_pre + DM, a.out + (size_t)m * DM, XN + (size_t)m * DM, lane); }
    SEAM(14);
    if (IN(15)) {
        pg8::Gemm g{XN, WGU + SZ_GU, DM, DM, DM}; pg8::StaticOrder S; S.init(SEQ, N_GU, G, bx);
        pg8::EpiFfn E{ACT, a.conv_ffn_w + 3 * DFF, HALOG, FIRSTG, FIRSTU, lds + RING_BYTES};
        pg8::gemm_phase<pg8::EpiFfn, pg8::StaticOrder, true>(lds, g, S, E);
    }
    SEAM(15);
    if (IN(16)) ffn_fix_phase(HALOG, FIRSTG, FIRSTU, a.conv_ffn_w + 3 * DFF, ACT, gtid, nthreads);
    SEAM(16);
    if (IN(17)) {
        pg8::Gemm g{ACT, WD + SZ_D, DFF, DFF, DFF}; pg8::StaticOrder S; S.init(SEQ, DM, G, bx);
        pg8::EpiStore E{Y, DM};
        pg8::gemm_phase<pg8::EpiStore, pg8::StaticOrder, true>(lds, g, S, E);
    }
    SEAM(17);
    if (IN(18)) { for (int m = gw; m < SEQ; m += ngw) norm_res_row(a.out + (size_t)m * DM, Y + (size_t)m * DM, a.g_ffn_post + DM, nullptr, a.out + (size_t)m * DM, nullptr, lane); }

#ifdef PROBE
    xcd_barrier(bar);
#if PROBE == 1
    { LAS float* scr = (LAS float*)(lds + wave * 16384);
      if (bx >= 8) { const int cw_ = (bx - 8) * 8 + wave, ncw = (G - 8) * 8;
            cvt_matrix<0>(a.w_conv_in, DM, N_CI, WCI, 0, scr, cw_, ncw, lane);
            cvt_matrix<0>(a.w_conv_out, K_CO, DM, WCO, 0, scr, cw_, ncw, lane);
            cvt_matrix<2>(a.w_ffn_gate, DM, DFF, WGU, 0, scr, cw_, ncw, lane);
            cvt_matrix<3>(a.w_ffn_up, DM, DFF, WGU, 0, scr, cw_, ncw, lane);
            cvt_matrix<0>(a.w_ffn_down, DFF, DM, WD, 0, scr, cw_, ncw, lane);
            cvt_matrix<1>(a.w_attn_in, DM, N_AI, WAI, 0, scr, cw_, ncw, lane);
            cvt_matrix<0>(a.w_attn_out, K_AO, DM, WAO, 0, scr, cw_, ncw, lane);
            cvt_matrix<2>(a.w_ffn_gate + SZ_D, DM, DFF, WGU + SZ_GU, 0, scr, cw_, ncw, lane);
            cvt_matrix<3>(a.w_ffn_up + SZ_D, DM, DFF, WGU + SZ_GU, 0, scr, cw_, ncw, lane);
            cvt_matrix<0>(a.w_ffn_down + SZ_D, DFF, DM, WD + SZ_D, 0, scr, cw_, ncw, lane); } }
#elif PROBE == 8
    { pg8::Gemm g{ACT, WD, DFF, DFF, DFF}; pg8::StaticOrder S; S.init(SEQ, DM, G, bx);
      pg8::EpiStore E{Y, DM};
      pg8::gemm_phase<pg8::EpiStore, pg8::StaticOrder, true>(lds, g, S, E); }
#elif PROBE == 4
    { pg8::Gemm g{A2, WCO, K_CO, K_CO, K_CO}; pg8::StaticOrder S; S.init(SEQ, DM, G, bx);
      pg8::EpiStore E{Y, DM};
      pg8::gemm_phase<pg8::EpiStore, pg8::StaticOrder, true>(lds, g, S, E); }
#elif PROBE == 40
    { pg8::Gemm g{A2, WCO, K_CO, K_CO, K_CO}; pg8::SameTileOrder S; S.n = 2;
      pg8::EpiStore E{Y, DM};
      pg8::gemm_phase<pg8::EpiStore, pg8::SameTileOrder, true>(lds, g, S, E); }
#elif PROBE == 6
    { pg8::Gemm g{XN, WGU, DM, DM, DM}; pg8::StaticOrder S; S.init(SEQ, N_GU, G, bx);
      pg8::EpiFfn E{ACT, a.conv_ffn_w, HALOG, FIRSTG, FIRSTU, lds + RING_BYTES};
      pg8::gemm_phase<pg8::EpiFfn, pg8::StaticOrder, true>(lds, g, S, E); }
#elif PROBE == 5
    { float* scratch_x = (float*)(ws + WS_S);
      for (int m = gw; m < SEQ; m += ngw) norm_res_row(a.x + (size_t)m * DM, Y + (size_t)m * DM, a.g_mix_post, a.g_ffn_pre, scratch_x + (size_t)m * DM, XN + (size_t)m * DM, lane); }
#elif PROBE == 3
    { for (int u = bx; u < 4 * (SEQ / 128); u += G) { const int hd = u / (SEQ / 128), qb = u % (SEQ / 128);
            attn_unit<256, 16, false>(lds, H + (size_t)(128 * qb) * N_CI + 3 * CW + 256 * hd, N_CI, KV + 256 * hd, KV + MW + 256 * hd, 2 * MW, 0,
                                      A2 + (size_t)(128 * qb) * K_CO + CW + 256 * hd, K_CO, nullptr, 0.0625f); }
        conv_gate_phase(H, a.conv_mix_w, A2, gtid, nthreads); }
#endif
#endif
#undef IN
#undef SEAM
}

extern "C" void kernel_launch(void* const* d_in, const int* in_sizes, int n_in, void* d_out, int out_size, void* d_ws, size_t ws_size, hipStream_t stream) {
    static int grid = 0;
    if (grid == 0) {
        if (n_in != 18 || in_sizes[0] != SEQ * DM || out_size != SEQ * DM || ws_size < WS_END) { fprintf(stderr, "kernel_launch: unexpected shapes (n_in %d, in0 %d, out %d, ws %zu < %zu?)\n", n_in, n_in > 0 ? in_sizes[0] : -1, out_size, ws_size, (size_t)WS_END); grid = -1; return; }
        int dev = 0, cus = 0;
        if (hipGetDevice(&dev) != hipSuccess || hipDeviceGetAttribute(&cus, hipDeviceAttributeMultiprocessorCount, dev) != hipSuccess) { grid = -1; return; }
        if (hipFuncSetAttribute((const void*)fwd_kernel, hipFuncAttributeMaxDynamicSharedMemorySize, LDS_BYTES) != hipSuccess) { fprintf(stderr, "kernel_launch: hipFuncSetAttribute failed\n"); grid = -1; return; }
        int per_cu = 0;
        if (hipOccupancyMaxActiveBlocksPerMultiprocessor(&per_cu, (const void*)fwd_kernel, 512, LDS_BYTES) != hipSuccess || per_cu < 1) fprintf(stderr, "kernel_launch: occupancy query says %d\n", per_cu);
        (void)hipGetLastError();
        grid = cus;
        if (grid < 16) { fprintf(stderr, "kernel_launch: needs >= 16 CUs\n"); grid = -1; return; }
    }
    if (grid < 0) return;
    (void)hipMemsetAsync((char*)d_ws + WS_CTL, 0, CTL_ZERO_BYTES, stream);
    Args a{};
    a.x = (const float*)d_in[0]; a.mem = (const float*)d_in[1]; a.pos = (const int*)d_in[2]; a.g_mem = (const float*)d_in[3]; a.w_mem_kv = (const float*)d_in[4];
    a.g_mix_pre = (const float*)d_in[5]; a.g_mix_post = (const float*)d_in[6]; a.g_ffn_pre = (const float*)d_in[7]; a.g_ffn_post = (const float*)d_in[8];
    a.w_conv_in = (const float*)d_in[9]; a.conv_mix_w = (const float*)d_in[10]; a.w_conv_out = (const float*)d_in[11]; a.w_attn_in = (const float*)d_in[12]; a.w_attn_out = (const float*)d_in[13];
    a.w_ffn_gate = (const float*)d_in[14]; a.w_ffn_up = (const float*)d_in[15]; a.conv_ffn_w = (const float*)d_in[16]; a.w_ffn_down = (const float*)d_in[17];
    a.out = (float*)d_out; a.ws = (unsigned char*)d_ws;
#if ONE_LAUNCH
    a.ph_lo = 0; a.ph_hi = NPHASE;
    hipLaunchKernelGGL(fwd_kernel, dim3(grid), dim3(512), LDS_BYTES, stream, a);
#else
    for (int p = 0; p < NPHASE; ++p) { a.ph_lo = p; a.ph_hi = p + 1; hipLaunchKernelGGL(fwd_kernel, dim3(grid), dim3(512), LDS_BYTES, stream, a); }
#endif
}
```

```cpp
#include <hip/hip_runtime.h>
#include <cstdio>
#include <cstdint>

#define LAS __attribute__((address_space(3)))
#define GAS __attribute__((address_space(1)))
typedef unsigned short bf16_t;
typedef short bf16x8 __attribute__((ext_vector_type(8)));
typedef short s16x4 __attribute__((ext_vector_type(4)));
typedef float f32x4 __attribute__((ext_vector_type(4)));
typedef unsigned u32x4 __attribute__((ext_vector_type(4)));
typedef unsigned u32x2 __attribute__((ext_vector_type(2)));

constexpr int SEQ = 8192, DM = 4096, DFF = 11008, CW = 3072, MW = 1024, GW = 2048, NMEM = 256, NHEAD = 16, HDIM = 128;
constexpr int N_CI = 3 * CW + MW;
constexpr int N_AI = 9 * GW + MW;
constexpr int N_GU = 2 * DFF;
constexpr int K_CO = CW + MW;
constexpr int K_AO = GW + MW;
constexpr float EPS = 1e-6f;

#ifndef ONE_LAUNCH
#define ONE_LAUNCH 1
#endif
constexpr int NPHASE = 19;

constexpr size_t MiB = 1u << 20;
constexpr size_t WS_CTL = 0, CTL_ZERO_BYTES = 1 * MiB;
constexpr size_t WS_WKV = 1 * MiB;
constexpr size_t WS_WCI = WS_WKV + 16 * MiB;
constexpr size_t WS_WCO = WS_WCI + 80 * MiB;
constexpr size_t WS_WAI = WS_WCO + 32 * MiB;
constexpr size_t WS_WAO = WS_WAI + 152 * MiB;
constexpr size_t WS_WGU = WS_WAO + 24 * MiB;
constexpr size_t WS_WD  = WS_WGU + 2 * 172 * MiB;
constexpr size_t WS_XN  = WS_WD + 2 * 86 * MiB;
constexpr size_t WS_R   = WS_XN + 64 * MiB;
constexpr size_t WS_S   = WS_R + 344 * MiB;
constexpr size_t WS_MEMN = WS_S + 172 * MiB;
constexpr size_t WS_KV  = WS_MEMN + 2 * MiB;
constexpr size_t WS_COS = WS_KV + 1 * MiB;
constexpr size_t WS_SIN = WS_COS + 2 * MiB;
constexpr size_t WS_LSE = WS_SIN + 2 * MiB;
constexpr size_t WS_HALOG = WS_LSE + 2 * MiB;
constexpr size_t WS_FIRSTG = WS_HALOG + 3 * MiB;
constexpr size_t WS_FIRSTU = WS_FIRSTG + 3 * MiB;
constexpr size_t WS_XRES = WS_FIRSTU + 3 * MiB;
constexpr size_t WS_END = WS_XRES + 64 * MiB;
constexpr int CW_BAR = 4096;

constexpr int RING_BYTES = 131072;
constexpr int LDSCTL_OFF = 146432;
constexpr int LDS_BYTES = 147456;

__device__ __forceinline__ unsigned cvt_pk_bf16(float lo, float hi) { unsigned r; asm("v_cvt_pk_bf16_f32 %0, %1, %2" : "=v"(r) : "v"(lo), "v"(hi)); return r; }
__device__ __forceinline__ float bf_lo(unsigned w) { return __uint_as_float(w << 16); }
__device__ __forceinline__ float bf_hi(unsigned w) { return __uint_as_float(w & 0xffff0000u); }
__device__ __forceinline__ int fresh_lane() { int l; asm volatile("v_mbcnt_lo_u32_b32 %0, -1, 0\n\tv_mbcnt_hi_u32_b32 %0, -1, %0" : "=v"(l)); return l; }
__device__ __forceinline__ int fresh_tid() { int t = threadIdx.x; asm volatile("" : "+v"(t)); return t; }
__device__ __forceinline__ float wave_sum(float v) {
#pragma unroll
    for (int o = 1; o < 64; o <<= 1) v += __shfl_xor(v, o);
    return v;
}

__constant__ float INV_FREQ[64] = {
1.000000000e+00f, 8.659643531e-01f, 7.498942018e-01f, 6.493816376e-01f, 5.623413324e-01f, 4.869675338e-01f, 4.216965139e-01f, 3.651741147e-01f, 3.162277639e-01f, 2.738419771e-01f, 2.371373773e-01f, 2.053525001e-01f, 1.778279394e-01f, 1.539926529e-01f, 1.333521456e-01f, 1.154781953e-01f,
1.000000015e-01f, 8.659642935e-02f, 7.498942316e-02f, 6.493816525e-02f, 5.623413250e-02f, 4.869675264e-02f, 4.216964915e-02f, 3.651741147e-02f, 3.162277490e-02f, 2.738419548e-02f, 2.371373773e-02f, 2.053525113e-02f, 1.778279431e-02f, 1.539926510e-02f, 1.333521400e-02f, 1.154781971e-02f,
9.999999776e-03f, 8.659643121e-03f, 7.498942316e-03f, 6.493816152e-03f, 5.623413250e-03f, 4.869675264e-03f, 4.216964822e-03f, 3.651741194e-03f, 3.162277630e-03f, 2.738419687e-03f, 2.371373819e-03f, 2.053525066e-03f, 1.778279431e-03f, 1.539926510e-03f, 1.333521446e-03f, 1.154782018e-03f,
1.000000047e-03f, 8.659643354e-04f, 7.498941850e-04f, 6.493816036e-04f, 5.623413017e-04f, 4.869675322e-04f, 4.216965172e-04f, 3.651741135e-04f, 3.162277571e-04f, 2.738419571e-04f, 2.371373703e-04f, 2.053525095e-04f, 1.778279402e-04f, 1.539926598e-04f, 1.333521504e-04f, 1.154782003e-04f };

namespace pg8 {
constexpr int BM = 256, BK = 64, HALF = 128, HTB = HALF * BK * 2, STAGE_BYTES = 8 * HTB, NXCD = 8, WGM = 8;
__host__ __device__ __forceinline__ int lds_byte(int r, int c) { const int st = (r >> 4) * 2 + (c >> 5), rr = r & 15, cc = c & 31, ob = rr * 64 + cc * 2; return st * 1024 + (ob ^ (((ob >> 9) & 1) << 5)); }
__host__ __device__ __forceinline__ void stage_rc(int b, int& R, int& C) { const int st = b / 1024, sb = b % 1024, swz = sb ^ (((sb >> 9) & 1) << 5); R = (st >> 1) * 16 + swz / 64; C = (st & 1) * 32 + (swz % 64) / 2; }
__host__ __device__ __forceinline__ int perm32(int rho) { const int n = rho >> 4, i = rho & 15; return 8 * (i >> 2) + 4 * n + (i & 3); }

struct Unit { int pm, pn; };
struct SameTileOrder { int n;
    __device__ bool next(int i, Unit& u) const { if (i >= n) return false; u.pm = 0; u.pn = 0; return true; }
    __device__ __forceinline__ void a_ready(const Unit&) const {}
    __device__ __forceinline__ void done(const Unit&) const {} };
struct Gemm { const bf16_t* A; const bf16_t* Bt; int K, lda, ldb; };

struct StaticOrder {
    int nM, nN, nwg, G, c;
    __host__ __device__ void init(int M, int N, int G_, int c_) { nM = M / BM; nN = N / BM; nwg = nM * nN; G = G_; c = c_; }
    __host__ __device__ bool next(int i, Unit& u) const {
        const long L = (long)i * G + c; if (L >= nwg) return false;
        int wgid = (int)L; { const int q = nwg / NXCD, r = nwg % NXCD, xcd = wgid % NXCD, off = wgid / NXCD; wgid = (xcd < r ? xcd * (q + 1) : r * (q + 1) + (xcd - r) * q) + off; }
        const int nig = WGM * nN, gid = wgid / nig, fm = gid * WGM, gsz = (nM - fm) < WGM ? (nM - fm) : WGM;
        u.pm = fm + ((wgid % nig) % gsz); u.pn = (wgid % nig) / gsz; return true;
    }
    __device__ __forceinline__ void a_ready(const Unit&) const {}
    __device__ __forceinline__ void done(const Unit&) const {}
};

struct EpiStore {
    static constexpr bool PERM = true, AFTER_DRAIN = false;
    bf16_t* O; int ldc;
    __device__ __forceinline__ void operator()(const f32x4 (&acc)[2][2][4][2], const Unit& u, int wr, int wc, int fr, int fq) const {
        const int row0 = u.pm * BM + wr * 64 + fr, col0 = u.pn * BM + wc * 32 + 8 * fq;
#pragma unroll
        for (int ai = 0; ai < 2; ++ai)
#pragma unroll
            for (int m = 0; m < 4; ++m) { bf16_t* rowp = O + (size_t)(row0 + ai * HALF + m * 16) * ldc + col0;
#pragma unroll
                for (int bj = 0; bj < 2; ++bj) { const f32x4 v0 = acc[ai][bj][m][0], v1 = acc[ai][bj][m][1];
                    u32x4 w; w.x = cvt_pk_bf16(v0[0], v0[1]); w.y = cvt_pk_bf16(v0[2], v0[3]); w.z = cvt_pk_bf16(v1[0], v1[1]); w.w = cvt_pk_bf16(v1[2], v1[3]);
                    *(u32x4*)(rowp + bj * HALF) = w; } }
    }
};
struct EpiQKV {
    static constexpr bool PERM = true, AFTER_DRAIN = false;
    bf16_t* QKVL; bf16_t* QM; const float* cosT; const float* sinT;
    __device__ __forceinline__ void operator()(const f32x4 (&acc)[2][2][4][2], const Unit& u, int wr, int wc, int fr, int fq) const {
        const int colt = u.pn * BM;
        const int row0 = u.pm * BM + wr * 64 + fr;
        if (colt >= 9 * GW) {
            const int col0 = colt - 9 * GW + wc * 32 + 8 * fq;
#pragma unroll
            for (int ai = 0; ai < 2; ++ai)
#pragma unroll
                for (int m = 0; m < 4; ++m) { bf16_t* rowp = QM + (size_t)(row0 + ai * HALF + m * 16) * MW + col0;
#pragma unroll
                    for (int bj = 0; bj < 2; ++bj) { const f32x4 v0 = acc[ai][bj][m][0], v1 = acc[ai][bj][m][1];
                        u32x4 w; w.x = cvt_pk_bf16(v0[0], v0[1]); w.y = cvt_pk_bf16(v0[2], v0[3]); w.z = cvt_pk_bf16(v1[0], v1[1]); w.w = cvt_pk_bf16(v1[2], v1[3]);
                        *(u32x4*)(rowp + bj * HALF) = w; } }
        } else {
            const int g = colt / (3 * GW), rem = colt % (3 * GW), part = rem / GW, hd0 = (rem % GW) / HDIM, dsh = 2 * g, dm1 = (1 << dsh) - 1;
            bf16_t* slab0 = QKVL + (size_t)((g * 3 + part) * NHEAD + hd0) * SEQ * HDIM;
            if (part == 2) {
#pragma unroll
                for (int ai = 0; ai < 2; ++ai)
#pragma unroll
                    for (int m = 0; m < 4; ++m) { const int row = row0 + ai * HALF + m * 16; const int rp = ((row & dm1) << (13 - dsh)) + (row >> dsh);
#pragma unroll
                        for (int bj = 0; bj < 2; ++bj) { const f32x4 v0 = acc[ai][bj][m][0], v1 = acc[ai][bj][m][1];
                            u32x4 w; w.x = cvt_pk_bf16(v0[0], v0[1]); w.y = cvt_pk_bf16(v0[2], v0[3]); w.z = cvt_pk_bf16(v1[0], v1[1]); w.w = cvt_pk_bf16(v1[2], v1[3]);
                            *(u32x4*)(slab0 + ((size_t)bj * SEQ + rp) * HDIM + wc * 32 + 8 * fq) = w; } }
            } else {
                const int x0 = wc * 32 + 8 * fq, hh = x0 >> 6, d0 = x0 & 63;
#pragma unroll
                for (int ai = 0; ai < 2; ++ai)
#pragma unroll
                    for (int m = 0; m < 4; ++m) { const int row = row0 + ai * HALF + m * 16; const int rp = ((row & dm1) << (13 - dsh)) + (row >> dsh);
                        const f32x4 c0 = *(const f32x4*)(cosT + (size_t)row * 64 + d0), c1 = *(const f32x4*)(cosT + (size_t)row * 64 + d0 + 4);
                        const f32x4 s0 = *(const f32x4*)(sinT + (size_t)row * 64 + d0), s1 = *(const f32x4*)(sinT + (size_t)row * 64 + d0 + 4);
                        const f32x4 a0 = acc[ai][0][m][0], a1 = acc[ai][0][m][1], b0 = acc[ai][1][m][0], b1 = acc[ai][1][m][1];
                        const f32x4 o10 = a0 * c0 - b0 * s0, o11 = a1 * c1 - b1 * s1, o20 = b0 * c0 + a0 * s0, o21 = b1 * c1 + a1 * s1;
                        bf16_t* rowp = slab0 + ((size_t)hh * SEQ + rp) * HDIM + d0;
                        u32x4 w; w.x = cvt_pk_bf16(o10[0], o10[1]); w.y = cvt_pk_bf16(o10[2], o10[3]); w.z = cvt_pk_bf16(o11[0], o11[1]); w.w = cvt_pk_bf16(o11[2], o11[3]);
                        *(u32x4*)(rowp) = w;
                        w.x = cvt_pk_bf16(o20[0], o20[1]); w.y = cvt_pk_bf16(o20[2], o20[3]); w.z = cvt_pk_bf16(o21[0], o21[1]); w.w = cvt_pk_bf16(o21[2], o21[3]);
                        *(u32x4*)(rowp + 64) = w;
                        asm volatile("" ::: "memory"); }
            }
        }
    }
};
__device__ __forceinline__ float dpp_ror1(float v) { return __builtin_bit_cast(float, __builtin_amdgcn_update_dpp(0, __builtin_bit_cast(int, v), 0x121, 0xf, 0xf, false)); }
__device__ __forceinline__ float dpp_ror2(float v) { return __builtin_bit_cast(float, __builtin_amdgcn_update_dpp(0, __builtin_bit_cast(int, v), 0x122, 0xf, 0xf, false)); }
struct EpiFfn {
    static constexpr bool PERM = true, AFTER_DRAIN = false;
    bf16_t* ACT; const float* cw; float* HALOG; float* FIRSTG; float* FIRSTU; LAS unsigned char* xl;
    __device__ __forceinline__ void operator()(const f32x4 (&acc)[2][2][4][2], const Unit& u, int wr, int wc, int fr, int fq) const {
        const int ch0 = u.pn * 128 + wc * 32 + 8 * fq;
        LAS f32x4* hl = (LAS f32x4*)xl;
        if (fr >= 14) {
#pragma unroll
            for (int ai = 0; ai < 2; ++ai) { const int idx = ((((ai * 2 + wr) * 4 + wc) * 2 + (fr - 14)) * 4 + fq) * 2; hl[idx] = acc[ai][0][3][0]; hl[idx + 1] = acc[ai][0][3][1]; }
        }
        float w0[8], w1[8], w2[8];
        { const f32x4 a0 = *(const f32x4*)(cw + ch0), a1 = *(const f32x4*)(cw + ch0 + 4), b0 = *(const f32x4*)(cw + DFF + ch0), b1 = *(const f32x4*)(cw + DFF + ch0 + 4), c0 = *(const f32x4*)(cw + 2 * DFF + ch0), c1 = *(const f32x4*)(cw + 2 * DFF + ch0 + 4);
#pragma unroll
          for (int i = 0; i < 4; ++i) { w0[i] = a0[i]; w0[4 + i] = a1[i]; w1[i] = b0[i]; w1[4 + i] = b1[i]; w2[i] = c0[i]; w2[4 + i] = c1[i]; } }
        asm volatile("s_waitcnt lgkmcnt(0)" ::: "memory"); __builtin_amdgcn_s_barrier(); asm volatile("" ::: "memory");
#pragma unroll
        for (int ai = 0; ai < 2; ++ai) {
            const bool ext = (wr == 0 && ai == 0);
            float x14[8], x15[8];
            if (ext) {
#pragma unroll
                for (int i = 0; i < 8; ++i) { x14[i] = 0.f; x15[i] = 0.f; }
            } else {
                const int sai = (wr == 1) ? ai : 0, swr = (wr == 1) ? 0 : 1;
                const int b = ((((sai * 2 + swr) * 4 + wc) * 2) * 4 + fq) * 2;
                const f32x4 p0 = hl[b], p1 = hl[b + 1], q0 = hl[b + 8], q1 = hl[b + 9];
#pragma unroll
                for (int i = 0; i < 4; ++i) { x14[i] = p0[i]; x14[4 + i] = p1[i]; x15[i] = q0[i]; x15[4 + i] = q1[i]; }
            }
            float r1p[8], r2p[8];
#pragma unroll
            for (int i = 0; i < 8; ++i) { r1p[i] = x15[i]; r2p[i] = (fr == 0) ? x14[i] : x15[i]; }
#pragma unroll
            for (int m = 0; m < 4; ++m) {
                float cur[8], up[8], o[8];
#pragma unroll
                for (int i = 0; i < 4; ++i) { cur[i] = acc[ai][0][m][0][i]; cur[4 + i] = acc[ai][0][m][1][i]; up[i] = acc[ai][1][m][0][i]; up[4 + i] = acc[ai][1][m][1][i]; }
                const int row = u.pm * BM + ai * HALF + wr * 64 + m * 16 + fr;
#pragma unroll
                for (int i = 0; i < 8; ++i) {
                    const float r1 = dpp_ror1(cur[i]), r2 = dpp_ror2(cur[i]);
                    const float p1 = (fr >= 1) ? r1 : r1p[i], p2 = (fr >= 2) ? r2 : r2p[i];
                    const float g = w0[i] * p2 + w1[i] * p1 + w2[i] * cur[i];
                    o[i] = g / (1.0f + __expf(-g)) * up[i];
                    r1p[i] = r1; r2p[i] = r2;
                }
                const bool first2 = ext && m == 0 && fr < 2 && u.pm > 0;
                if (!first2) {
                    u32x4 w; w.x = cvt_pk_bf16(o[0], o[1]); w.y = cvt_pk_bf16(o[2], o[3]); w.z = cvt_pk_bf16(o[4], o[5]); w.w = cvt_pk_bf16(o[6], o[7]);
                    *(u32x4*)(ACT + (size_t)row * DFF + ch0) = w;
                } else {
                    float* fg = FIRSTG + (size_t)(u.pm * 2 + fr) * DFF + ch0; float* fu = FIRSTU + (size_t)(u.pm * 2 + fr) * DFF + ch0;
                    *(f32x4*)fg = acc[ai][0][m][0]; *(f32x4*)(fg + 4) = acc[ai][0][m][1]; *(f32x4*)fu = acc[ai][1][m][0]; *(f32x4*)(fu + 4) = acc[ai][1][m][1];
                }
                if (ai == 1 && wr == 1 && m == 3 && fr >= 14) { float* hg = HALOG + (size_t)(u.pm * 2 + fr - 14) * DFF + ch0; *(f32x4*)hg = acc[ai][0][m][0]; *(f32x4*)(hg + 4) = acc[ai][0][m][1]; }
            }
        }
    }
};

template <class Epi, class Sched, bool ALIGN_EPI>
__device__ __forceinline__ void gemm_phase(LAS unsigned char* lds, const Gemm g, const Sched& S, const Epi& E) {
    const int tid = fresh_tid(), wid = __builtin_amdgcn_readfirstlane(tid >> 6), lane = tid & 63, wr = wid >> 2, wc = wid & 3, fr = lane & 15, fq = lane >> 4;
    const int K = g.K, nt = K / BK;
    unsigned voffA[2], voffB[2];
#pragma unroll
    for (int i = 0; i < 2; ++i) { int R, C; stage_rc(tid * 16 + i * 8192, R, C); const int Rb = Epi::PERM ? ((R & ~31) + perm32(R & 31)) : R;
        voffA[i] = (unsigned)(R * g.lda + C) * 2u; voffB[i] = (unsigned)(Rb * g.ldb + C) * 2u; }
    const size_t kstep = (size_t)(BK * 2);
    const size_t hstepA = (size_t)HALF * g.lda * 2, hstepB = (size_t)HALF * g.ldb * 2;
    const size_t tstepA = 2 * hstepA, tstepB = 2 * hstepB;
    const unsigned ldsw = (unsigned)wid * 1024u;
    const int aoff = lds_byte(wr * 64 + fr, fq * 8), boff = lds_byte(wc * 32 + fr, fq * 8);
#define PG8_SA(b, h) (((b) * 2 + (h)) * HTB)
#define PG8_SB(b, h) ((4 + (b) * 2 + (h)) * HTB)
#define PG8_STAGE(bufoff, gbase, voff) do { _Pragma("unroll") for (int _i = 0; _i < 2; ++_i) \
        __builtin_amdgcn_global_load_lds((const unsigned*)((const char*)(gbase) + (voff)[_i]), (LAS unsigned*)(lds + (bufoff) + ldsw + _i * 8192), 16, 0, 0); } while (0)
#define PG8_LDA(dst, b, h) do { _Pragma("unroll") for (int m = 0; m < 4; ++m) _Pragma("unroll") for (int k = 0; k < 2; ++k) dst[m][k] = *(const LAS bf16x8*)(lds + PG8_SA(b, h) + aoff + m * 2048 + k * 1024); } while (0)
#define PG8_LDB(dst, b, h) do { _Pragma("unroll") for (int n = 0; n < 2; ++n) _Pragma("unroll") for (int k = 0; k < 2; ++k) dst[n][k] = *(const LAS bf16x8*)(lds + PG8_SB(b, h) + boff + n * 2048 + k * 1024); } while (0)
#define PG8_MMA(ai, bj, At, Bt) do { __builtin_amdgcn_s_setprio(1); _Pragma("unroll") for (int m = 0; m < 4; ++m) _Pragma("unroll") for (int n = 0; n < 2; ++n) _Pragma("unroll") for (int k = 0; k < 2; ++k) \
        acc[ai][bj][m][n] = __builtin_amdgcn_mfma_f32_16x16x32_bf16(Bt[n][k], At[m][k], acc[ai][bj][m][n], 0, 0, 0); __builtin_amdgcn_s_setprio(0); } while (0)
#define PG8_WAIT_V(n) asm volatile("s_waitcnt vmcnt(" #n ")" ::: "memory")
#define PG8_WAIT_L(n) asm volatile("s_waitcnt lgkmcnt(" #n ")" ::: "memory")
#define PG8_BAR __builtin_amdgcn_s_barrier()
#define PG8_SCHED __builtin_amdgcn_sched_barrier(0)
    Unit cur, nxt; int ui = 0;
    if (!S.next(0, cur)) return;
    f32x4 acc[2][2][4][2];
#pragma unroll
    for (int a = 0; a < 2; ++a)
#pragma unroll
        for (int b = 0; b < 2; ++b)
#pragma unroll
            for (int m = 0; m < 4; ++m)
#pragma unroll
                for (int n = 0; n < 2; ++n) acc[a][b][m][n] = (f32x4){0.f, 0.f, 0.f, 0.f};
    bf16x8 At[4][2], B0[2][2], B1[2][2];
    const char* cA = (const char*)g.A + (size_t)cur.pm * tstepA; const char* cB = (const char*)g.Bt + (size_t)cur.pn * tstepB;
    S.a_ready(cur);
    PG8_STAGE(PG8_SB(0, 0), cB, voffB); PG8_STAGE(PG8_SB(0, 1), cB + hstepB, voffB); PG8_STAGE(PG8_SA(0, 0), cA, voffA); PG8_STAGE(PG8_SA(0, 1), cA + hstepA, voffA);
    if (wr == 1) PG8_BAR;
    PG8_WAIT_V(2); PG8_BAR;
    PG8_STAGE(PG8_SB(1, 0), cB + kstep, voffB); PG8_STAGE(PG8_SA(1, 0), cA + kstep, voffA); PG8_STAGE(PG8_SB(1, 1), cB + hstepB + kstep, voffB);
    PG8_WAIT_V(6); PG8_BAR;
    for (;;) {
        const bool has_next = S.next(ui + 1, nxt);
        const char* nA = has_next ? (const char*)g.A + (size_t)nxt.pm * tstepA : cA; const char* nB = has_next ? (const char*)g.Bt + (size_t)nxt.pn * tstepB : cB;
        for (int t = 0; t < nt; t += 2) {
            const bool last = (t == nt - 2);
            const char* a1 = cA + (size_t)(t + 1) * kstep;
            const char* a2 = last ? nA : cA + (size_t)(t + 2) * kstep; const char* b2 = last ? nB : cB + (size_t)(t + 2) * kstep;
            const char* a3 = a2 + kstep; const char* b3 = b2 + kstep;
            if (last && has_next) S.a_ready(nxt);
            PG8_LDB(B0, 0, 0); PG8_LDB(B1, 0, 1); PG8_SCHED; PG8_LDA(At, 0, 0); PG8_STAGE(PG8_SA(1, 1), a1 + hstepA, voffA);
            PG8_WAIT_V(8); PG8_WAIT_L(0); PG8_BAR; PG8_MMA(0, 0, At, B0); PG8_MMA(0, 1, At, B1); PG8_BAR; PG8_SCHED;
            PG8_LDA(At, 0, 1); PG8_STAGE(PG8_SB(0, 0), b2, voffB); PG8_STAGE(PG8_SB(0, 1), b2 + hstepB, voffB); PG8_STAGE(PG8_SA(0, 0), a2, voffA);
            PG8_WAIT_V(8); PG8_WAIT_L(0); PG8_BAR; PG8_MMA(1, 0, At, B0); PG8_MMA(1, 1, At, B1); PG8_BAR; PG8_SCHED;
            PG8_LDB(B0, 1, 0); PG8_LDB(B1, 1, 1); PG8_SCHED; PG8_LDA(At, 1, 0); PG8_STAGE(PG8_SA(0, 1), a2 + hstepA, voffA);
            PG8_WAIT_V(8); PG8_WAIT_L(0); PG8_BAR; PG8_MMA(0, 0, At, B0); PG8_MMA(0, 1, At, B1); PG8_BAR; PG8_SCHED;
            PG8_LDA(At, 1, 1); PG8_STAGE(PG8_SB(1, 0), b3, voffB); PG8_STAGE(PG8_SB(1, 1), b3 + hstepB, voffB); PG8_STAGE(PG8_SA(1, 0), a3, voffA);
            PG8_WAIT_V(8); PG8_WAIT_L(0); PG8_BAR; PG8_MMA(1, 0, At, B0); PG8_MMA(1, 1, At, B1); PG8_BAR; PG8_SCHED;
        }
        if constexpr (ALIGN_EPI) { if (wr == 0) PG8_BAR; }
        E(acc, cur, wr, wc, fr, fq); S.done(cur);
        if (!has_next) break;
#pragma unroll
        for (int a = 0; a < 2; ++a)
#pragma unroll
            for (int b = 0; b < 2; ++b)
#pragma unroll
                for (int m = 0; m < 4; ++m)
#pragma unroll
                    for (int n = 0; n < 2; ++n) acc[a][b][m][n] = (f32x4){0.f, 0.f, 0.f, 0.f};
        cur = nxt; cA = nA; cB = nB; ++ui;
        if constexpr (ALIGN_EPI) { if (wr == 1) PG8_BAR; }
    }
    PG8_WAIT_V(0);
    if constexpr (!ALIGN_EPI) { if (wr == 0) PG8_BAR; }
    PG8_BAR;
#undef PG8_SA
#undef PG8_SB
#undef PG8_STAGE
#undef PG8_LDA
#undef PG8_LDB
#undef PG8_MMA
#undef PG8_WAIT_V
#undef PG8_WAIT_L
#undef PG8_BAR
#undef PG8_SCHED
}
}

#define XB_TMO      128
#define XB_XCNT(j)  (256  + 64 * (j))
#define XB_XSUB(j)  (1280 + 64 * (j))
#define XB_XGEN(j)  (2304 + 64 * (j))
#define XB_TOP      3328
#define XB_TOPGEN   3392
#define XCD_BAR_WORDS 3456
#define XB_SPIN_CAP (1u << 18)
__device__ __forceinline__ unsigned xb_ld(unsigned* p)              { return __hip_atomic_load(p, __ATOMIC_RELAXED, __HIP_MEMORY_SCOPE_AGENT); }
__device__ __forceinline__ unsigned xb_add(unsigned* p, unsigned v) { return __hip_atomic_fetch_add(p, v, __ATOMIC_RELAXED, __HIP_MEMORY_SCOPE_AGENT); }
__device__ __forceinline__ unsigned xb_xcc_id() { return (unsigned)__builtin_amdgcn_s_getreg((3 << 11) | 20) & 0xFu; }
#define XB_SPIN(cond, bar) do { unsigned _sp = 0; while (cond) { __builtin_amdgcn_s_sleep(1); \
    if ((++_sp & 255u) == 0u) { if (xb_ld(&(bar)[XB_TMO])) break; if (_sp > XB_SPIN_CAP) { atomicAdd(&(bar)[XB_TMO], 1u); break; } } } } while (0)
struct XcdBarrier { unsigned* bar; unsigned x; volatile LAS unsigned* st; };
__device__ __forceinline__ XcdBarrier xcd_barrier_post(unsigned* bar, volatile LAS unsigned* st) {
    XcdBarrier b; b.bar = bar; b.x = xb_xcc_id(); b.st = st;
    if (threadIdx.x == 0) (void)xb_add(&bar[XB_XCNT(b.x)], 1u);
    return b;
}
__device__ __forceinline__ void xcd_barrier_complete(unsigned* bar, unsigned x, unsigned& nloc, unsigned& nx) {
    const unsigned G = gridDim.x * gridDim.y * gridDim.z;
    unsigned sum, cnt, mine, sp = 0u;
    for (;;) {
        sum = 0u; cnt = 0u; mine = 0u;
#pragma unroll
        for (unsigned j = 0; j < 16; ++j) { const unsigned c = xb_ld(&bar[XB_XCNT(j)]); sum += c; cnt += (c > 0u) ? 1u : 0u; mine = (j == x) ? c : mine; }
        if (sum == G) break;
        __builtin_amdgcn_s_sleep(1);
        if ((++sp & 255u) == 0u) { if (xb_ld(&bar[XB_TMO])) break; if (sp > XB_SPIN_CAP) { atomicAdd(&bar[XB_TMO], 1u); break; } }
    }
    nloc = mine > 0u ? mine : 1u; nx = cnt > 0u ? cnt : 1u;
}
__device__ __forceinline__ void xcd_barrier(const XcdBarrier& b) {
    asm volatile("s_waitcnt vmcnt(0)" ::: "memory");
    __syncthreads();
    if (threadIdx.x == 0) {
        unsigned* bar = b.bar;
        __builtin_amdgcn_s_waitcnt(0);
        unsigned nloc = b.st[0], nx = b.st[1];
        if (nloc == 0u) { xcd_barrier_complete(bar, b.x, nloc, nx); b.st[0] = nloc; b.st[1] = nx; }
        const unsigned old = xb_add(&bar[XB_XSUB(b.x)], 1u);
        const unsigned gen = old / nloc;
        if (old + 1u == (gen + 1u) * nloc) {
            __builtin_amdgcn_fence(__ATOMIC_RELEASE, "agent");
            asm volatile("s_waitcnt vmcnt(0)" ::: "memory");
            const unsigned og = xb_add(&bar[XB_TOP], 1u);
            const unsigned tg = og / nx;
            if (og + 1u == (tg + 1u) * nx) xb_add(&bar[XB_TOPGEN], 1u);
            else XB_SPIN(xb_ld(&bar[XB_TOPGEN]) == tg, bar);
            __builtin_amdgcn_fence(__ATOMIC_ACQUIRE, "agent");
            xb_add(&bar[XB_XGEN(b.x)], 1u);
            asm volatile("s_waitcnt vmcnt(0)" ::: "memory");
        } else {
            XB_SPIN(xb_ld(&bar[XB_XGEN(b.x)]) == gen, bar);
            __builtin_amdgcn_fence(__ATOMIC_ACQUIRE, "agent");
            asm volatile("s_waitcnt vmcnt(0)" ::: "memory");
        }
    }
    __syncthreads();
}

template <int MODE  >
__device__ __forceinline__ void cvt_matrix(const float* W, int K, int N, bf16_t* WT, int row_off, LAS float* scr, int gw, int ngw, int) {
    const int lane = fresh_lane();
    const int nblk = N / 32, nitems = (K / 64) * nblk;
    for (int item = gw; item < nitems; item += ngw) {
        const int kb = item / nblk, nb = item % nblk, k0 = 64 * kb, n0 = 32 * nb;
#pragma unroll 8
        for (int i = 0; i < 32; ++i) { const int kk = 2 * i + (lane >> 5); scr[kk * 33 + (lane & 31)] = W[(size_t)(k0 + kk) * N + n0 + (lane & 31)]; }
        asm volatile("s_waitcnt lgkmcnt(0)" ::: "memory");
        int d0 = n0;
        if (MODE == 1) { if (n0 < 9 * GW && (n0 % (3 * GW)) < 2 * GW) d0 = (n0 & ~0xC0) | ((n0 & 0x40) << 1) | ((n0 & 0x80) >> 1); }
        if (MODE == 2) d0 = (n0 >> 7) * 256 + (n0 & 127);
        if (MODE == 3) d0 = (n0 >> 7) * 256 + 128 + (n0 & 127);
        const int c = lane & 7;
#pragma unroll
        for (int j = 0; j < 4; ++j) { const int n = (lane >> 3) + 8 * j; const LAS float* s = scr + (8 * c) * 33 + n;
            u32x4 o; o.x = cvt_pk_bf16(s[0 * 33], s[1 * 33]); o.y = cvt_pk_bf16(s[2 * 33], s[3 * 33]); o.z = cvt_pk_bf16(s[4 * 33], s[5 * 33]); o.w = cvt_pk_bf16(s[6 * 33], s[7 * 33]);
            *(u32x4*)(WT + (size_t)(row_off + d0 + n) * K + k0 + 8 * c) = o; }
        asm volatile("s_waitcnt lgkmcnt(0)" ::: "memory");
    }
}
__device__ __forceinline__ void rms_row_to_bf16(const float* xrow, const float* g, bf16_t* orow, int) {
    const int lane = fresh_lane();
    const f32x4* xr = (const f32x4*)xrow + lane;
    f32x4 v[16]; float s = 0.f;
#pragma unroll
    for (int j = 0; j < 16; ++j) { v[j] = xr[64 * j]; s += (v[j].x * v[j].x + v[j].y * v[j].y) + (v[j].z * v[j].z + v[j].w * v[j].w); }
    const float rstd = 1.0f / sqrtf(wave_sum(s) * (1.f / DM) + EPS);
    const f32x4* gr = (const f32x4*)g + lane; u32x2* o8 = (u32x2*)orow + lane;
#pragma unroll
    for (int j = 0; j < 16; ++j) { const f32x4 gv = gr[64 * j]; u32x2 w; w.x = cvt_pk_bf16(v[j].x * rstd * gv.x, v[j].y * rstd * gv.y); w.y = cvt_pk_bf16(v[j].z * rstd * gv.z, v[j].w * rstd * gv.w); o8[64 * j] = w; }
}
template <bool SRC_F32, bool DST_F32, bool HAS_XN>
__device__ __forceinline__ void norm_res_row(const void* xsrc, const bf16_t* yrow, const float* gpost, const float* gpre, void* xout, bf16_t* xn) {
    const int lane = fresh_lane();
    const u32x2* yr = (const u32x2*)yrow + lane; f32x4 y[16]; float s = 0.f;
#pragma unroll
    for (int j = 0; j < 16; ++j) { const u32x2 w = yr[64 * j]; y[j] = (f32x4){bf_lo(w.x), bf_hi(w.x), bf_lo(w.y), bf_hi(w.y)}; s += (y[j].x * y[j].x + y[j].y * y[j].y) + (y[j].z * y[j].z + y[j].w * y[j].w); }
    const float rstd = 1.0f / sqrtf(wave_sum(s) * (1.f / DM) + EPS);
    const f32x4* gp = (const f32x4*)gpost + lane; float s2 = 0.f;
#pragma unroll
    for (int j = 0; j < 16; ++j) { f32x4 xv;
        if (SRC_F32) xv = ((const f32x4*)xsrc + lane)[64 * j]; else { const u32x2 w = ((const u32x2*)xsrc + lane)[64 * j]; xv = (f32x4){bf_lo(w.x), bf_hi(w.x), bf_lo(w.y), bf_hi(w.y)}; }
        const f32x4 gv = gp[64 * j]; y[j] = xv + y[j] * rstd * gv;
        if (DST_F32) ((f32x4*)xout + lane)[64 * j] = y[j];
        else { u32x2 w; w.x = cvt_pk_bf16(y[j].x, y[j].y); w.y = cvt_pk_bf16(y[j].z, y[j].w); ((u32x2*)xout + lane)[64 * j] = w; y[j] = (f32x4){bf_lo(w.x), bf_hi(w.x), bf_lo(w.y), bf_hi(w.y)}; }
        s2 += (y[j].x * y[j].x + y[j].y * y[j].y) + (y[j].z * y[j].z + y[j].w * y[j].w); }
    if (HAS_XN) {
        const float rstd2 = 1.0f / sqrtf(wave_sum(s2) * (1.f / DM) + EPS);
        const f32x4* gr = (const f32x4*)gpre + lane; u32x2* o8 = (u32x2*)xn + lane;
#pragma unroll
        for (int j = 0; j < 16; ++j) { const f32x4 gv = gr[64 * j]; u32x2 w; w.x = cvt_pk_bf16(y[j].x * rstd2 * gv.x, y[j].y * rstd2 * gv.y); w.y = cvt_pk_bf16(y[j].z * rstd2 * gv.z, y[j].w * rstd2 * gv.w); o8[64 * j] = w; }
    }
}
__device__ __forceinline__ void unpack8(const u32x4 w, float (&f)[8]) { f[0] = bf_lo(w.x); f[1] = bf_hi(w.x); f[2] = bf_lo(w.y); f[3] = bf_hi(w.y); f[4] = bf_lo(w.z); f[5] = bf_hi(w.z); f[6] = bf_lo(w.w); f[7] = bf_hi(w.w); }
__device__ __forceinline__ u32x4 pack8f(const float (&f)[8]) { u32x4 w; w.x = cvt_pk_bf16(f[0], f[1]); w.y = cvt_pk_bf16(f[2], f[3]); w.z = cvt_pk_bf16(f[4], f[5]); w.w = cvt_pk_bf16(f[6], f[7]); return w; }

__device__ __forceinline__ void conv_gate_phase(const bf16_t* H, const float* cw  , bf16_t* A2  , int gtid, int nthreads) {
    constexpr int RB = 32, NCG = CW / 8, NIT = (SEQ / RB) * NCG;
    asm volatile("" : "+v"(gtid));
    for (int it = gtid; it < NIT; it += nthreads) {
        const int cg = it % NCG, rb = it / NCG, c0 = cg * 8, t0 = rb * RB;
        float w0[8], w1[8], w2[8], m2[8], m1[8];
#pragma unroll
        for (int i = 0; i < 8; ++i) { w0[i] = cw[c0 + i]; w1[i] = cw[CW + c0 + i]; w2[i] = cw[2 * CW + c0 + i]; m2[i] = 0.f; m1[i] = 0.f; }
        if (t0 >= 2) {
            float a[8], b[8];
            unpack8(*(const u32x4*)(H + (size_t)(t0 - 2) * N_CI + CW + c0), a); unpack8(*(const u32x4*)(H + (size_t)(t0 - 2) * N_CI + 2 * CW + c0), b);
#pragma unroll
            for (int i = 0; i < 8; ++i) m2[i] = a[i] * b[i];
            unpack8(*(const u32x4*)(H + (size_t)(t0 - 1) * N_CI + CW + c0), a); unpack8(*(const u32x4*)(H + (size_t)(t0 - 1) * N_CI + 2 * CW + c0), b);
#pragma unroll
            for (int i = 0; i < 8; ++i) m1[i] = a[i] * b[i];
        }
#pragma unroll 4
        for (int r = 0; r < RB; ++r) {
            const bf16_t* hr = H + (size_t)(t0 + r) * N_CI + c0;
            float bg[8], cgt[8], uu[8], o[8];
            unpack8(*(const u32x4*)(hr), bg); unpack8(*(const u32x4*)(hr + CW), cgt); unpack8(*(const u32x4*)(hr + 2 * CW), uu);
#pragma unroll
            for (int i = 0; i < 8; ++i) { const float cu = cgt[i] * uu[i]; o[i] = bg[i] * (w0[i] * m2[i] + w1[i] * m1[i] + w2[i] * cu); m2[i] = m1[i]; m1[i] = cu; }
            *(u32x4*)(A2 + (size_t)(t0 + r) * K_CO + c0) = pack8f(o);
        }
    }
}
__device__ __forceinline__ void ffn_fix_phase(const float* HALOG, const float* FIRSTG, const float* FIRSTU, const float* cw, bf16_t* ACT, int gtid, int nthreads) {
    constexpr int NC4 = DFF / 4, NIT = 31 * NC4;
    asm volatile("" : "+v"(gtid));
    for (int it = gtid; it < NIT; it += nthreads) {
        const int pm = 1 + it / NC4, c = (it % NC4) * 4;
        const f32x4 gm2 = *(const f32x4*)(HALOG + (size_t)((pm - 1) * 2 + 0) * DFF + c), gm1 = *(const f32x4*)(HALOG + (size_t)((pm - 1) * 2 + 1) * DFF + c);
        const f32x4 g0 = *(const f32x4*)(FIRSTG + (size_t)(pm * 2 + 0) * DFF + c), g1 = *(const f32x4*)(FIRSTG + (size_t)(pm * 2 + 1) * DFF + c);
        const f32x4 u0 = *(const f32x4*)(FIRSTU + (size_t)(pm * 2 + 0) * DFF + c), u1 = *(const f32x4*)(FIRSTU + (size_t)(pm * 2 + 1) * DFF + c);
        const f32x4 w0 = *(const f32x4*)(cw + c), w1 = *(const f32x4*)(cw + DFF + c), w2 = *(const f32x4*)(cw + 2 * DFF + c);
        float o0[4], o1[4];
#pragma unroll
        for (int i = 0; i < 4; ++i) { const float a = w0[i] * gm2[i] + w1[i] * gm1[i] + w2[i] * g0[i], b = w0[i] * gm1[i] + w1[i] * g0[i] + w2[i] * g1[i];
            o0[i] = a / (1.0f + __expf(-a)) * u0[i]; o1[i] = b / (1.0f + __expf(-b)) * u1[i]; }
        u32x2 w; w.x = cvt_pk_bf16(o0[0], o0[1]); w.y = cvt_pk_bf16(o0[2], o0[3]); *(u32x2*)(ACT + (size_t)(256 * pm) * DFF + c) = w;
        w.x = cvt_pk_bf16(o1[0], o1[1]); w.y = cvt_pk_bf16(o1[2], o1[3]); *(u32x2*)(ACT + (size_t)(256 * pm + 1) * DFF + c) = w;
    }
}
__device__ __forceinline__ void merge_phase(const bf16_t* OG  , const float* LSE  , bf16_t* A2  , int gtid, int nthreads) {
    constexpr int NIT = SEQ * (GW / 8);
    asm volatile("" : "+v"(gtid));
    for (int it = gtid; it < NIT; it += nthreads) {
        const int ch = it % (GW / 8), t = it / (GW / 8), hd = ch >> 4, d8 = (ch & 15) * 8;
        const int r0 = t, r1 = (t & 3) * (SEQ / 4) + (t >> 2), r2 = (t & 15) * (SEQ / 16) + (t >> 4);
        const float l0 = LSE[(size_t)(0 * 16 + hd) * SEQ + r0], l1 = LSE[(size_t)(1 * 16 + hd) * SEQ + r1], l2 = LSE[(size_t)(2 * 16 + hd) * SEQ + r2];
        const float mx = fmaxf(l0, fmaxf(l1, l2));
        const float e0 = __expf(l0 - mx), e1 = __expf(l1 - mx), e2 = __expf(l2 - mx), inv = 1.0f / (e0 + e1 + e2);
        float a[8], b[8], c[8], o[8];
        unpack8(*(const u32x4*)(OG + ((size_t)(0 * 16 + hd) * SEQ + r0) * HDIM + d8), a); unpack8(*(const u32x4*)(OG + ((size_t)(1 * 16 + hd) * SEQ + r1) * HDIM + d8), b); unpack8(*(const u32x4*)(OG + ((size_t)(2 * 16 + hd) * SEQ + r2) * HDIM + d8), c);
#pragma unroll
        for (int i = 0; i < 8; ++i) o[i] = (e0 * a[i] + e1 * b[i] + e2 * c[i]) * inv;
        *(u32x4*)(A2 + (size_t)t * K_AO + ch * 8) = pack8f(o);
    }
}

template <int HD, int STR>
__device__ __forceinline__ void attn_load_tile(LAS unsigned char* dst, const bf16_t* src, long stride, int valid_from, int tid) {
    constexpr int CPR = HD / 8, PER = 256 * CPR / 512;
    u32x4 v[PER];
#pragma unroll
    for (int j = 0; j < PER; ++j) { const int idx = tid + 512 * j, row = idx / CPR, ch = idx % CPR;
        v[j] = (u32x4){0u, 0u, 0u, 0u}; if (row >= valid_from) v[j] = *(const u32x4*)(src + (long)row * stride + ch * 8); }
#pragma unroll
    for (int j = 0; j < PER; ++j) { const int idx = tid + 512 * j, row = idx / CPR, ch = idx % CPR; *(LAS u32x4*)(dst + row * STR + ch * 16) = v[j]; }
}
template <int HD, int NT, bool DIL>
__device__ __forceinline__ void attn_unit(LAS unsigned char* lds, const bf16_t* Qp, long qstride, const bf16_t* Kp, const bf16_t* Vp, long kvstride, int valid_from,
                                          bf16_t* Op, long ostride, float* lsep, float scale) {
    constexpr int KSTR = HD * 2 + 16, VSTR = HD * 2 + 32, NC = (NT + 1) / 2, NDT = HD / 16, NQC = HD / 32;
    constexpr bool BOTH = (256 * KSTR + 256 * VSTR) <= LDSCTL_OFF;
    const int tid = fresh_tid(), w = __builtin_amdgcn_readfirstlane(tid >> 6), lane = tid & 63, lq = lane & 15, g4 = lane >> 4;
    LAS unsigned char* Kl = lds; LAS unsigned char* Vl = BOTH ? lds + 256 * KSTR : lds;
    __syncthreads();
    attn_load_tile<HD, KSTR>(Kl, Kp, kvstride, valid_from, tid);
    if (BOTH) attn_load_tile<HD, VSTR>(Vl, Vp, kvstride, valid_from, tid);
    bf16x8 qf[NQC];
#pragma unroll
    for (int c = 0; c < NQC; ++c) qf[c] = *(const bf16x8*)(Qp + (long)(16 * w + lq) * qstride + 32 * c + 8 * g4);
    __syncthreads();
    const int jt0 = DIL ? w : 0;
    f32x4 s[NT];
#pragma unroll
    for (int j = 0; j < NT; ++j) { s[j] = (f32x4){0.f, 0.f, 0.f, 0.f}; const LAS unsigned char* kr = Kl + (16 * (jt0 + j) + lq) * KSTR + 16 * g4;
#pragma unroll
        for (int c = 0; c < NQC; ++c) { const bf16x8 kf = *(const LAS bf16x8*)(kr + 64 * c); s[j] = __builtin_amdgcn_mfma_f32_16x16x32_bf16(kf, qf[c], s[j], 0, 0, 0); } }
    if (!BOTH) { __syncthreads(); attn_load_tile<HD, VSTR>(Vl, Vp, kvstride, valid_from, tid); }
    const float NEG = -__builtin_inff();
    float mx = NEG;
    const int qi = 16 * w + lq;
#pragma unroll
    for (int j = 0; j < NT; ++j)
#pragma unroll
        for (int e = 0; e < 4; ++e) { if (DIL) { const int kr = 16 * (jt0 + j) + 4 * g4 + e; const bool ok = (kr >= qi) && (kr <= qi + 128) && (kr >= valid_from); s[j][e] = ok ? s[j][e] : NEG; } mx = fmaxf(mx, s[j][e]); }
    mx = fmaxf(mx, __shfl_xor(mx, 16)); mx = fmaxf(mx, __shfl_xor(mx, 32));
    const float c2 = scale * 1.4426950408889634f, mb = -mx * c2; float sum = 0.f;
#pragma unroll
    for (int j = 0; j < NT; ++j)
#pragma unroll
        for (int e = 0; e < 4; ++e) { const float p = __builtin_amdgcn_exp2f(fmaf(s[j][e], c2, mb)); s[j][e] = p; sum += p; }
    sum += __shfl_xor(sum, 16); sum += __shfl_xor(sum, 32);
    const float inv = 1.0f / sum;
    bf16x8 pf[NC];
#pragma unroll
    for (int cc = 0; cc < NC; ++cc) { u32x4 wv; wv.x = cvt_pk_bf16(s[2 * cc][0], s[2 * cc][1]); wv.y = cvt_pk_bf16(s[2 * cc][2], s[2 * cc][3]);
        if (2 * cc + 1 < NT) { wv.z = cvt_pk_bf16(s[(2 * cc + 1) % NT][0], s[(2 * cc + 1) % NT][1]); wv.w = cvt_pk_bf16(s[(2 * cc + 1) % NT][2], s[(2 * cc + 1) % NT][3]); } else { wv.z = 0u; wv.w = 0u; }
        pf[cc] = __builtin_bit_cast(bf16x8, wv); }
    if (!BOTH) __syncthreads();
    f32x4 o[NDT];
#pragma unroll
    for (int dt = 0; dt < NDT; ++dt) o[dt] = (f32x4){0.f, 0.f, 0.f, 0.f};
    const unsigned vbase = (unsigned)(size_t)Vl + (unsigned)((16 * jt0 + 4 * g4 + (lq >> 2)) * VSTR + (lq & 3) * 8);
#pragma unroll
    for (int cc = 0; cc < NC; ++cc) {
        const unsigned va = vbase + (unsigned)(cc * 32 * VSTR);
        constexpr int T1OFF = 16 * VSTR;
        const bool has1 = (2 * cc + 1 < NT);
#pragma unroll
        for (int d4 = 0; d4 < NDT; d4 += 4) {
            s16x4 a0, a1, a2, a3, b0, b1, b2, b3;
#define TRRD(dst, addr, off) asm volatile("ds_read_b64_tr_b16 %0, %1 offset:%2" : "=&v"(dst) : "v"(addr), "i"(off) : "memory")
            if (has1) {
                TRRD(a0, va, (d4 + 0) * 32); TRRD(b0, va, (d4 + 0) * 32 + T1OFF); TRRD(a1, va, (d4 + 1) * 32); TRRD(b1, va, (d4 + 1) * 32 + T1OFF);
                TRRD(a2, va, (d4 + 2) * 32); TRRD(b2, va, (d4 + 2) * 32 + T1OFF); TRRD(a3, va, (d4 + 3) * 32); TRRD(b3, va, (d4 + 3) * 32 + T1OFF);
            } else {
                TRRD(a0, va, (d4 + 0) * 32); TRRD(b0, va, (d4 + 0) * 32); TRRD(a1, va, (d4 + 1) * 32); TRRD(b1, va, (d4 + 1) * 32);
                TRRD(a2, va, (d4 + 2) * 32); TRRD(b2, va, (d4 + 2) * 32); TRRD(a3, va, (d4 + 3) * 32); TRRD(b3, va, (d4 + 3) * 32);
            }
#undef TRRD
            asm volatile("s_waitcnt lgkmcnt(0)" ::: "memory"); __builtin_amdgcn_sched_barrier(0);
            o[d4 + 0] = __builtin_amdgcn_mfma_f32_16x16x32_bf16((bf16x8){a0[0], a0[1], a0[2], a0[3], b0[0], b0[1], b0[2], b0[3]}, pf[cc], o[d4 + 0], 0, 0, 0);
            o[d4 + 1] = __builtin_amdgcn_mfma_f32_16x16x32_bf16((bf16x8){a1[0], a1[1], a1[2], a1[3], b1[0], b1[1], b1[2], b1[3]}, pf[cc], o[d4 + 1], 0, 0, 0);
            o[d4 + 2] = __builtin_amdgcn_mfma_f32_16x16x32_bf16((bf16x8){a2[0], a2[1], a2[2], a2[3], b2[0], b2[1], b2[2], b2[3]}, pf[cc], o[d4 + 2], 0, 0, 0);
            o[d4 + 3] = __builtin_amdgcn_mfma_f32_16x16x32_bf16((bf16x8){a3[0], a3[1], a3[2], a3[3], b3[0], b3[1], b3[2], b3[3]}, pf[cc], o[d4 + 3], 0, 0, 0);
        }
    }
    bf16_t* orow = Op + (long)qi * ostride + 4 * g4;
#pragma unroll
    for (int dt = 0; dt < NDT; ++dt) { u32x2 wv; wv.x = cvt_pk_bf16(o[dt][0] * inv, o[dt][1] * inv); wv.y = cvt_pk_bf16(o[dt][2] * inv, o[dt][3] * inv); *(u32x2*)(orow + 16 * dt) = wv; }
    if (lsep && g4 == 0) lsep[qi] = mx * scale + __logf(sum);
}


__device__ __forceinline__ void attn_dil_unit(LAS unsigned char* lds, const bf16_t* Qs, const bf16_t* Ks, const bf16_t* Vs, int valid_from, bf16_t* Os, float* lsep, float scale) {
    constexpr int NT = 9, NC = 5, NDT = 8;
    const int tid = fresh_tid(), w = __builtin_amdgcn_readfirstlane(tid >> 6), lane = tid & 63, lq = lane & 15, g4 = lane >> 4;
    LAS unsigned char* Kl = lds; LAS unsigned char* Vl = lds + 65536;
    __syncthreads();
#pragma unroll
    for (int i = 0; i < 8; ++i) { const int row = 32 * w + 4 * i + g4;
        __builtin_amdgcn_global_load_lds((const unsigned*)(Ks + (size_t)row * HDIM + ((lq ^ (row & 15)) << 3)), (LAS unsigned*)(Kl + (w * 8 + i) * 1024), 16, 0, 0);
        __builtin_amdgcn_global_load_lds((const unsigned*)(Vs + (size_t)row * HDIM + ((lq ^ ((row & 7) << 1)) << 3)), (LAS unsigned*)(Vl + (w * 8 + i) * 1024), 16, 0, 0); }
    bf16x8 qf[4];
#pragma unroll
    for (int c = 0; c < 4; ++c) qf[c] = *(const bf16x8*)(Qs + (size_t)(16 * w + lq) * HDIM + 32 * c + 8 * g4);
    asm volatile("s_waitcnt vmcnt(0)" ::: "memory");
    __syncthreads();
    f32x4 s[NT];
    { unsigned ko[4];
#pragma unroll
      for (int c = 0; c < 4; ++c) ko[c] = (unsigned)(((4 * c + g4) ^ lq) << 4);
      const LAS unsigned char* kb = Kl + (16 * w + lq) * 256;
#pragma unroll
      for (int j = 0; j < NT; ++j) { s[j] = (f32x4){0.f, 0.f, 0.f, 0.f};
#pragma unroll
        for (int c = 0; c < 4; ++c) { const bf16x8 kf = *(const LAS bf16x8*)(kb + j * 4096 + ko[c]); s[j] = __builtin_amdgcn_mfma_f32_16x16x32_bf16(kf, qf[c], s[j], 0, 0, 0); } } }
    const float NEG = -__builtin_inff();
    float mx = NEG;
    const int qi = 16 * w + lq;
#pragma unroll
    for (int j = 0; j < NT; ++j)
#pragma unroll
        for (int e = 0; e < 4; ++e) { const int kr = 16 * (w + j) + 4 * g4 + e; const bool ok = (kr >= qi) && (kr <= qi + 128) && (kr >= valid_from); s[j][e] = ok ? s[j][e] : NEG; mx = fmaxf(mx, s[j][e]); }
    mx = fmaxf(mx, __shfl_xor(mx, 16)); mx = fmaxf(mx, __shfl_xor(mx, 32));
    const float c2 = scale * 1.4426950408889634f, mb = -mx * c2; float sum = 0.f;
#pragma unroll
    for (int j = 0; j < NT; ++j)
#pragma unroll
        for (int e = 0; e < 4; ++e) { const float p = __builtin_amdgcn_exp2f(fmaf(s[j][e], c2, mb)); s[j][e] = p; sum += p; }
    sum += __shfl_xor(sum, 16); sum += __shfl_xor(sum, 32);
    const float inv = 1.0f / sum;
    bf16x8 pf[NC];
#pragma unroll
    for (int cc = 0; cc < NC; ++cc) { u32x4 wv; wv.x = cvt_pk_bf16(s[2 * cc][0], s[2 * cc][1]); wv.y = cvt_pk_bf16(s[2 * cc][2], s[2 * cc][3]);
        if (2 * cc + 1 < NT) { wv.z = cvt_pk_bf16(s[(2 * cc + 1) % NT][0], s[(2 * cc + 1) % NT][1]); wv.w = cvt_pk_bf16(s[(2 * cc + 1) % NT][2], s[(2 * cc + 1) % NT][3]); } else { wv.z = 0u; wv.w = 0u; }
        pf[cc] = __builtin_bit_cast(bf16x8, wv); }
    f32x4 o[NDT];
#pragma unroll
    for (int dt = 0; dt < NDT; ++dt) o[dt] = (f32x4){0.f, 0.f, 0.f, 0.f};
    const int q4 = lq >> 2, p4 = lq & 3, kx = ((4 * g4 + q4) & 7) << 5;
    const unsigned vb = (unsigned)(size_t)Vl + (unsigned)((16 * w + 4 * g4 + q4) * 256 + ((p4 >> 1) << 4) + ((p4 & 1) << 3));
    unsigned va[NDT];
#pragma unroll
    for (int dt = 0; dt < NDT; ++dt) va[dt] = vb + (unsigned)((dt << 5) ^ kx);
#define TRRD(dst, addr, off) asm volatile("ds_read_b64_tr_b16 %0, %1 offset:%2" : "=&v"(dst) : "v"(addr), "i"(off) : "memory")
#pragma unroll
    for (int cc = 0; cc < NC; ++cc) {
        const int o0 = cc * 32 * 256, o1 = (2 * cc + 1 < NT) ? o0 + 16 * 256 : o0;
#pragma unroll
        for (int d4 = 0; d4 < NDT; d4 += 4) {
            s16x4 a0, a1, a2, a3, b0, b1, b2, b3;
            if (cc == 0) { TRRD(a0, va[d4 + 0], 0 * 8192); TRRD(b0, va[d4 + 0], 0 * 8192 + 4096); TRRD(a1, va[d4 + 1], 0 * 8192); TRRD(b1, va[d4 + 1], 0 * 8192 + 4096); TRRD(a2, va[d4 + 2], 0 * 8192); TRRD(b2, va[d4 + 2], 0 * 8192 + 4096); TRRD(a3, va[d4 + 3], 0 * 8192); TRRD(b3, va[d4 + 3], 0 * 8192 + 4096); }
            if (cc == 1) { TRRD(a0, va[d4 + 0], 1 * 8192); TRRD(b0, va[d4 + 0], 1 * 8192 + 4096); TRRD(a1, va[d4 + 1], 1 * 8192); TRRD(b1, va[d4 + 1], 1 * 8192 + 4096); TRRD(a2, va[d4 + 2], 1 * 8192); TRRD(b2, va[d4 + 2], 1 * 8192 + 4096); TRRD(a3, va[d4 + 3], 1 * 8192); TRRD(b3, va[d4 + 3], 1 * 8192 + 4096); }
            if (cc == 2) { TRRD(a0, va[d4 + 0], 2 * 8192); TRRD(b0, va[d4 + 0], 2 * 8192 + 4096); TRRD(a1, va[d4 + 1], 2 * 8192); TRRD(b1, va[d4 + 1], 2 * 8192 + 4096); TRRD(a2, va[d4 + 2], 2 * 8192); TRRD(b2, va[d4 + 2], 2 * 8192 + 4096); TRRD(a3, va[d4 + 3], 2 * 8192); TRRD(b3, va[d4 + 3], 2 * 8192 + 4096); }
            if (cc == 3) { TRRD(a0, va[d4 + 0], 3 * 8192); TRRD(b0, va[d4 + 0], 3 * 8192 + 4096); TRRD(a1, va[d4 + 1], 3 * 8192); TRRD(b1, va[d4 + 1], 3 * 8192 + 4096); TRRD(a2, va[d4 + 2], 3 * 8192); TRRD(b2, va[d4 + 2], 3 * 8192 + 4096); TRRD(a3, va[d4 + 3], 3 * 8192); TRRD(b3, va[d4 + 3], 3 * 8192 + 4096); }
            if (cc == 4) { TRRD(a0, va[d4 + 0], 4 * 8192); TRRD(b0, va[d4 + 0], 4 * 8192); TRRD(a1, va[d4 + 1], 4 * 8192); TRRD(b1, va[d4 + 1], 4 * 8192); TRRD(a2, va[d4 + 2], 4 * 8192); TRRD(b2, va[d4 + 2], 4 * 8192); TRRD(a3, va[d4 + 3], 4 * 8192); TRRD(b3, va[d4 + 3], 4 * 8192); }
            (void)o0; (void)o1;
            asm volatile("s_waitcnt lgkmcnt(0)" ::: "memory"); __builtin_amdgcn_sched_barrier(0);
            o[d4 + 0] = __builtin_amdgcn_mfma_f32_16x16x32_bf16((bf16x8){a0[0], a0[1], a0[2], a0[3], b0[0], b0[1], b0[2], b0[3]}, pf[cc], o[d4 + 0], 0, 0, 0);
            o[d4 + 1] = __builtin_amdgcn_mfma_f32_16x16x32_bf16((bf16x8){a1[0], a1[1], a1[2], a1[3], b1[0], b1[1], b1[2], b1[3]}, pf[cc], o[d4 + 1], 0, 0, 0);
            o[d4 + 2] = __builtin_amdgcn_mfma_f32_16x16x32_bf16((bf16x8){a2[0], a2[1], a2[2], a2[3], b2[0], b2[1], b2[2], b2[3]}, pf[cc], o[d4 + 2], 0, 0, 0);
            o[d4 + 3] = __builtin_amdgcn_mfma_f32_16x16x32_bf16((bf16x8){a3[0], a3[1], a3[2], a3[3], b3[0], b3[1], b3[2], b3[3]}, pf[cc], o[d4 + 3], 0, 0, 0);
        }
    }
#undef TRRD
    bf16_t* orow = Os + (size_t)qi * HDIM + 4 * g4;
#pragma unroll
    for (int dt = 0; dt < NDT; ++dt) { u32x2 wv; wv.x = cvt_pk_bf16(o[dt][0] * inv, o[dt][1] * inv); wv.y = cvt_pk_bf16(o[dt][2] * inv, o[dt][3] * inv); *(u32x2*)(orow + 16 * dt) = wv; }
    if (g4 == 0) lsep[qi] = mx * scale + __logf(sum);
}

struct Args {
    const float* x; const float* mem; const int* pos; const float* g_mem; const float* w_mem_kv; const float* g_mix_pre; const float* g_mix_post; const float* g_ffn_pre; const float* g_ffn_post;
    const float* w_conv_in; const float* conv_mix_w; const float* w_conv_out; const float* w_attn_in; const float* w_attn_out; const float* w_ffn_gate; const float* w_ffn_up; const float* conv_ffn_w; const float* w_ffn_down;
    float* out; unsigned char* ws; int ph_lo, ph_hi;
};

__global__ void __launch_bounds__(512, 2) fwd_kernel(Args a) {
    extern __shared__ __attribute__((aligned(16))) unsigned char lds_raw[];
    LAS unsigned char* lds = (LAS unsigned char*)lds_raw;
    volatile LAS unsigned* MISC = (volatile LAS unsigned*)(lds + LDSCTL_OFF);
    const int tid = threadIdx.x, lane = tid & 63, wave = __builtin_amdgcn_readfirstlane(tid >> 6);
    const int G = gridDim.x, bx = blockIdx.x;
    const int gtid = bx * 512 + tid, nthreads = G * 512, gw = bx * 8 + wave, ngw = G * 8;
    unsigned char* ws = a.ws;
    unsigned* ctl = (unsigned*)(ws + WS_CTL);
    bf16_t* WKV = (bf16_t*)(ws + WS_WKV); bf16_t* WCI = (bf16_t*)(ws + WS_WCI); bf16_t* WCO = (bf16_t*)(ws + WS_WCO); bf16_t* WAI = (bf16_t*)(ws + WS_WAI); bf16_t* WAO = (bf16_t*)(ws + WS_WAO);
    bf16_t* WGU = (bf16_t*)(ws + WS_WGU); bf16_t* WD = (bf16_t*)(ws + WS_WD);
    bf16_t* XN = (bf16_t*)(ws + WS_XN); bf16_t* H = (bf16_t*)(ws + WS_R); bf16_t* GU = (bf16_t*)(ws + WS_R); bf16_t* Y = (bf16_t*)(ws + WS_R);
    bf16_t* QKVL = (bf16_t*)(ws + WS_R); bf16_t* QM = (bf16_t*)(ws + WS_R + 288 * MiB);
    bf16_t* ACT = (bf16_t*)(ws + WS_S); bf16_t* A2 = (bf16_t*)(ws + WS_S); bf16_t* OG = (bf16_t*)(ws + WS_S + 64 * MiB);
    bf16_t* MEMN = (bf16_t*)(ws + WS_MEMN); bf16_t* KV = (bf16_t*)(ws + WS_KV); float* COS = (float*)(ws + WS_COS); float* SIN = (float*)(ws + WS_SIN); float* LSE = (float*)(ws + WS_LSE);
    bf16_t* XRES = (bf16_t*)(ws + WS_XRES);
    float* HALOG = (float*)(ws + WS_HALOG); float* FIRSTG = (float*)(ws + WS_FIRSTG); float* FIRSTU = (float*)(ws + WS_FIRSTU);

    for (int u = tid; u < (LDS_BYTES - LDSCTL_OFF) / 4; u += 512) ((LAS unsigned*)(lds + LDSCTL_OFF))[u] = 0u;
    __syncthreads();
    XcdBarrier bar; bar.bar = ctl + CW_BAR; bar.x = 0; bar.st = nullptr;
    if (ONE_LAUNCH) bar = xcd_barrier_post(ctl + CW_BAR, MISC + 8);
    const int lo = a.ph_lo, hi = a.ph_hi;
#define IN(k) (lo <= (k) && (k) < hi)
#define SEAM(k) do { if (IN(k) && IN((k) + 1)) xcd_barrier(bar); } while (0)
    constexpr size_t SZ_GU = (size_t)N_GU * DM, SZ_D = (size_t)DM * DFF;

    if (IN(0)) {
        LAS float* scr = (LAS float*)(lds + wave * 16384);
        cvt_matrix<0>(a.w_mem_kv, DM, 2 * MW, WKV, 0, scr, gw, ngw, lane);
        for (int m = gw; m < NMEM; m += ngw) rms_row_to_bf16(a.mem + (size_t)m * DM, a.g_mem, MEMN + (size_t)m * DM, lane);
        for (int m = gw; m < SEQ; m += ngw) rms_row_to_bf16(a.x + (size_t)m * DM, a.g_mix_pre, XN + (size_t)m * DM, lane);
        for (int idx = gtid; idx < SEQ * 64; idx += nthreads) { const int t = idx >> 6, i = idx & 63;
            const float ang = (float)a.pos[t] * INV_FREQ[i];
            const double kq = rint((double)ang * 0.15915494309189535); double r = fma(-kq, 6.283185307179586, (double)ang); r = fma(-kq, 2.4492935982947064e-16, r);
            const float rf = (float)r; COS[idx] = cosf(rf); SIN[idx] = sinf(rf); }
    }
    SEAM(0);
    if (IN(1)) {
        if (bx < 8) {
            pg8::Gemm g{MEMN, WKV, DM, DM, DM}; pg8::StaticOrder S; S.init(NMEM, 2 * MW, 8, bx);
            pg8::EpiStore E{KV, 2 * MW};
            pg8::gemm_phase<pg8::EpiStore, pg8::StaticOrder, true>(lds, g, S, E);
        } else {
            LAS float* scr = (LAS float*)(lds + wave * 16384);
            const int cw_ = (bx - 8) * 8 + wave, ncw = (G - 8) * 8;
            cvt_matrix<0>(a.w_conv_in, DM, N_CI, WCI, 0, scr, cw_, ncw, lane);
            cvt_matrix<0>(a.w_conv_out, K_CO, DM, WCO, 0, scr, cw_, ncw, lane);
            cvt_matrix<2>(a.w_ffn_gate, DM, DFF, WGU, 0, scr, cw_, ncw, lane);
            cvt_matrix<3>(a.w_ffn_up, DM, DFF, WGU, 0, scr, cw_, ncw, lane);
            cvt_matrix<0>(a.w_ffn_down, DFF, DM, WD, 0, scr, cw_, ncw, lane);
            cvt_matrix<1>(a.w_attn_in, DM, N_AI, WAI, 0, scr, cw_, ncw, lane);
            cvt_matrix<0>(a.w_attn_out, K_AO, DM, WAO, 0, scr, cw_, ncw, lane);
            cvt_matrix<2>(a.w_ffn_gate + SZ_D, DM, DFF, WGU + SZ_GU, 0, scr, cw_, ncw, lane);
            cvt_matrix<3>(a.w_ffn_up + SZ_D, DM, DFF, WGU + SZ_GU, 0, scr, cw_, ncw, lane);
            cvt_matrix<0>(a.w_ffn_down + SZ_D, DFF, DM, WD + SZ_D, 0, scr, cw_, ncw, lane);
        }
    }
    SEAM(1);
    if (IN(2)) {
        pg8::Gemm g{XN, WCI, DM, DM, DM}; pg8::StaticOrder S; S.init(SEQ, N_CI, G, bx);
        pg8::EpiStore E{H, N_CI};
        pg8::gemm_phase<pg8::EpiStore, pg8::StaticOrder, true>(lds, g, S, E);
    }
    SEAM(2);
    if (IN(3)) {
        for (int u = bx; u < 4 * (SEQ / 128); u += G) { const int hd = u / (SEQ / 128), qb = u % (SEQ / 128);
            attn_unit<256, 16, false>(lds, H + (size_t)(128 * qb) * N_CI + 3 * CW + 256 * hd, N_CI, KV + 256 * hd, KV + MW + 256 * hd, 2 * MW, 0,
                                      A2 + (size_t)(128 * qb) * K_CO + CW + 256 * hd, K_CO, nullptr, 0.0625f); }
        conv_gate_phase(H, a.conv_mix_w, A2, gtid, nthreads);
    }
    SEAM(3);
    if (IN(4)) {
        pg8::Gemm g{A2, WCO, K_CO, K_CO, K_CO}; pg8::StaticOrder S; S.init(SEQ, DM, G, bx);
        pg8::EpiStore E{Y, DM};
        pg8::gemm_phase<pg8::EpiStore, pg8::StaticOrder, true>(lds, g, S, E);
    }
    SEAM(4);
    if (IN(5)) { for (int m = gw; m < SEQ; m += ngw) norm_res_row<true, false, true>(a.x + (size_t)m * DM, Y + (size_t)m * DM, a.g_mix_post, a.g_ffn_pre, XRES + (size_t)m * DM, XN + (size_t)m * DM); }
    SEAM(5);
    if (IN(6)) {
        pg8::Gemm g{XN, WGU, DM, DM, DM}; pg8::StaticOrder S; S.init(SEQ, N_GU, G, bx);
        pg8::EpiFfn E{ACT, a.conv_ffn_w, HALOG, FIRSTG, FIRSTU, lds + RING_BYTES};
        pg8::gemm_phase<pg8::EpiFfn, pg8::StaticOrder, true>(lds, g, S, E);
    }
    SEAM(6);
    if (IN(7)) ffn_fix_phase(HALOG, FIRSTG, FIRSTU, a.conv_ffn_w, ACT, gtid, nthreads);
    SEAM(7);
    if (IN(8)) {
        pg8::Gemm g{ACT, WD, DFF, DFF, DFF}; pg8::StaticOrder S; S.init(SEQ, DM, G, bx);
        pg8::EpiStore E{Y, DM};
        pg8::gemm_phase<pg8::EpiStore, pg8::StaticOrder, true>(lds, g, S, E);
    }
    SEAM(8);
    if (IN(9)) { for (int m = gw; m < SEQ; m += ngw) norm_res_row<false, false, true>(XRES + (size_t)m * DM, Y + (size_t)m * DM, a.g_ffn_post, a.g_mix_pre + DM, XRES + (size_t)m * DM, XN + (size_t)m * DM); }
    SEAM(9);
    if (IN(10)) {
        pg8::Gemm g{XN, WAI, DM, DM, DM}; pg8::StaticOrder S; S.init(SEQ, N_AI, G, bx);
        pg8::EpiQKV E{QKVL, QM, COS, SIN};
        pg8::gemm_phase<pg8::EpiQKV, pg8::StaticOrder, true>(lds, g, S, E);
    }
    SEAM(10);
    if (IN(11)) {
        const int per = (3 * 16 * 64 + G - 1) / G;
        for (int k = 0; k < per; ++k) {
            const int u = bx * per + k; if (u >= 3 * 16 * 64) break;
            const int grp = u >> 10, rem = u & 1023, hd = rem >> 6, blk = rem & 63;
            const int dsh = 2 * grp, nbr = 64 >> dsh, r = blk / nbr, nb = blk % nbr;
            const size_t rowq = (size_t)r * (SEQ >> dsh) + 128 * nb;
            const bf16_t* qs = QKVL + ((size_t)((grp * 3 + 0) * NHEAD + hd) * SEQ + rowq) * HDIM;
            const bf16_t* ks = QKVL + ((size_t)((grp * 3 + 1) * NHEAD + hd) * SEQ + rowq) * HDIM - 128 * HDIM;
            const bf16_t* vs = QKVL + ((size_t)((grp * 3 + 2) * NHEAD + hd) * SEQ + rowq) * HDIM - 128 * HDIM;
            attn_dil_unit(lds, qs, ks, vs, nb == 0 ? 128 : 0, OG + ((size_t)(grp * NHEAD + hd) * SEQ + rowq) * HDIM, LSE + (size_t)(grp * NHEAD + hd) * SEQ + rowq, 0.08838834764831845f);
        }
        for (int u = bx; u < 4 * (SEQ / 128); u += G) { const int hd = u / (SEQ / 128), qb = u % (SEQ / 128);
            attn_unit<256, 16, false>(lds, QM + (size_t)(128 * qb) * MW + 256 * hd, MW, KV + 256 * hd, KV + MW + 256 * hd, 2 * MW, 0,
                                      A2 + (size_t)(128 * qb) * K_AO + GW + 256 * hd, K_AO, nullptr, 0.0625f); }
    }
    SEAM(11);
    if (IN(12)) merge_phase(OG, LSE, A2, gtid, nthreads);
    SEAM(12);
    if (IN(13)) {
        pg8::Gemm g{A2, WAO, K_AO, K_AO, K_AO}; pg8::StaticOrder S; S.init(SEQ, DM, G, bx);
        pg8::EpiStore E{Y, DM};
        pg8::gemm_phase<pg8::EpiStore, pg8::StaticOrder, true>(lds, g, S, E);
    }
    SEAM(13);
    if (IN(14)) { for (int m = gw; m < SEQ; m += ngw) norm_res_row<false, false, true>(XRES + (size_t)m * DM, Y + (size_t)m * DM, a.g_mix_post + DM, a.g_ffn_pre + DM, XRES + (size_t)m * DM, XN + (size_t)m * DM); }
    SEAM(14);
    if (IN(15)) {
        pg8::Gemm g{XN, WGU + SZ_GU, DM, DM, DM}; pg8::StaticOrder S; S.init(SEQ, N_GU, G, bx);
        pg8::EpiFfn E{ACT, a.conv_ffn_w + 3 * DFF, HALOG, FIRSTG, FIRSTU, lds + RING_BYTES};
        pg8::gemm_phase<pg8::EpiFfn, pg8::StaticOrder, true>(lds, g, S, E);
    }
    SEAM(15);
    if (IN(16)) ffn_fix_phase(HALOG, FIRSTG, FIRSTU, a.conv_ffn_w + 3 * DFF, ACT, gtid, nthreads);
    SEAM(16);
    if (IN(17)) {
        pg8::Gemm g{ACT, WD + SZ_D, DFF, DFF, DFF}; pg8::StaticOrder S; S.init(SEQ, DM, G, bx);
        pg8::EpiStore E{Y, DM};
        pg8::gemm_phase<pg8::EpiStore, pg8::StaticOrder, true>(lds, g, S, E);
    }
    SEAM(17);
    if (IN(18)) { for (int m = gw; m < SEQ; m += ngw) norm_res_row<false, true, false>(XRES + (size_t)m * DM, Y + (size_t)m * DM, a.g_ffn_post + DM, nullptr, a.out + (size_t)m * DM, nullptr); }

#ifdef PROBE
    xcd_barrier(bar);
#if PROBE == 1
    { LAS float* scr = (LAS float*)(lds + wave * 16384);
      if (bx >= 8) { const int cw_ = (bx - 8) * 8 + wave, ncw = (G - 8) * 8;
            cvt_matrix<0>(a.w_conv_in, DM, N_CI, WCI, 0, scr, cw_, ncw, lane);
            cvt_matrix<0>(a.w_conv_out, K_CO, DM, WCO, 0, scr, cw_, ncw, lane);
            cvt_matrix<2>(a.w_ffn_gate, DM, DFF, WGU, 0, scr, cw_, ncw, lane);
            cvt_matrix<3>(a.w_ffn_up, DM, DFF, WGU, 0, scr, cw_, ncw, lane);
            cvt_matrix<0>(a.w_ffn_down, DFF, DM, WD, 0, scr, cw_, ncw, lane);
            cvt_matrix<1>(a.w_attn_in, DM, N_AI, WAI, 0, scr, cw_, ncw, lane);
            cvt_matrix<0>(a.w_attn_out, K_AO, DM, WAO, 0, scr, cw_, ncw, lane);
            cvt_matrix<2>(a.w_ffn_gate + SZ_D, DM, DFF, WGU + SZ_GU, 0, scr, cw_, ncw, lane);
            cvt_matrix<3>(a.w_ffn_up + SZ_D, DM, DFF, WGU + SZ_GU, 0, scr, cw_, ncw, lane);
            cvt_matrix<0>(a.w_ffn_down + SZ_D, DFF, DM, WD + SZ_D, 0, scr, cw_, ncw, lane); } }
#elif PROBE == 8
    { pg8::Gemm g{ACT, WD, DFF, DFF, DFF}; pg8::StaticOrder S; S.init(SEQ, DM, G, bx);
      pg8::EpiStore E{Y, DM};
      pg8::gemm_phase<pg8::EpiStore, pg8::StaticOrder, true>(lds, g, S, E); }
#elif PROBE == 4
    { pg8::Gemm g{A2, WCO, K_CO, K_CO, K_CO}; pg8::StaticOrder S; S.init(SEQ, DM, G, bx);
      pg8::EpiStore E{Y, DM};
      pg8::gemm_phase<pg8::EpiStore, pg8::StaticOrder, true>(lds, g, S, E); }
#elif PROBE == 40
    { pg8::Gemm g{A2, WCO, K_CO, K_CO, K_CO}; pg8::SameTileOrder S; S.n = 2;
      pg8::EpiStore E{Y, DM};
      pg8::gemm_phase<pg8::EpiStore, pg8::SameTileOrder, true>(lds, g, S, E); }
#elif PROBE == 6
    { pg8::Gemm g{XN, WGU, DM, DM, DM}; pg8::StaticOrder S; S.init(SEQ, N_GU, G, bx);
      pg8::EpiFfn E{ACT, a.conv_ffn_w, HALOG, FIRSTG, FIRSTU, lds + RING_BYTES};
      pg8::gemm_phase<pg8::EpiFfn, pg8::StaticOrder, true>(lds, g, S, E); }
#elif PROBE == 5
    { float* scratch_x = (float*)(ws + WS_S);
      for (int m = gw; m < SEQ; m += ngw) norm_res_row<true, true, true>(a.x + (size_t)m * DM, Y + (size_t)m * DM, a.g_mix_post, a.g_ffn_pre, scratch_x + (size_t)m * DM, XN + (size_t)m * DM); }
#elif PROBE == 3
    { for (int u = bx; u < 4 * (SEQ / 128); u += G) { const int hd = u / (SEQ / 128), qb = u % (SEQ / 128);
            attn_unit<256, 16, false>(lds, H + (size_t)(128 * qb) * N_CI + 3 * CW + 256 * hd, N_CI, KV + 256 * hd, KV + MW + 256 * hd, 2 * MW, 0,
                                      A2 + (size_t)(128 * qb) * K_CO + CW + 256 * hd, K_CO, nullptr, 0.0625f); }
        conv_gate_phase(H, a.conv_mix_w, A2, gtid, nthreads); }
#endif
#endif
#undef IN
#undef SEAM
}

extern "C" void kernel_launch(void* const* d_in, const int* in_sizes, int n_in, void* d_out, int out_size, void* d_ws, size_t ws_size, hipStream_t stream) {
    static int grid = 0;
    if (grid == 0) {
        if (n_in != 18 || in_sizes[0] != SEQ * DM || out_size != SEQ * DM || ws_size < WS_END) { fprintf(stderr, "kernel_launch: unexpected shapes (n_in %d, in0 %d, out %d, ws %zu < %zu?)\n", n_in, n_in > 0 ? in_sizes[0] : -1, out_size, ws_size, (size_t)WS_END); grid = -1; return; }
        int dev = 0, cus = 0;
        if (hipGetDevice(&dev) != hipSuccess || hipDeviceGetAttribute(&cus, hipDeviceAttributeMultiprocessorCount, dev) != hipSuccess) { grid = -1; return; }
        if (hipFuncSetAttribute((const void*)fwd_kernel, hipFuncAttributeMaxDynamicSharedMemorySize, LDS_BYTES) != hipSuccess) { fprintf(stderr, "kernel_launch: hipFuncSetAttribute failed\n"); grid = -1; return; }
        int per_cu = 0;
        if (hipOccupancyMaxActiveBlocksPerMultiprocessor(&per_cu, (const void*)fwd_kernel, 512, LDS_BYTES) != hipSuccess || per_cu < 1) fprintf(stderr, "kernel_launch: occupancy query says %d\n", per_cu);
        (void)hipGetLastError();
        grid = cus;
        if (grid < 16) { fprintf(stderr, "kernel_launch: needs >= 16 CUs\n"); grid = -1; return; }
    }
    if (grid < 0) return;
    (void)hipMemsetAsync((char*)d_ws + WS_CTL, 0, CTL_ZERO_BYTES, stream);
    Args a{};
    a.x = (const float*)d_in[0]; a.mem = (const float*)d_in[1]; a.pos = (const int*)d_in[2]; a.g_mem = (const float*)d_in[3]; a.w_mem_kv = (const float*)d_in[4];
    a.g_mix_pre = (const float*)d_in[5]; a.g_mix_post = (const float*)d_in[6]; a.g_ffn_pre = (const float*)d_in[7]; a.g_ffn_post = (const float*)d_in[8];
    a.w_conv_in = (const float*)d_in[9]; a.conv_mix_w = (const float*)d_in[10]; a.w_conv_out = (const float*)d_in[11]; a.w_attn_in = (const float*)d_in[12]; a.w_attn_out = (const float*)d_in[13];
    a.w_ffn_gate = (const float*)d_in[14]; a.w_ffn_up = (const float*)d_in[15]; a.conv_ffn_w = (const float*)d_in[16]; a.w_ffn_down = (const float*)d_in[17];
    a.out = (float*)d_out; a.ws = (unsigned char*)d_ws;
#if ONE_LAUNCH
    a.ph_lo = 0; a.ph_hi = NPHASE;
    hipLaunchKernelGGL(fwd_kernel, dim3(grid), dim3(512), LDS_BYTES, stream, a);
#else
    for (int p = 0; p < NPHASE; ++p) { a.ph_lo = p; a.ph_hi = p + 1; hipLaunchKernelGGL(fwd_kernel, dim3(grid), dim3(512), LDS_BYTES, stream, a); }
#endif
}
```

```cpp
#include <hip/hip_runtime.h>
#include <cstdio>
#include <cstdint>

#define LAS __attribute__((address_space(3)))
#define GAS __attribute__((address_space(1)))
typedef unsigned short bf16_t;
typedef short bf16x8 __attribute__((ext_vector_type(8)));
typedef short s16x4 __attribute__((ext_vector_type(4)));
typedef float f32x4 __attribute__((ext_vector_type(4)));
typedef unsigned u32x4 __attribute__((ext_vector_type(4)));
typedef unsigned u32x2 __attribute__((ext_vector_type(2)));

constexpr int SEQ = 8192, DM = 4096, DFF = 11008, CW = 3072, MW = 1024, GW = 2048, NMEM = 256, NHEAD = 16, HDIM = 128;
constexpr int N_CI = 3 * CW + MW;
constexpr int N_AI = 9 * GW + MW;
constexpr int N_GU = 2 * DFF;
constexpr int K_CO = CW + MW;
constexpr int K_AO = GW + MW;
constexpr float EPS = 1e-6f;

#ifndef ONE_LAUNCH
#define ONE_LAUNCH 1
#endif
constexpr int NPHASE = 19;

constexpr size_t MiB = 1u << 20;
constexpr size_t WS_CTL = 0, CTL_ZERO_BYTES = 1 * MiB;
constexpr size_t WS_WKV = 1 * MiB;
constexpr size_t WS_WCI = WS_WKV + 16 * MiB;
constexpr size_t WS_WCO = WS_WCI + 80 * MiB;
constexpr size_t WS_WAI = WS_WCO + 32 * MiB;
constexpr size_t WS_WAO = WS_WAI + 152 * MiB;
constexpr size_t WS_WGU = WS_WAO + 24 * MiB;
constexpr size_t WS_WD  = WS_WGU + 2 * 172 * MiB;
constexpr size_t WS_XN  = WS_WD + 2 * 86 * MiB;
constexpr size_t WS_R   = WS_XN + 64 * MiB;
constexpr size_t WS_S   = WS_R + 344 * MiB;
constexpr size_t WS_MEMN = WS_S + 172 * MiB;
constexpr size_t WS_KV  = WS_MEMN + 2 * MiB;
constexpr size_t WS_COS = WS_KV + 1 * MiB;
constexpr size_t WS_SIN = WS_COS + 2 * MiB;
constexpr size_t WS_LSE = WS_SIN + 2 * MiB;
constexpr size_t WS_HALOG = WS_LSE + 2 * MiB;
constexpr size_t WS_FIRSTG = WS_HALOG + 3 * MiB;
constexpr size_t WS_FIRSTU = WS_FIRSTG + 3 * MiB;
constexpr size_t WS_XRES = WS_FIRSTU + 3 * MiB;
constexpr size_t WS_END = WS_XRES + 64 * MiB;
constexpr int CW_BAR = 4096;

constexpr int RING_BYTES = 131072;
constexpr int LDSCTL_OFF = 146432;
constexpr int LDS_BYTES = 147456;

__device__ __forceinline__ unsigned cvt_pk_bf16(float lo, float hi) { unsigned r; asm("v_cvt_pk_bf16_f32 %0, %1, %2" : "=v"(r) : "v"(lo), "v"(hi)); return r; }
__device__ __forceinline__ float bf_lo(unsigned w) { return __uint_as_float(w << 16); }
__device__ __forceinline__ float bf_hi(unsigned w) { return __uint_as_float(w & 0xffff0000u); }
__device__ __forceinline__ int fresh_lane() { int l; asm volatile("v_mbcnt_lo_u32_b32 %0, -1, 0\n\tv_mbcnt_hi_u32_b32 %0, -1, %0" : "=v"(l)); return l; }
__device__ __forceinline__ int fresh_tid() { int t = threadIdx.x; asm volatile("" : "+v"(t)); return t; }
__device__ __forceinline__ float wave_sum(float v) {
#pragma unroll
    for (int o = 1; o < 64; o <<= 1) v += __shfl_xor(v, o);
    return v;
}

__constant__ float INV_FREQ[64] = {
1.000000000e+00f, 8.659643531e-01f, 7.498942018e-01f, 6.493816376e-01f, 5.623413324e-01f, 4.869675338e-01f, 4.216965139e-01f, 3.651741147e-01f, 3.162277639e-01f, 2.738419771e-01f, 2.371373773e-01f, 2.053525001e-01f, 1.778279394e-01f, 1.539926529e-01f, 1.333521456e-01f, 1.154781953e-01f,
1.000000015e-01f, 8.659642935e-02f, 7.498942316e-02f, 6.493816525e-02f, 5.623413250e-02f, 4.869675264e-02f, 4.216964915e-02f, 3.651741147e-02f, 3.162277490e-02f, 2.738419548e-02f, 2.371373773e-02f, 2.053525113e-02f, 1.778279431e-02f, 1.539926510e-02f, 1.333521400e-02f, 1.154781971e-02f,
9.999999776e-03f, 8.659643121e-03f, 7.498942316e-03f, 6.493816152e-03f, 5.623413250e-03f, 4.869675264e-03f, 4.216964822e-03f, 3.651741194e-03f, 3.162277630e-03f, 2.738419687e-03f, 2.371373819e-03f, 2.053525066e-03f, 1.778279431e-03f, 1.539926510e-03f, 1.333521446e-03f, 1.154782018e-03f,
1.000000047e-03f, 8.659643354e-04f, 7.498941850e-04f, 6.493816036e-04f, 5.623413017e-04f, 4.869675322e-04f, 4.216965172e-04f, 3.651741135e-04f, 3.162277571e-04f, 2.738419571e-04f, 2.371373703e-04f, 2.053525095e-04f, 1.778279402e-04f, 1.539926598e-04f, 1.333521504e-04f, 1.154782003e-04f };

namespace pg8 {
constexpr int BM = 256, BK = 64, HALF = 128, HTB = HALF * BK * 2, STAGE_BYTES = 8 * HTB, NXCD = 8, WGM = 8;
__host__ __device__ __forceinline__ int lds_byte(int r, int c) { const int st = (r >> 4) * 2 + (c >> 5), rr = r & 15, cc = c & 31, ob = rr * 64 + cc * 2; return st * 1024 + (ob ^ (((ob >> 9) & 1) << 5)); }
__host__ __device__ __forceinline__ void stage_rc(int b, int& R, int& C) { const int st = b / 1024, sb = b % 1024, swz = sb ^ (((sb >> 9) & 1) << 5); R = (st >> 1) * 16 + swz / 64; C = (st & 1) * 32 + (swz % 64) / 2; }
__host__ __device__ __forceinline__ int perm32(int rho) { const int n = rho >> 4, i = rho & 15; return 8 * (i >> 2) + 4 * n + (i & 3); }

struct Unit { int pm, pn; };
struct SameTileOrder { int n;
    __device__ bool next(int i, Unit& u) const { if (i >= n) return false; u.pm = 0; u.pn = 0; return true; }
    __device__ __forceinline__ void a_ready(const Unit&) const {}
    __device__ __forceinline__ void done(const Unit&) const {} };
struct Gemm { const bf16_t* A; const bf16_t* Bt; int K, lda, ldb; };

struct StaticOrder {
    int nM, nN, nwg, G, c;
    __host__ __device__ void init(int M, int N, int G_, int c_) { nM = M / BM; nN = N / BM; nwg = nM * nN; G = G_; c = c_; }
    __host__ __device__ bool next(int i, Unit& u) const {
        const long L = (long)i * G + c; if (L >= nwg) return false;
        int wgid = (int)L; { const int q = nwg / NXCD, r = nwg % NXCD, xcd = wgid % NXCD, off = wgid / NXCD; wgid = (xcd < r ? xcd * (q + 1) : r * (q + 1) + (xcd - r) * q) + off; }
        const int nig = WGM * nN, gid = wgid / nig, fm = gid * WGM, gsz = (nM - fm) < WGM ? (nM - fm) : WGM;
        u.pm = fm + ((wgid % nig) % gsz); u.pn = (wgid % nig) / gsz; return true;
    }
    __device__ __forceinline__ void a_ready(const Unit&) const {}
    __device__ __forceinline__ void done(const Unit&) const {}
};

struct EpiStore {
    static constexpr bool PERM = true, AFTER_DRAIN = false;
    bf16_t* O; int ldc;
    __device__ __forceinline__ void operator()(const f32x4 (&acc)[2][2][4][2], const Unit& u, int wr, int wc, int fr, int fq) const {
        const int row0 = u.pm * BM + wr * 64 + fr, col0 = u.pn * BM + wc * 32 + 8 * fq;
#pragma unroll
        for (int ai = 0; ai < 2; ++ai)
#pragma unroll
            for (int m = 0; m < 4; ++m) { bf16_t* rowp = O + (size_t)(row0 + ai * HALF + m * 16) * ldc + col0;
#pragma unroll
                for (int bj = 0; bj < 2; ++bj) { const f32x4 v0 = acc[ai][bj][m][0], v1 = acc[ai][bj][m][1];
                    u32x4 w; w.x = cvt_pk_bf16(v0[0], v0[1]); w.y = cvt_pk_bf16(v0[2], v0[3]); w.z = cvt_pk_bf16(v1[0], v1[1]); w.w = cvt_pk_bf16(v1[2], v1[3]);
                    *(u32x4*)(rowp + bj * HALF) = w; } }
    }
};
struct EpiQKV {
    static constexpr bool PERM = true, AFTER_DRAIN = false;
    bf16_t* QKVL; bf16_t* QM; const float* cosT; const float* sinT;
    __device__ __forceinline__ void operator()(const f32x4 (&acc)[2][2][4][2], const Unit& u, int wr, int wc, int fr, int fq) const {
        const int colt = u.pn * BM;
        const int row0 = u.pm * BM + wr * 64 + fr;
        if (colt >= 9 * GW) {
            const int col0 = colt - 9 * GW + wc * 32 + 8 * fq;
#pragma unroll
            for (int ai = 0; ai < 2; ++ai)
#pragma unroll
                for (int m = 0; m < 4; ++m) { bf16_t* rowp = QM + (size_t)(row0 + ai * HALF + m * 16) * MW + col0;
#pragma unroll
                    for (int bj = 0; bj < 2; ++bj) { const f32x4 v0 = acc[ai][bj][m][0], v1 = acc[ai][bj][m][1];
                        u32x4 w; w.x = cvt_pk_bf16(v0[0], v0[1]); w.y = cvt_pk_bf16(v0[2], v0[3]); w.z = cvt_pk_bf16(v1[0], v1[1]); w.w = cvt_pk_bf16(v1[2], v1[3]);
                        *(u32x4*)(rowp + bj * HALF) = w; } }
        } else {
            const int g = colt / (3 * GW), rem = colt % (3 * GW), part = rem / GW, hd0 = (rem % GW) / HDIM, dsh = 2 * g, dm1 = (1 << dsh) - 1;
            bf16_t* slab0 = QKVL + (size_t)((g * 3 + part) * NHEAD + hd0) * SEQ * HDIM;
            if (part == 2) {
#pragma unroll
                for (int ai = 0; ai < 2; ++ai)
#pragma unroll
                    for (int m = 0; m < 4; ++m) { const int row = row0 + ai * HALF + m * 16; const int rp = ((row & dm1) << (13 - dsh)) + (row >> dsh);
#pragma unroll
                        for (int bj = 0; bj < 2; ++bj) { const f32x4 v0 = acc[ai][bj][m][0], v1 = acc[ai][bj][m][1];
                            u32x4 w; w.x = cvt_pk_bf16(v0[0], v0[1]); w.y = cvt_pk_bf16(v0[2], v0[3]); w.z = cvt_pk_bf16(v1[0], v1[1]); w.w = cvt_pk_bf16(v1[2], v1[3]);
                            *(u32x4*)(slab0 + ((size_t)bj * SEQ + rp) * HDIM + wc * 32 + 8 * fq) = w; } }
            } else {
                const int x0 = wc * 32 + 8 * fq, hh = x0 >> 6, d0 = x0 & 63;
#pragma unroll
                for (int ai = 0; ai < 2; ++ai)
#pragma unroll
                    for (int m = 0; m < 4; ++m) { const int row = row0 + ai * HALF + m * 16; const int rp = ((row & dm1) << (13 - dsh)) + (row >> dsh);
                        const f32x4 c0 = *(const f32x4*)(cosT + (size_t)row * 64 + d0), c1 = *(const f32x4*)(cosT + (size_t)row * 64 + d0 + 4);
                        const f32x4 s0 = *(const f32x4*)(sinT + (size_t)row * 64 + d0), s1 = *(const f32x4*)(sinT + (size_t)row * 64 + d0 + 4);
                        const f32x4 a0 = acc[ai][0][m][0], a1 = acc[ai][0][m][1], b0 = acc[ai][1][m][0], b1 = acc[ai][1][m][1];
                        const f32x4 o10 = a0 * c0 - b0 * s0, o11 = a1 * c1 - b1 * s1, o20 = b0 * c0 + a0 * s0, o21 = b1 * c1 + a1 * s1;
                        bf16_t* rowp = slab0 + ((size_t)hh * SEQ + rp) * HDIM + d0;
                        u32x4 w; w.x = cvt_pk_bf16(o10[0], o10[1]); w.y = cvt_pk_bf16(o10[2], o10[3]); w.z = cvt_pk_bf16(o11[0], o11[1]); w.w = cvt_pk_bf16(o11[2], o11[3]);
                        *(u32x4*)(rowp) = w;
                        w.x = cvt_pk_bf16(o20[0], o20[1]); w.y = cvt_pk_bf16(o20[2], o20[3]); w.z = cvt_pk_bf16(o21[0], o21[1]); w.w = cvt_pk_bf16(o21[2], o21[3]);
                        *(u32x4*)(rowp + 64) = w;
                        asm volatile("" ::: "memory"); }
            }
        }
    }
};
__device__ __forceinline__ float dpp_ror1(float v) { return __builtin_bit_cast(float, __builtin_amdgcn_update_dpp(0, __builtin_bit_cast(int, v), 0x121, 0xf, 0xf, false)); }
__device__ __forceinline__ float dpp_ror2(float v) { return __builtin_bit_cast(float, __builtin_amdgcn_update_dpp(0, __builtin_bit_cast(int, v), 0x122, 0xf, 0xf, false)); }
struct EpiFfn {
    static constexpr bool PERM = true, AFTER_DRAIN = false;
    bf16_t* ACT; const float* cw; float* HALOG; float* FIRSTG; float* FIRSTU; LAS unsigned char* xl;
    __device__ __forceinline__ void operator()(const f32x4 (&acc)[2][2][4][2], const Unit& u, int wr, int wc, int fr, int fq) const {
        const int ch0 = u.pn * 128 + wc * 32 + 8 * fq;
        LAS f32x4* hl = (LAS f32x4*)xl;
        if (fr >= 14) {
#pragma unroll
            for (int ai = 0; ai < 2; ++ai) { const int idx = ((((ai * 2 + wr) * 4 + wc) * 2 + (fr - 14)) * 4 + fq) * 2; hl[idx] = acc[ai][0][3][0]; hl[idx + 1] = acc[ai][0][3][1]; }
        }
        float w0[8], w1[8], w2[8];
        { const f32x4 a0 = *(const f32x4*)(cw + ch0), a1 = *(const f32x4*)(cw + ch0 + 4), b0 = *(const f32x4*)(cw + DFF + ch0), b1 = *(const f32x4*)(cw + DFF + ch0 + 4), c0 = *(const f32x4*)(cw + 2 * DFF + ch0), c1 = *(const f32x4*)(cw + 2 * DFF + ch0 + 4);
#pragma unroll
          for (int i = 0; i < 4; ++i) { w0[i] = a0[i]; w0[4 + i] = a1[i]; w1[i] = b0[i]; w1[4 + i] = b1[i]; w2[i] = c0[i]; w2[4 + i] = c1[i]; } }
        asm volatile("s_waitcnt lgkmcnt(0)" ::: "memory"); __builtin_amdgcn_s_barrier(); asm volatile("" ::: "memory");
#pragma unroll
        for (int ai = 0; ai < 2; ++ai) {
            const bool ext = (wr == 0 && ai == 0);
            float x14[8], x15[8];
            if (ext) {
#pragma unroll
                for (int i = 0; i < 8; ++i) { x14[i] = 0.f; x15[i] = 0.f; }
            } else {
                const int sai = (wr == 1) ? ai : 0, swr = (wr == 1) ? 0 : 1;
                const int b = ((((sai * 2 + swr) * 4 + wc) * 2) * 4 + fq) * 2;
                const f32x4 p0 = hl[b], p1 = hl[b + 1], q0 = hl[b + 8], q1 = hl[b + 9];
#pragma unroll
                for (int i = 0; i < 4; ++i) { x14[i] = p0[i]; x14[4 + i] = p1[i]; x15[i] = q0[i]; x15[4 + i] = q1[i]; }
            }
            float r1p[8], r2p[8];
#pragma unroll
            for (int i = 0; i < 8; ++i) { r1p[i] = x15[i]; r2p[i] = (fr == 0) ? x14[i] : x15[i]; }
#pragma unroll
            for (int m = 0; m < 4; ++m) {
                float cur[8], up[8], o[8];
#pragma unroll
                for (int i = 0; i < 4; ++i) { cur[i] = acc[ai][0][m][0][i]; cur[4 + i] = acc[ai][0][m][1][i]; up[i] = acc[ai][1][m][0][i]; up[4 + i] = acc[ai][1][m][1][i]; }
                const int row = u.pm * BM + ai * HALF + wr * 64 + m * 16 + fr;
#pragma unroll
                for (int i = 0; i < 8; ++i) {
                    const float r1 = dpp_ror1(cur[i]), r2 = dpp_ror2(cur[i]);
                    const float p1 = (fr >= 1) ? r1 : r1p[i], p2 = (fr >= 2) ? r2 : r2p[i];
                    const float g = w0[i] * p2 + w1[i] * p1 + w2[i] * cur[i];
                    o[i] = g * __builtin_amdgcn_rcpf(1.0f + __builtin_amdgcn_exp2f(-1.4426950408889634f * g)) * up[i];
                    r1p[i] = r1; r2p[i] = r2;
                }
                const bool first2 = ext && m == 0 && fr < 2 && u.pm > 0;
                if (!first2) {
                    u32x4 w; w.x = cvt_pk_bf16(o[0], o[1]); w.y = cvt_pk_bf16(o[2], o[3]); w.z = cvt_pk_bf16(o[4], o[5]); w.w = cvt_pk_bf16(o[6], o[7]);
                    *(u32x4*)(ACT + (size_t)row * DFF + ch0) = w;
                } else {
                    float* fg = FIRSTG + (size_t)(u.pm * 2 + fr) * DFF + ch0; float* fu = FIRSTU + (size_t)(u.pm * 2 + fr) * DFF + ch0;
                    *(f32x4*)fg = acc[ai][0][m][0]; *(f32x4*)(fg + 4) = acc[ai][0][m][1]; *(f32x4*)fu = acc[ai][1][m][0]; *(f32x4*)(fu + 4) = acc[ai][1][m][1];
                }
                if (ai == 1 && wr == 1 && m == 3 && fr >= 14) { float* hg = HALOG + (size_t)(u.pm * 2 + fr - 14) * DFF + ch0; *(f32x4*)hg = acc[ai][0][m][0]; *(f32x4*)(hg + 4) = acc[ai][0][m][1]; }
            }
        }
    }
};

template <class Epi, class Sched, bool ALIGN_EPI>
__device__ __forceinline__ void gemm_phase(LAS unsigned char* lds, const Gemm g, const Sched& S, const Epi& E) {
    const int tid = fresh_tid(), wid = __builtin_amdgcn_readfirstlane(tid >> 6), lane = tid & 63, wr = wid >> 2, wc = wid & 3, fr = lane & 15, fq = lane >> 4;
    const int K = g.K, nt = K / BK;
    unsigned voffA[2], voffB[2];
#pragma unroll
    for (int i = 0; i < 2; ++i) { int R, C; stage_rc(tid * 16 + i * 8192, R, C); const int Rb = Epi::PERM ? ((R & ~31) + perm32(R & 31)) : R;
        voffA[i] = (unsigned)(R * g.lda + C) * 2u; voffB[i] = (unsigned)(Rb * g.ldb + C) * 2u; }
    const size_t kstep = (size_t)(BK * 2);
    const size_t hstepA = (size_t)HALF * g.lda * 2, hstepB = (size_t)HALF * g.ldb * 2;
    const size_t tstepA = 2 * hstepA, tstepB = 2 * hstepB;
    const unsigned ldsw = (unsigned)wid * 1024u;
    const int aoff = lds_byte(wr * 64 + fr, fq * 8), boff = lds_byte(wc * 32 + fr, fq * 8);
#define PG8_SA(b, h) (((b) * 2 + (h)) * HTB)
#define PG8_SB(b, h) ((4 + (b) * 2 + (h)) * HTB)
#define PG8_STAGE(bufoff, gbase, voff) do { _Pragma("unroll") for (int _i = 0; _i < 2; ++_i) \
        __builtin_amdgcn_global_load_lds((const unsigned*)((const char*)(gbase) + (voff)[_i]), (LAS unsigned*)(lds + (bufoff) + ldsw + _i * 8192), 16, 0, 0); } while (0)
#define PG8_LDA(dst, b, h) do { _Pragma("unroll") for (int m = 0; m < 4; ++m) _Pragma("unroll") for (int k = 0; k < 2; ++k) dst[m][k] = *(const LAS bf16x8*)(lds + PG8_SA(b, h) + aoff + m * 2048 + k * 1024); } while (0)
#define PG8_LDB(dst, b, h) do { _Pragma("unroll") for (int n = 0; n < 2; ++n) _Pragma("unroll") for (int k = 0; k < 2; ++k) dst[n][k] = *(const LAS bf16x8*)(lds + PG8_SB(b, h) + boff + n * 2048 + k * 1024); } while (0)
#define PG8_MMA(ai, bj, At, Bt) do { __builtin_amdgcn_s_setprio(1); _Pragma("unroll") for (int m = 0; m < 4; ++m) _Pragma("unroll") for (int n = 0; n < 2; ++n) _Pragma("unroll") for (int k = 0; k < 2; ++k) \
        acc[ai][bj][m][n] = __builtin_amdgcn_mfma_f32_16x16x32_bf16(Bt[n][k], At[m][k], acc[ai][bj][m][n], 0, 0, 0); __builtin_amdgcn_s_setprio(0); } while (0)
#define PG8_WAIT_V(n) asm volatile("s_waitcnt vmcnt(" #n ")" ::: "memory")
#define PG8_WAIT_L(n) asm volatile("s_waitcnt lgkmcnt(" #n ")" ::: "memory")
#define PG8_BAR __builtin_amdgcn_s_barrier()
#define PG8_SCHED __builtin_amdgcn_sched_barrier(0)
    Unit cur, nxt; int ui = 0;
    if (!S.next(0, cur)) return;
    f32x4 acc[2][2][4][2];
#pragma unroll
    for (int a = 0; a < 2; ++a)
#pragma unroll
        for (int b = 0; b < 2; ++b)
#pragma unroll
            for (int m = 0; m < 4; ++m)
#pragma unroll
                for (int n = 0; n < 2; ++n) acc[a][b][m][n] = (f32x4){0.f, 0.f, 0.f, 0.f};
    bf16x8 At[4][2], B0[2][2], B1[2][2];
    const char* cA = (const char*)g.A + (size_t)cur.pm * tstepA; const char* cB = (const char*)g.Bt + (size_t)cur.pn * tstepB;
    S.a_ready(cur);
    PG8_STAGE(PG8_SB(0, 0), cB, voffB); PG8_STAGE(PG8_SB(0, 1), cB + hstepB, voffB); PG8_STAGE(PG8_SA(0, 0), cA, voffA); PG8_STAGE(PG8_SA(0, 1), cA + hstepA, voffA);
    if (wr == 1) PG8_BAR;
    PG8_WAIT_V(2); PG8_BAR;
    PG8_STAGE(PG8_SB(1, 0), cB + kstep, voffB); PG8_STAGE(PG8_SA(1, 0), cA + kstep, voffA); PG8_STAGE(PG8_SB(1, 1), cB + hstepB + kstep, voffB);
    PG8_WAIT_V(6); PG8_BAR;
    for (;;) {
        const bool has_next = S.next(ui + 1, nxt);
        const char* nA = has_next ? (const char*)g.A + (size_t)nxt.pm * tstepA : cA; const char* nB = has_next ? (const char*)g.Bt + (size_t)nxt.pn * tstepB : cB;
        for (int t = 0; t < nt; t += 2) {
            const bool last = (t == nt - 2);
            const char* a1 = cA + (size_t)(t + 1) * kstep;
            const char* a2 = last ? nA : cA + (size_t)(t + 2) * kstep; const char* b2 = last ? nB : cB + (size_t)(t + 2) * kstep;
            const char* a3 = a2 + kstep; const char* b3 = b2 + kstep;
            if (last && has_next) S.a_ready(nxt);
            PG8_LDB(B0, 0, 0); PG8_LDB(B1, 0, 1); PG8_SCHED; PG8_LDA(At, 0, 0); PG8_STAGE(PG8_SA(1, 1), a1 + hstepA, voffA);
            PG8_WAIT_V(8); PG8_WAIT_L(0); PG8_BAR; PG8_MMA(0, 0, At, B0); PG8_MMA(0, 1, At, B1); PG8_BAR; PG8_SCHED;
            PG8_LDA(At, 0, 1); PG8_STAGE(PG8_SB(0, 0), b2, voffB); PG8_STAGE(PG8_SB(0, 1), b2 + hstepB, voffB); PG8_STAGE(PG8_SA(0, 0), a2, voffA);
            PG8_WAIT_V(8); PG8_WAIT_L(0); PG8_BAR; PG8_MMA(1, 0, At, B0); PG8_MMA(1, 1, At, B1); PG8_BAR; PG8_SCHED;
            PG8_LDB(B0, 1, 0); PG8_LDB(B1, 1, 1); PG8_SCHED; PG8_LDA(At, 1, 0); PG8_STAGE(PG8_SA(0, 1), a2 + hstepA, voffA);
            PG8_WAIT_V(8); PG8_WAIT_L(0); PG8_BAR; PG8_MMA(0, 0, At, B0); PG8_MMA(0, 1, At, B1); PG8_BAR; PG8_SCHED;
            PG8_LDA(At, 1, 1); PG8_STAGE(PG8_SB(1, 0), b3, voffB); PG8_STAGE(PG8_SB(1, 1), b3 + hstepB, voffB); PG8_STAGE(PG8_SA(1, 0), a3, voffA);
            PG8_WAIT_V(8); PG8_WAIT_L(0); PG8_BAR; PG8_MMA(1, 0, At, B0); PG8_MMA(1, 1, At, B1); PG8_BAR; PG8_SCHED;
        }
        if constexpr (ALIGN_EPI) { if (wr == 0) PG8_BAR; }
        E(acc, cur, wr, wc, fr, fq); S.done(cur);
        if (!has_next) break;
#pragma unroll
        for (int a = 0; a < 2; ++a)
#pragma unroll
            for (int b = 0; b < 2; ++b)
#pragma unroll
                for (int m = 0; m < 4; ++m)
#pragma unroll
                    for (int n = 0; n < 2; ++n) acc[a][b][m][n] = (f32x4){0.f, 0.f, 0.f, 0.f};
        cur = nxt; cA = nA; cB = nB; ++ui;
        if constexpr (ALIGN_EPI) { if (wr == 1) PG8_BAR; }
    }
    PG8_WAIT_V(0);
    if constexpr (!ALIGN_EPI) { if (wr == 0) PG8_BAR; }
    PG8_BAR;
#undef PG8_SA
#undef PG8_SB
#undef PG8_STAGE
#undef PG8_LDA
#undef PG8_LDB
#undef PG8_MMA
#undef PG8_WAIT_V
#undef PG8_WAIT_L
#undef PG8_BAR
#undef PG8_SCHED
}
}

#define XB_TMO      128
#define XB_XCNT(j)  (256  + 64 * (j))
#define XB_XSUB(j)  (1280 + 64 * (j))
#define XB_XGEN(j)  (2304 + 64 * (j))
#define XB_TOP      3328
#define XB_TOPGEN   3392
#define XCD_BAR_WORDS 3456
#define XB_SPIN_CAP (1u << 18)
__device__ __forceinline__ unsigned xb_ld(unsigned* p)              { return __hip_atomic_load(p, __ATOMIC_RELAXED, __HIP_MEMORY_SCOPE_AGENT); }
__device__ __forceinline__ unsigned xb_add(unsigned* p, unsigned v) { return __hip_atomic_fetch_add(p, v, __ATOMIC_RELAXED, __HIP_MEMORY_SCOPE_AGENT); }
__device__ __forceinline__ unsigned xb_xcc_id() { return (unsigned)__builtin_amdgcn_s_getreg((3 << 11) | 20) & 0xFu; }
#define XB_SPIN(cond, bar) do { unsigned _sp = 0; while (cond) { __builtin_amdgcn_s_sleep(1); \
    if ((++_sp & 255u) == 0u) { if (xb_ld(&(bar)[XB_TMO])) break; if (_sp > XB_SPIN_CAP) { atomicAdd(&(bar)[XB_TMO], 1u); break; } } } } while (0)
struct XcdBarrier { unsigned* bar; unsigned x; volatile LAS unsigned* st; };
__device__ __forceinline__ XcdBarrier xcd_barrier_post(unsigned* bar, volatile LAS unsigned* st) {
    XcdBarrier b; b.bar = bar; b.x = xb_xcc_id(); b.st = st;
    if (threadIdx.x == 0) (void)xb_add(&bar[XB_XCNT(b.x)], 1u);
    return b;
}
__device__ __forceinline__ void xcd_barrier_complete(unsigned* bar, unsigned x, unsigned& nloc, unsigned& nx) {
    const unsigned G = gridDim.x * gridDim.y * gridDim.z;
    unsigned sum, cnt, mine, sp = 0u;
    for (;;) {
        sum = 0u; cnt = 0u; mine = 0u;
#pragma unroll
        for (unsigned j = 0; j < 16; ++j) { const unsigned c = xb_ld(&bar[XB_XCNT(j)]); sum += c; cnt += (c > 0u) ? 1u : 0u; mine = (j == x) ? c : mine; }
        if (sum == G) break;
        __builtin_amdgcn_s_sleep(1);
        if ((++sp & 255u) == 0u) { if (xb_ld(&bar[XB_TMO])) break; if (sp > XB_SPIN_CAP) { atomicAdd(&bar[XB_TMO], 1u); break; } }
    }
    nloc = mine > 0u ? mine : 1u; nx = cnt > 0u ? cnt : 1u;
}
__device__ __forceinline__ void xcd_barrier(const XcdBarrier& b) {
    asm volatile("s_waitcnt vmcnt(0)" ::: "memory");
    __syncthreads();
    if (threadIdx.x == 0) {
        unsigned* bar = b.bar;
        __builtin_amdgcn_s_waitcnt(0);
        unsigned nloc = b.st[0], nx = b.st[1];
        if (nloc == 0u) { xcd_barrier_complete(bar, b.x, nloc, nx); b.st[0] = nloc; b.st[1] = nx; }
        const unsigned old = xb_add(&bar[XB_XSUB(b.x)], 1u);
        const unsigned gen = old / nloc;
        if (old + 1u == (gen + 1u) * nloc) {
            __builtin_amdgcn_fence(__ATOMIC_RELEASE, "agent");
            asm volatile("s_waitcnt vmcnt(0)" ::: "memory");
            const unsigned og = xb_add(&bar[XB_TOP], 1u);
            const unsigned tg = og / nx;
            if (og + 1u == (tg + 1u) * nx) xb_add(&bar[XB_TOPGEN], 1u);
            else XB_SPIN(xb_ld(&bar[XB_TOPGEN]) == tg, bar);
            __builtin_amdgcn_fence(__ATOMIC_ACQUIRE, "agent");
            xb_add(&bar[XB_XGEN(b.x)], 1u);
            asm volatile("s_waitcnt vmcnt(0)" ::: "memory");
        } else {
            XB_SPIN(xb_ld(&bar[XB_XGEN(b.x)]) == gen, bar);
            __builtin_amdgcn_fence(__ATOMIC_ACQUIRE, "agent");
            asm volatile("s_waitcnt vmcnt(0)" ::: "memory");
        }
    }
    __syncthreads();
}

template <int MODE  >
__device__ __forceinline__ void cvt_matrix(const float* W, int K, int N, bf16_t* WT, int row_off, LAS float* scr, int gw, int ngw, int) {
    const int lane = fresh_lane();
    const int nblk = N / 32, nitems = (K / 64) * nblk;
    for (int item = gw; item < nitems; item += ngw) {
        const int kb = item / nblk, nb = item % nblk, k0 = 64 * kb, n0 = 32 * nb;
#pragma unroll 8
        for (int i = 0; i < 32; ++i) { const int kk = 2 * i + (lane >> 5); scr[kk * 33 + (lane & 31)] = W[(size_t)(k0 + kk) * N + n0 + (lane & 31)]; }
        asm volatile("s_waitcnt lgkmcnt(0)" ::: "memory");
        int d0 = n0;
        if (MODE == 1) { if (n0 < 9 * GW && (n0 % (3 * GW)) < 2 * GW) d0 = (n0 & ~0xC0) | ((n0 & 0x40) << 1) | ((n0 & 0x80) >> 1); }
        if (MODE == 2) d0 = (n0 >> 7) * 256 + (n0 & 127);
        if (MODE == 3) d0 = (n0 >> 7) * 256 + 128 + (n0 & 127);
        const int c = lane & 7;
#pragma unroll
        for (int j = 0; j < 4; ++j) { const int n = (lane >> 3) + 8 * j; const LAS float* s = scr + (8 * c) * 33 + n;
            u32x4 o; o.x = cvt_pk_bf16(s[0 * 33], s[1 * 33]); o.y = cvt_pk_bf16(s[2 * 33], s[3 * 33]); o.z = cvt_pk_bf16(s[4 * 33], s[5 * 33]); o.w = cvt_pk_bf16(s[6 * 33], s[7 * 33]);
            *(u32x4*)(WT + (size_t)(row_off + d0 + n) * K + k0 + 8 * c) = o; }
        asm volatile("s_waitcnt lgkmcnt(0)" ::: "memory");
    }
}
__device__ __forceinline__ void rms_row_to_bf16(const float* xrow, const float* g, bf16_t* orow, int) {
    const int lane = fresh_lane();
    const f32x4* xr = (const f32x4*)xrow + lane;
    f32x4 v[16]; float s = 0.f;
#pragma unroll
    for (int j = 0; j < 16; ++j) { v[j] = xr[64 * j]; s += (v[j].x * v[j].x + v[j].y * v[j].y) + (v[j].z * v[j].z + v[j].w * v[j].w); }
    const float rstd = 1.0f / sqrtf(wave_sum(s) * (1.f / DM) + EPS);
    const f32x4* gr = (const f32x4*)g + lane; u32x2* o8 = (u32x2*)orow + lane;
#pragma unroll
    for (int j = 0; j < 16; ++j) { const f32x4 gv = gr[64 * j]; u32x2 w; w.x = cvt_pk_bf16(v[j].x * rstd * gv.x, v[j].y * rstd * gv.y); w.y = cvt_pk_bf16(v[j].z * rstd * gv.z, v[j].w * rstd * gv.w); o8[64 * j] = w; }
}
template <bool SRC_F32, bool DST_F32, bool HAS_XN>
__device__ __forceinline__ void norm_res_row(const void* xsrc, const bf16_t* yrow, const float* gpost, const float* gpre, void* xout, bf16_t* xn) {
    const int lane = fresh_lane();
    const u32x2* yr = (const u32x2*)yrow + lane; f32x4 y[16]; float s = 0.f;
#pragma unroll
    for (int j = 0; j < 16; ++j) { const u32x2 w = yr[64 * j]; y[j] = (f32x4){bf_lo(w.x), bf_hi(w.x), bf_lo(w.y), bf_hi(w.y)}; s += (y[j].x * y[j].x + y[j].y * y[j].y) + (y[j].z * y[j].z + y[j].w * y[j].w); }
    const float rstd = 1.0f / sqrtf(wave_sum(s) * (1.f / DM) + EPS);
    const f32x4* gp = (const f32x4*)gpost + lane; float s2 = 0.f;
#pragma unroll
    for (int j = 0; j < 16; ++j) { f32x4 xv;
        if (SRC_F32) xv = ((const f32x4*)xsrc + lane)[64 * j]; else { const u32x2 w = ((const u32x2*)xsrc + lane)[64 * j]; xv = (f32x4){bf_lo(w.x), bf_hi(w.x), bf_lo(w.y), bf_hi(w.y)}; }
        const f32x4 gv = gp[64 * j]; y[j] = xv + y[j] * rstd * gv;
        if (DST_F32) ((f32x4*)xout + lane)[64 * j] = y[j];
        else { u32x2 w; w.x = cvt_pk_bf16(y[j].x, y[j].y); w.y = cvt_pk_bf16(y[j].z, y[j].w); ((u32x2*)xout + lane)[64 * j] = w; y[j] = (f32x4){bf_lo(w.x), bf_hi(w.x), bf_lo(w.y), bf_hi(w.y)}; }
        s2 += (y[j].x * y[j].x + y[j].y * y[j].y) + (y[j].z * y[j].z + y[j].w * y[j].w); }
    if (HAS_XN) {
        const float rstd2 = 1.0f / sqrtf(wave_sum(s2) * (1.f / DM) + EPS);
        const f32x4* gr = (const f32x4*)gpre + lane; u32x2* o8 = (u32x2*)xn + lane;
#pragma unroll
        for (int j = 0; j < 16; ++j) { const f32x4 gv = gr[64 * j]; u32x2 w; w.x = cvt_pk_bf16(y[j].x * rstd2 * gv.x, y[j].y * rstd2 * gv.y); w.y = cvt_pk_bf16(y[j].z * rstd2 * gv.z, y[j].w * rstd2 * gv.w); o8[64 * j] = w; }
    }
}
__device__ __forceinline__ void unpack8(const u32x4 w, float (&f)[8]) { f[0] = bf_lo(w.x); f[1] = bf_hi(w.x); f[2] = bf_lo(w.y); f[3] = bf_hi(w.y); f[4] = bf_lo(w.z); f[5] = bf_hi(w.z); f[6] = bf_lo(w.w); f[7] = bf_hi(w.w); }
__device__ __forceinline__ u32x4 pack8f(const float (&f)[8]) { u32x4 w; w.x = cvt_pk_bf16(f[0], f[1]); w.y = cvt_pk_bf16(f[2], f[3]); w.z = cvt_pk_bf16(f[4], f[5]); w.w = cvt_pk_bf16(f[6], f[7]); return w; }

__device__ __forceinline__ void conv_gate_phase(const bf16_t* H, const float* cw  , bf16_t* A2  , int gtid, int nthreads) {
    constexpr int RB = 32, NCG = CW / 8, NIT = (SEQ / RB) * NCG;
    asm volatile("" : "+v"(gtid));
    for (int it = gtid; it < NIT; it += nthreads) {
        const int cg = it % NCG, rb = it / NCG, c0 = cg * 8, t0 = rb * RB;
        float w0[8], w1[8], w2[8], m2[8], m1[8];
#pragma unroll
        for (int i = 0; i < 8; ++i) { w0[i] = cw[c0 + i]; w1[i] = cw[CW + c0 + i]; w2[i] = cw[2 * CW + c0 + i]; m2[i] = 0.f; m1[i] = 0.f; }
        if (t0 >= 2) {
            float a[8], b[8];
            unpack8(*(const u32x4*)(H + (size_t)(t0 - 2) * N_CI + CW + c0), a); unpack8(*(const u32x4*)(H + (size_t)(t0 - 2) * N_CI + 2 * CW + c0), b);
#pragma unroll
            for (int i = 0; i < 8; ++i) m2[i] = a[i] * b[i];
            unpack8(*(const u32x4*)(H + (size_t)(t0 - 1) * N_CI + CW + c0), a); unpack8(*(const u32x4*)(H + (size_t)(t0 - 1) * N_CI + 2 * CW + c0), b);
#pragma unroll
            for (int i = 0; i < 8; ++i) m1[i] = a[i] * b[i];
        }
#pragma unroll 4
        for (int r = 0; r < RB; ++r) {
            const bf16_t* hr = H + (size_t)(t0 + r) * N_CI + c0;
            float bg[8], cgt[8], uu[8], o[8];
            unpack8(*(const u32x4*)(hr), bg); unpack8(*(const u32x4*)(hr + CW), cgt); unpack8(*(const u32x4*)(hr + 2 * CW), uu);
#pragma unroll
            for (int i = 0; i < 8; ++i) { const float cu = cgt[i] * uu[i]; o[i] = bg[i] * (w0[i] * m2[i] + w1[i] * m1[i] + w2[i] * cu); m2[i] = m1[i]; m1[i] = cu; }
            *(u32x4*)(A2 + (size_t)(t0 + r) * K_CO + c0) = pack8f(o);
        }
    }
}
__device__ __forceinline__ void ffn_fix_phase(const float* HALOG, const float* FIRSTG, const float* FIRSTU, const float* cw, bf16_t* ACT, int gtid, int nthreads) {
    constexpr int NC4 = DFF / 4, NIT = 31 * NC4;
    asm volatile("" : "+v"(gtid));
    for (int it = gtid; it < NIT; it += nthreads) {
        const int pm = 1 + it / NC4, c = (it % NC4) * 4;
        const f32x4 gm2 = *(const f32x4*)(HALOG + (size_t)((pm - 1) * 2 + 0) * DFF + c), gm1 = *(const f32x4*)(HALOG + (size_t)((pm - 1) * 2 + 1) * DFF + c);
        const f32x4 g0 = *(const f32x4*)(FIRSTG + (size_t)(pm * 2 + 0) * DFF + c), g1 = *(const f32x4*)(FIRSTG + (size_t)(pm * 2 + 1) * DFF + c);
        const f32x4 u0 = *(const f32x4*)(FIRSTU + (size_t)(pm * 2 + 0) * DFF + c), u1 = *(const f32x4*)(FIRSTU + (size_t)(pm * 2 + 1) * DFF + c);
        const f32x4 w0 = *(const f32x4*)(cw + c), w1 = *(const f32x4*)(cw + DFF + c), w2 = *(const f32x4*)(cw + 2 * DFF + c);
        float o0[4], o1[4];
#pragma unroll
        for (int i = 0; i < 4; ++i) { const float a = w0[i] * gm2[i] + w1[i] * gm1[i] + w2[i] * g0[i], b = w0[i] * gm1[i] + w1[i] * g0[i] + w2[i] * g1[i];
            o0[i] = a / (1.0f + __expf(-a)) * u0[i]; o1[i] = b / (1.0f + __expf(-b)) * u1[i]; }
        u32x2 w; w.x = cvt_pk_bf16(o0[0], o0[1]); w.y = cvt_pk_bf16(o0[2], o0[3]); *(u32x2*)(ACT + (size_t)(256 * pm) * DFF + c) = w;
        w.x = cvt_pk_bf16(o1[0], o1[1]); w.y = cvt_pk_bf16(o1[2], o1[3]); *(u32x2*)(ACT + (size_t)(256 * pm + 1) * DFF + c) = w;
    }
}
__device__ __forceinline__ void merge_phase(const bf16_t* OG  , const float* LSE  , bf16_t* A2  , int gtid, int nthreads) {
    constexpr int NIT = SEQ * (GW / 8);
    asm volatile("" : "+v"(gtid));
    for (int it = gtid; it < NIT; it += nthreads) {
        const int ch = it % (GW / 8), t = it / (GW / 8), hd = ch >> 4, d8 = (ch & 15) * 8;
        const int r0 = t, r1 = (t & 3) * (SEQ / 4) + (t >> 2), r2 = (t & 15) * (SEQ / 16) + (t >> 4);
        const float l0 = LSE[(size_t)(0 * 16 + hd) * SEQ + r0], l1 = LSE[(size_t)(1 * 16 + hd) * SEQ + r1], l2 = LSE[(size_t)(2 * 16 + hd) * SEQ + r2];
        const float mx = fmaxf(l0, fmaxf(l1, l2));
        const float e0 = __expf(l0 - mx), e1 = __expf(l1 - mx), e2 = __expf(l2 - mx), inv = 1.0f / (e0 + e1 + e2);
        float a[8], b[8], c[8], o[8];
        unpack8(*(const u32x4*)(OG + ((size_t)(0 * 16 + hd) * SEQ + r0) * HDIM + d8), a); unpack8(*(const u32x4*)(OG + ((size_t)(1 * 16 + hd) * SEQ + r1) * HDIM + d8), b); unpack8(*(const u32x4*)(OG + ((size_t)(2 * 16 + hd) * SEQ + r2) * HDIM + d8), c);
#pragma unroll
        for (int i = 0; i < 8; ++i) o[i] = (e0 * a[i] + e1 * b[i] + e2 * c[i]) * inv;
        *(u32x4*)(A2 + (size_t)t * K_AO + ch * 8) = pack8f(o);
    }
}

template <int HD, int STR>
__device__ __forceinline__ void attn_load_tile(LAS unsigned char* dst, const bf16_t* src, long stride, int valid_from, int tid) {
    constexpr int CPR = HD / 8, PER = 256 * CPR / 512;
    u32x4 v[PER];
#pragma unroll
    for (int j = 0; j < PER; ++j) { const int idx = tid + 512 * j, row = idx / CPR, ch = idx % CPR;
        v[j] = (u32x4){0u, 0u, 0u, 0u}; if (row >= valid_from) v[j] = *(const u32x4*)(src + (long)row * stride + ch * 8); }
#pragma unroll
    for (int j = 0; j < PER; ++j) { const int idx = tid + 512 * j, row = idx / CPR, ch = idx % CPR; *(LAS u32x4*)(dst + row * STR + ch * 16) = v[j]; }
}
template <int HD, int NT, bool DIL>
__device__ __forceinline__ void attn_unit(LAS unsigned char* lds, const bf16_t* Qp, long qstride, const bf16_t* Kp, const bf16_t* Vp, long kvstride, int valid_from,
                                          bf16_t* Op, long ostride, float* lsep, float scale) {
    constexpr int KSTR = HD * 2 + 16, VSTR = HD * 2 + 32, NC = (NT + 1) / 2, NDT = HD / 16, NQC = HD / 32;
    constexpr bool BOTH = (256 * KSTR + 256 * VSTR) <= LDSCTL_OFF;
    const int tid = fresh_tid(), w = __builtin_amdgcn_readfirstlane(tid >> 6), lane = tid & 63, lq = lane & 15, g4 = lane >> 4;
    LAS unsigned char* Kl = lds; LAS unsigned char* Vl = BOTH ? lds + 256 * KSTR : lds;
    __syncthreads();
    attn_load_tile<HD, KSTR>(Kl, Kp, kvstride, valid_from, tid);
    if (BOTH) attn_load_tile<HD, VSTR>(Vl, Vp, kvstride, valid_from, tid);
    bf16x8 qf[NQC];
#pragma unroll
    for (int c = 0; c < NQC; ++c) qf[c] = *(const bf16x8*)(Qp + (long)(16 * w + lq) * qstride + 32 * c + 8 * g4);
    __syncthreads();
    const int jt0 = DIL ? w : 0;
    f32x4 s[NT];
#pragma unroll
    for (int j = 0; j < NT; ++j) { s[j] = (f32x4){0.f, 0.f, 0.f, 0.f}; const LAS unsigned char* kr = Kl + (16 * (jt0 + j) + lq) * KSTR + 16 * g4;
#pragma unroll
        for (int c = 0; c < NQC; ++c) { const bf16x8 kf = *(const LAS bf16x8*)(kr + 64 * c); s[j] = __builtin_amdgcn_mfma_f32_16x16x32_bf16(kf, qf[c], s[j], 0, 0, 0); } }
    if (!BOTH) { __syncthreads(); attn_load_tile<HD, VSTR>(Vl, Vp, kvstride, valid_from, tid); }
    const float NEG = -__builtin_inff();
    float mx = NEG;
    const int qi = 16 * w + lq;
#pragma unroll
    for (int j = 0; j < NT; ++j)
#pragma unroll
        for (int e = 0; e < 4; ++e) { if (DIL) { const int kr = 16 * (jt0 + j) + 4 * g4 + e; const bool ok = (kr >= qi) && (kr <= qi + 128) && (kr >= valid_from); s[j][e] = ok ? s[j][e] : NEG; } mx = fmaxf(mx, s[j][e]); }
    mx = fmaxf(mx, __shfl_xor(mx, 16)); mx = fmaxf(mx, __shfl_xor(mx, 32));
    const float c2 = scale * 1.4426950408889634f, mb = -mx * c2; float sum = 0.f;
#pragma unroll
    for (int j = 0; j < NT; ++j)
#pragma unroll
        for (int e = 0; e < 4; ++e) { const float p = __builtin_amdgcn_exp2f(fmaf(s[j][e], c2, mb)); s[j][e] = p; sum += p; }
    sum += __shfl_xor(sum, 16); sum += __shfl_xor(sum, 32);
    const float inv = 1.0f / sum;
    bf16x8 pf[NC];
#pragma unroll
    for (int cc = 0; cc < NC; ++cc) { u32x4 wv; wv.x = cvt_pk_bf16(s[2 * cc][0], s[2 * cc][1]); wv.y = cvt_pk_bf16(s[2 * cc][2], s[2 * cc][3]);
        if (2 * cc + 1 < NT) { wv.z = cvt_pk_bf16(s[(2 * cc + 1) % NT][0], s[(2 * cc + 1) % NT][1]); wv.w = cvt_pk_bf16(s[(2 * cc + 1) % NT][2], s[(2 * cc + 1) % NT][3]); } else { wv.z = 0u; wv.w = 0u; }
        pf[cc] = __builtin_bit_cast(bf16x8, wv); }
    if (!BOTH) __syncthreads();
    f32x4 o[NDT];
#pragma unroll
    for (int dt = 0; dt < NDT; ++dt) o[dt] = (f32x4){0.f, 0.f, 0.f, 0.f};
    const unsigned vbase = (unsigned)(size_t)Vl + (unsigned)((16 * jt0 + 4 * g4 + (lq >> 2)) * VSTR + (lq & 3) * 8);
#pragma unroll
    for (int cc = 0; cc < NC; ++cc) {
        const unsigned va = vbase + (unsigned)(cc * 32 * VSTR);
        constexpr int T1OFF = 16 * VSTR;
        const bool has1 = (2 * cc + 1 < NT);
#pragma unroll
        for (int d4 = 0; d4 < NDT; d4 += 4) {
            s16x4 a0, a1, a2, a3, b0, b1, b2, b3;
#define TRRD(dst, addr, off) asm volatile("ds_read_b64_tr_b16 %0, %1 offset:%2" : "=&v"(dst) : "v"(addr), "i"(off) : "memory")
            if (has1) {
                TRRD(a0, va, (d4 + 0) * 32); TRRD(b0, va, (d4 + 0) * 32 + T1OFF); TRRD(a1, va, (d4 + 1) * 32); TRRD(b1, va, (d4 + 1) * 32 + T1OFF);
                TRRD(a2, va, (d4 + 2) * 32); TRRD(b2, va, (d4 + 2) * 32 + T1OFF); TRRD(a3, va, (d4 + 3) * 32); TRRD(b3, va, (d4 + 3) * 32 + T1OFF);
            } else {
                TRRD(a0, va, (d4 + 0) * 32); TRRD(b0, va, (d4 + 0) * 32); TRRD(a1, va, (d4 + 1) * 32); TRRD(b1, va, (d4 + 1) * 32);
                TRRD(a2, va, (d4 + 2) * 32); TRRD(b2, va, (d4 + 2) * 32); TRRD(a3, va, (d4 + 3) * 32); TRRD(b3, va, (d4 + 3) * 32);
            }
#undef TRRD
            asm volatile("s_waitcnt lgkmcnt(0)" ::: "memory"); __builtin_amdgcn_sched_barrier(0);
            o[d4 + 0] = __builtin_amdgcn_mfma_f32_16x16x32_bf16((bf16x8){a0[0], a0[1], a0[2], a0[3], b0[0], b0[1], b0[2], b0[3]}, pf[cc], o[d4 + 0], 0, 0, 0);
            o[d4 + 1] = __builtin_amdgcn_mfma_f32_16x16x32_bf16((bf16x8){a1[0], a1[1], a1[2], a1[3], b1[0], b1[1], b1[2], b1[3]}, pf[cc], o[d4 + 1], 0, 0, 0);
            o[d4 + 2] = __builtin_amdgcn_mfma_f32_16x16x32_bf16((bf16x8){a2[0], a2[1], a2[2], a2[3], b2[0], b2[1], b2[2], b2[3]}, pf[cc], o[d4 + 2], 0, 0, 0);
            o[d4 + 3] = __builtin_amdgcn_mfma_f32_16x16x32_bf16((bf16x8){a3[0], a3[1], a3[2], a3[3], b3[0], b3[1], b3[2], b3[3]}, pf[cc], o[d4 + 3], 0, 0, 0);
        }
    }
    bf16_t* orow = Op + (long)qi * ostride + 4 * g4;
#pragma unroll
    for (int dt = 0; dt < NDT; ++dt) { u32x2 wv; wv.x = cvt_pk_bf16(o[dt][0] * inv, o[dt][1] * inv); wv.y = cvt_pk_bf16(o[dt][2] * inv, o[dt][3] * inv); *(u32x2*)(orow + 16 * dt) = wv; }
    if (lsep && g4 == 0) lsep[qi] = mx * scale + __logf(sum);
}


__device__ __forceinline__ void attn_dil_unit(LAS unsigned char* lds, const bf16_t* Qs, const bf16_t* Ks, const bf16_t* Vs, int valid_from, bf16_t* Os, float* lsep, float scale) {
    constexpr int NT = 9, NC = 5, NDT = 8;
    const int tid = fresh_tid(), w = __builtin_amdgcn_readfirstlane(tid >> 6), lane = tid & 63, lq = lane & 15, g4 = lane >> 4;
    LAS unsigned char* Kl = lds; LAS unsigned char* Vl = lds + 65536;
    __syncthreads();
#pragma unroll
    for (int i = 0; i < 8; ++i) { const int row = 32 * w + 4 * i + g4;
        __builtin_amdgcn_global_load_lds((const unsigned*)(Ks + (size_t)row * HDIM + ((lq ^ (row & 15)) << 3)), (LAS unsigned*)(Kl + (w * 8 + i) * 1024), 16, 0, 0);
        __builtin_amdgcn_global_load_lds((const unsigned*)(Vs + (size_t)row * HDIM + ((lq ^ ((row & 7) << 1)) << 3)), (LAS unsigned*)(Vl + (w * 8 + i) * 1024), 16, 0, 0); }
    bf16x8 qf[4];
#pragma unroll
    for (int c = 0; c < 4; ++c) qf[c] = *(const bf16x8*)(Qs + (size_t)(16 * w + lq) * HDIM + 32 * c + 8 * g4);
    asm volatile("s_waitcnt vmcnt(0)" ::: "memory");
    __syncthreads();
    f32x4 s[NT];
    { unsigned ko[4];
#pragma unroll
      for (int c = 0; c < 4; ++c) ko[c] = (unsigned)(((4 * c + g4) ^ lq) << 4);
      const LAS unsigned char* kb = Kl + (16 * w + lq) * 256;
#pragma unroll
      for (int j = 0; j < NT; ++j) { s[j] = (f32x4){0.f, 0.f, 0.f, 0.f};
#pragma unroll
        for (int c = 0; c < 4; ++c) { const bf16x8 kf = *(const LAS bf16x8*)(kb + j * 4096 + ko[c]); s[j] = __builtin_amdgcn_mfma_f32_16x16x32_bf16(kf, qf[c], s[j], 0, 0, 0); } } }
    const float NEG = -__builtin_inff();
    float mx = NEG;
    const int qi = 16 * w + lq;
#pragma unroll
    for (int j = 0; j < NT; ++j)
#pragma unroll
        for (int e = 0; e < 4; ++e) { const int kr = 16 * (w + j) + 4 * g4 + e; const bool ok = (kr >= qi) && (kr <= qi + 128) && (kr >= valid_from); s[j][e] = ok ? s[j][e] : NEG; mx = fmaxf(mx, s[j][e]); }
    mx = fmaxf(mx, __shfl_xor(mx, 16)); mx = fmaxf(mx, __shfl_xor(mx, 32));
    const float c2 = scale * 1.4426950408889634f, mb = -mx * c2; float sum = 0.f;
#pragma unroll
    for (int j = 0; j < NT; ++j)
#pragma unroll
        for (int e = 0; e < 4; ++e) { const float p = __builtin_amdgcn_exp2f(fmaf(s[j][e], c2, mb)); s[j][e] = p; sum += p; }
    sum += __shfl_xor(sum, 16); sum += __shfl_xor(sum, 32);
    const float inv = 1.0f / sum;
    bf16x8 pf[NC];
#pragma unroll
    for (int cc = 0; cc < NC; ++cc) { u32x4 wv; wv.x = cvt_pk_bf16(s[2 * cc][0], s[2 * cc][1]); wv.y = cvt_pk_bf16(s[2 * cc][2], s[2 * cc][3]);
        if (2 * cc + 1 < NT) { wv.z = cvt_pk_bf16(s[(2 * cc + 1) % NT][0], s[(2 * cc + 1) % NT][1]); wv.w = cvt_pk_bf16(s[(2 * cc + 1) % NT][2], s[(2 * cc + 1) % NT][3]); } else { wv.z = 0u; wv.w = 0u; }
        pf[cc] = __builtin_bit_cast(bf16x8, wv); }
    f32x4 o[NDT];
#pragma unroll
    for (int dt = 0; dt < NDT; ++dt) o[dt] = (f32x4){0.f, 0.f, 0.f, 0.f};
    const int q4 = lq >> 2, p4 = lq & 3, kx = ((4 * g4 + q4) & 7) << 5;
    const unsigned vb = (unsigned)(size_t)Vl + (unsigned)((16 * w + 4 * g4 + q4) * 256 + ((p4 >> 1) << 4) + ((p4 & 1) << 3));
    unsigned va[NDT];
#pragma unroll
    for (int dt = 0; dt < NDT; ++dt) va[dt] = vb + (unsigned)((dt << 5) ^ kx);
#define TRRD(dst, addr, off) asm volatile("ds_read_b64_tr_b16 %0, %1 offset:%2" : "=&v"(dst) : "v"(addr), "i"(off) : "memory")
#pragma unroll
    for (int cc = 0; cc < NC; ++cc) {
        const int o0 = cc * 32 * 256, o1 = (2 * cc + 1 < NT) ? o0 + 16 * 256 : o0;
#pragma unroll
        for (int d4 = 0; d4 < NDT; d4 += 4) {
            s16x4 a0, a1, a2, a3, b0, b1, b2, b3;
            if (cc == 0) { TRRD(a0, va[d4 + 0], 0 * 8192); TRRD(b0, va[d4 + 0], 0 * 8192 + 4096); TRRD(a1, va[d4 + 1], 0 * 8192); TRRD(b1, va[d4 + 1], 0 * 8192 + 4096); TRRD(a2, va[d4 + 2], 0 * 8192); TRRD(b2, va[d4 + 2], 0 * 8192 + 4096); TRRD(a3, va[d4 + 3], 0 * 8192); TRRD(b3, va[d4 + 3], 0 * 8192 + 4096); }
            if (cc == 1) { TRRD(a0, va[d4 + 0], 1 * 8192); TRRD(b0, va[d4 + 0], 1 * 8192 + 4096); TRRD(a1, va[d4 + 1], 1 * 8192); TRRD(b1, va[d4 + 1], 1 * 8192 + 4096); TRRD(a2, va[d4 + 2], 1 * 8192); TRRD(b2, va[d4 + 2], 1 * 8192 + 4096); TRRD(a3, va[d4 + 3], 1 * 8192); TRRD(b3, va[d4 + 3], 1 * 8192 + 4096); }
            if (cc == 2) { TRRD(a0, va[d4 + 0], 2 * 8192); TRRD(b0, va[d4 + 0], 2 * 8192 + 4096); TRRD(a1, va[d4 + 1], 2 * 8192); TRRD(b1, va[d4 + 1], 2 * 8192 + 4096); TRRD(a2, va[d4 + 2], 2 * 8192); TRRD(b2, va[d4 + 2], 2 * 8192 + 4096); TRRD(a3, va[d4 + 3], 2 * 8192); TRRD(b3, va[d4 + 3], 2 * 8192 + 4096); }
            if (cc == 3) { TRRD(a0, va[d4 + 0], 3 * 8192); TRRD(b0, va[d4 + 0], 3 * 8192 + 4096); TRRD(a1, va[d4 + 1], 3 * 8192); TRRD(b1, va[d4 + 1], 3 * 8192 + 4096); TRRD(a2, va[d4 + 2], 3 * 8192); TRRD(b2, va[d4 + 2], 3 * 8192 + 4096); TRRD(a3, va[d4 + 3], 3 * 8192); TRRD(b3, va[d4 + 3], 3 * 8192 + 4096); }
            if (cc == 4) { TRRD(a0, va[d4 + 0], 4 * 8192); TRRD(b0, va[d4 + 0], 4 * 8192); TRRD(a1, va[d4 + 1], 4 * 8192); TRRD(b1, va[d4 + 1], 4 * 8192); TRRD(a2, va[d4 + 2], 4 * 8192); TRRD(b2, va[d4 + 2], 4 * 8192); TRRD(a3, va[d4 + 3], 4 * 8192); TRRD(b3, va[d4 + 3], 4 * 8192); }
            (void)o0; (void)o1;
            asm volatile("s_waitcnt lgkmcnt(0)" ::: "memory"); __builtin_amdgcn_sched_barrier(0);
            o[d4 + 0] = __builtin_amdgcn_mfma_f32_16x16x32_bf16((bf16x8){a0[0], a0[1], a0[2], a0[3], b0[0], b0[1], b0[2], b0[3]}, pf[cc], o[d4 + 0], 0, 0, 0);
            o[d4 + 1] = __builtin_amdgcn_mfma_f32_16x16x32_bf16((bf16x8){a1[0], a1[1], a1[2], a1[3], b1[0], b1[1], b1[2], b1[3]}, pf[cc], o[d4 + 1], 0, 0, 0);
            o[d4 + 2] = __builtin_amdgcn_mfma_f32_16x16x32_bf16((bf16x8){a2[0], a2[1], a2[2], a2[3], b2[0], b2[1], b2[2], b2[3]}, pf[cc], o[d4 + 2], 0, 0, 0);
            o[d4 + 3] = __builtin_amdgcn_mfma_f32_16x16x32_bf16((bf16x8){a3[0], a3[1], a3[2], a3[3], b3[0], b3[1], b3[2], b3[3]}, pf[cc], o[d4 + 3], 0, 0, 0);
        }
    }
#undef TRRD
    bf16_t* orow = Os + (size_t)qi * HDIM + 4 * g4;
#pragma unroll
    for (int dt = 0; dt < NDT; ++dt) { u32x2 wv; wv.x = cvt_pk_bf16(o[dt][0] * inv, o[dt][1] * inv); wv.y = cvt_pk_bf16(o[dt][2] * inv, o[dt][3] * inv); *(u32x2*)(orow + 16 * dt) = wv; }
    if (g4 == 0) lsep[qi] = mx * scale + __logf(sum);
}

struct Args {
    const float* x; const float* mem; const int* pos; const float* g_mem; const float* w_mem_kv; const float* g_mix_pre; const float* g_mix_post; const float* g_ffn_pre; const float* g_ffn_post;
    const float* w_conv_in; const float* conv_mix_w; const float* w_conv_out; const float* w_attn_in; const float* w_attn_out; const float* w_ffn_gate; const float* w_ffn_up; const float* conv_ffn_w; const float* w_ffn_down;
    float* out; unsigned char* ws; int ph_lo, ph_hi;
};

__global__ void __launch_bounds__(512, 2) fwd_kernel(Args a) {
    extern __shared__ __attribute__((aligned(16))) unsigned char lds_raw[];
    LAS unsigned char* lds = (LAS unsigned char*)lds_raw;
    volatile LAS unsigned* MISC = (volatile LAS unsigned*)(lds + LDSCTL_OFF);
    const int tid = threadIdx.x, lane = tid & 63, wave = __builtin_amdgcn_readfirstlane(tid >> 6);
    const int G = gridDim.x, bx = blockIdx.x;
    const int gtid = bx * 512 + tid, nthreads = G * 512, gw = bx * 8 + wave, ngw = G * 8;
    unsigned char* ws = a.ws;
    unsigned* ctl = (unsigned*)(ws + WS_CTL);
    bf16_t* WKV = (bf16_t*)(ws + WS_WKV); bf16_t* WCI = (bf16_t*)(ws + WS_WCI); bf16_t* WCO = (bf16_t*)(ws + WS_WCO); bf16_t* WAI = (bf16_t*)(ws + WS_WAI); bf16_t* WAO = (bf16_t*)(ws + WS_WAO);
    bf16_t* WGU = (bf16_t*)(ws + WS_WGU); bf16_t* WD = (bf16_t*)(ws + WS_WD);
    bf16_t* XN = (bf16_t*)(ws + WS_XN); bf16_t* H = (bf16_t*)(ws + WS_R); bf16_t* GU = (bf16_t*)(ws + WS_R); bf16_t* Y = (bf16_t*)(ws + WS_R);
    bf16_t* QKVL = (bf16_t*)(ws + WS_R); bf16_t* QM = (bf16_t*)(ws + WS_R + 288 * MiB);
    bf16_t* ACT = (bf16_t*)(ws + WS_S); bf16_t* A2 = (bf16_t*)(ws + WS_S); bf16_t* OG = (bf16_t*)(ws + WS_S + 64 * MiB);
    bf16_t* MEMN = (bf16_t*)(ws + WS_MEMN); bf16_t* KV = (bf16_t*)(ws + WS_KV); float* COS = (float*)(ws + WS_COS); float* SIN = (float*)(ws + WS_SIN); float* LSE = (float*)(ws + WS_LSE);
    bf16_t* XRES = (bf16_t*)(ws + WS_XRES);
    float* HALOG = (float*)(ws + WS_HALOG); float* FIRSTG = (float*)(ws + WS_FIRSTG); float* FIRSTU = (float*)(ws + WS_FIRSTU);

    for (int u = tid; u < (LDS_BYTES - LDSCTL_OFF) / 4; u += 512) ((LAS unsigned*)(lds + LDSCTL_OFF))[u] = 0u;
    __syncthreads();
    XcdBarrier bar; bar.bar = ctl + CW_BAR; bar.x = 0; bar.st = nullptr;
    if (ONE_LAUNCH) bar = xcd_barrier_post(ctl + CW_BAR, MISC + 8);
    const int lo = a.ph_lo, hi = a.ph_hi;
#define IN(k) (lo <= (k) && (k) < hi)
#define SEAM(k) do { if (IN(k) && IN((k) + 1)) xcd_barrier(bar); } while (0)
    constexpr size_t SZ_GU = (size_t)N_GU * DM, SZ_D = (size_t)DM * DFF;

    if (IN(0)) {
        LAS float* scr = (LAS float*)(lds + wave * 16384);
        cvt_matrix<0>(a.w_mem_kv, DM, 2 * MW, WKV, 0, scr, gw, ngw, lane);
        for (int m = gw; m < NMEM; m += ngw) rms_row_to_bf16(a.mem + (size_t)m * DM, a.g_mem, MEMN + (size_t)m * DM, lane);
        for (int m = gw; m < SEQ; m += ngw) rms_row_to_bf16(a.x + (size_t)m * DM, a.g_mix_pre, XN + (size_t)m * DM, lane);
        for (int idx = gtid; idx < SEQ * 64; idx += nthreads) { const int t = idx >> 6, i = idx & 63;
            const float ang = (float)a.pos[t] * INV_FREQ[i];
            const double kq = rint((double)ang * 0.15915494309189535); double r = fma(-kq, 6.283185307179586, (double)ang); r = fma(-kq, 2.4492935982947064e-16, r);
            const float rf = (float)r; COS[idx] = cosf(rf); SIN[idx] = sinf(rf); }
    }
    SEAM(0);
    if (IN(1)) {
        if (bx < 8) {
            pg8::Gemm g{MEMN, WKV, DM, DM, DM}; pg8::StaticOrder S; S.init(NMEM, 2 * MW, 8, bx);
            pg8::EpiStore E{KV, 2 * MW};
            pg8::gemm_phase<pg8::EpiStore, pg8::StaticOrder, true>(lds, g, S, E);
        } else {
            LAS float* scr = (LAS float*)(lds + wave * 16384);
            const int cw_ = (bx - 8) * 8 + wave, ncw = (G - 8) * 8;
            cvt_matrix<0>(a.w_conv_in, DM, N_CI, WCI, 0, scr, cw_, ncw, lane);
            cvt_matrix<0>(a.w_conv_out, K_CO, DM, WCO, 0, scr, cw_, ncw, lane);
            cvt_matrix<2>(a.w_ffn_gate, DM, DFF, WGU, 0, scr, cw_, ncw, lane);
            cvt_matrix<3>(a.w_ffn_up, DM, DFF, WGU, 0, scr, cw_, ncw, lane);
            cvt_matrix<0>(a.w_ffn_down, DFF, DM, WD, 0, scr, cw_, ncw, lane);
            cvt_matrix<1>(a.w_attn_in, DM, N_AI, WAI, 0, scr, cw_, ncw, lane);
            cvt_matrix<0>(a.w_attn_out, K_AO, DM, WAO, 0, scr, cw_, ncw, lane);
            cvt_matrix<2>(a.w_ffn_gate + SZ_D, DM, DFF, WGU + SZ_GU, 0, scr, cw_, ncw, lane);
            cvt_matrix<3>(a.w_ffn_up + SZ_D, DM, DFF, WGU + SZ_GU, 0, scr, cw_, ncw, lane);
            cvt_matrix<0>(a.w_ffn_down + SZ_D, DFF, DM, WD + SZ_D, 0, scr, cw_, ncw, lane);
        }
    }
    SEAM(1);
    if (IN(2)) {
        pg8::Gemm g{XN, WCI, DM, DM, DM}; pg8::StaticOrder S; S.init(SEQ, N_CI, G, bx);
        pg8::EpiStore E{H, N_CI};
        pg8::gemm_phase<pg8::EpiStore, pg8::StaticOrder, true>(lds, g, S, E);
    }
    SEAM(2);
    if (IN(3)) {
        for (int u = bx; u < 4 * (SEQ / 128); u += G) { const int hd = u / (SEQ / 128), qb = u % (SEQ / 128);
            attn_unit<256, 16, false>(lds, H + (size_t)(128 * qb) * N_CI + 3 * CW + 256 * hd, N_CI, KV + 256 * hd, KV + MW + 256 * hd, 2 * MW, 0,
                                      A2 + (size_t)(128 * qb) * K_CO + CW + 256 * hd, K_CO, nullptr, 0.0625f); }
        conv_gate_phase(H, a.conv_mix_w, A2, gtid, nthreads);
    }
    SEAM(3);
    if (IN(4)) {
        pg8::Gemm g{A2, WCO, K_CO, K_CO, K_CO}; pg8::StaticOrder S; S.init(SEQ, DM, G, bx);
        pg8::EpiStore E{Y, DM};
        pg8::gemm_phase<pg8::EpiStore, pg8::StaticOrder, true>(lds, g, S, E);
    }
    SEAM(4);
    if (IN(5)) { for (int m = gw; m < SEQ; m += ngw) norm_res_row<true, false, true>(a.x + (size_t)m * DM, Y + (size_t)m * DM, a.g_mix_post, a.g_ffn_pre, XRES + (size_t)m * DM, XN + (size_t)m * DM); }
    SEAM(5);
    if (IN(6)) {
        pg8::Gemm g{XN, WGU, DM, DM, DM}; pg8::StaticOrder S; S.init(SEQ, N_GU, G, bx);
        pg8::EpiFfn E{ACT, a.conv_ffn_w, HALOG, FIRSTG, FIRSTU, lds + RING_BYTES};
        pg8::gemm_phase<pg8::EpiFfn, pg8::StaticOrder, true>(lds, g, S, E);
    }
    SEAM(6);
    if (IN(7)) ffn_fix_phase(HALOG, FIRSTG, FIRSTU, a.conv_ffn_w, ACT, gtid, nthreads);
    SEAM(7);
    if (IN(8)) {
        pg8::Gemm g{ACT, WD, DFF, DFF, DFF}; pg8::StaticOrder S; S.init(SEQ, DM, G, bx);
        pg8::EpiStore E{Y, DM};
        pg8::gemm_phase<pg8::EpiStore, pg8::StaticOrder, true>(lds, g, S, E);
    }
    SEAM(8);
    if (IN(9)) { for (int m = gw; m < SEQ; m += ngw) norm_res_row<false, false, true>(XRES + (size_t)m * DM, Y + (size_t)m * DM, a.g_ffn_post, a.g_mix_pre + DM, XRES + (size_t)m * DM, XN + (size_t)m * DM); }
    SEAM(9);
    if (IN(10)) {
        pg8::Gemm g{XN, WAI, DM, DM, DM}; pg8::StaticOrder S; S.init(SEQ, N_AI, G, bx);
        pg8::EpiQKV E{QKVL, QM, COS, SIN};
        pg8::gemm_phase<pg8::EpiQKV, pg8::StaticOrder, true>(lds, g, S, E);
    }
    SEAM(10);
    if (IN(11)) {
        const int per = (3 * 16 * 64 + G - 1) / G;
        for (int k = 0; k < per; ++k) {
            const int u = bx * per + k; if (u >= 3 * 16 * 64) break;
            const int grp = u >> 10, rem = u & 1023, hd = rem >> 6, blk = rem & 63;
            const int dsh = 2 * grp, nbr = 64 >> dsh, r = blk / nbr, nb = blk % nbr;
            const size_t rowq = (size_t)r * (SEQ >> dsh) + 128 * nb;
            const bf16_t* qs = QKVL + ((size_t)((grp * 3 + 0) * NHEAD + hd) * SEQ + rowq) * HDIM;
            const bf16_t* ks = QKVL + ((size_t)((grp * 3 + 1) * NHEAD + hd) * SEQ + rowq) * HDIM - 128 * HDIM;
            const bf16_t* vs = QKVL + ((size_t)((grp * 3 + 2) * NHEAD + hd) * SEQ + rowq) * HDIM - 128 * HDIM;
            attn_dil_unit(lds, qs, ks, vs, nb == 0 ? 128 : 0, OG + ((size_t)(grp * NHEAD + hd) * SEQ + rowq) * HDIM, LSE + (size_t)(grp * NHEAD + hd) * SEQ + rowq, 0.08838834764831845f);
        }
        for (int u = bx; u < 4 * (SEQ / 128); u += G) { const int hd = u / (SEQ / 128), qb = u % (SEQ / 128);
            attn_unit<256, 16, false>(lds, QM + (size_t)(128 * qb) * MW + 256 * hd, MW, KV + 256 * hd, KV + MW + 256 * hd, 2 * MW, 0,
                                      A2 + (size_t)(128 * qb) * K_AO + GW + 256 * hd, K_AO, nullptr, 0.0625f); }
    }
    SEAM(11);
    if (IN(12)) merge_phase(OG, LSE, A2, gtid, nthreads);
    SEAM(12);
    if (IN(13)) {
        pg8::Gemm g{A2, WAO, K_AO, K_AO, K_AO}; pg8::StaticOrder S; S.init(SEQ, DM, G, bx);
        pg8::EpiStore E{Y, DM};
        pg8::gemm_phase<pg8::EpiStore, pg8::StaticOrder, true>(lds, g, S, E);
    }
    SEAM(13);
    if (IN(14)) { for (int m = gw; m < SEQ; m += ngw) norm_res_row<false, false, true>(XRES + (size_t)m * DM, Y + (size_t)m * DM, a.g_mix_post + DM, a.g_ffn_pre + DM, XRES + (size_t)m * DM, XN + (size_t)m * DM); }
    SEAM(14);
    if (IN(15)) {
        pg8::Gemm g{XN, WGU + SZ_GU, DM, DM, DM}; pg8::StaticOrder S; S.init(SEQ, N_GU, G, bx);
        pg8::EpiFfn E{ACT, a.conv_ffn_w + 3 * DFF, HALOG, FIRSTG, FIRSTU, lds + RING_BYTES};
        pg8::gemm_phase<pg8::EpiFfn, pg8::StaticOrder, true>(lds, g, S, E);
    }
    SEAM(15);
    if (IN(16)) ffn_fix_phase(HALOG, FIRSTG, FIRSTU, a.conv_ffn_w + 3 * DFF, ACT, gtid, nthreads);
    SEAM(16);
    if (IN(17)) {
        pg8::Gemm g{ACT, WD + SZ_D, DFF, DFF, DFF}; pg8::StaticOrder S; S.init(SEQ, DM, G, bx);
        pg8::EpiStore E{Y, DM};
        pg8::gemm_phase<pg8::EpiStore, pg8::StaticOrder, true>(lds, g, S, E);
    }
    SEAM(17);
    if (IN(18)) { for (int m = gw; m < SEQ; m += ngw) norm_res_row<false, true, false>(XRES + (size_t)m * DM, Y + (size_t)m * DM, a.g_ffn_post + DM, nullptr, a.out + (size_t)m * DM, nullptr); }

#ifdef PROBE
    xcd_barrier(bar);
#if PROBE == 1
    { LAS float* scr = (LAS float*)(lds + wave * 16384);
      if (bx >= 8) { const int cw_ = (bx - 8) * 8 + wave, ncw = (G - 8) * 8;
            cvt_matrix<0>(a.w_conv_in, DM, N_CI, WCI, 0, scr, cw_, ncw, lane);
            cvt_matrix<0>(a.w_conv_out, K_CO, DM, WCO, 0, scr, cw_, ncw, lane);
            cvt_matrix<2>(a.w_ffn_gate, DM, DFF, WGU, 0, scr, cw_, ncw, lane);
            cvt_matrix<3>(a.w_ffn_up, DM, DFF, WGU, 0, scr, cw_, ncw, lane);
            cvt_matrix<0>(a.w_ffn_down, DFF, DM, WD, 0, scr, cw_, ncw, lane);
            cvt_matrix<1>(a.w_attn_in, DM, N_AI, WAI, 0, scr, cw_, ncw, lane);
            cvt_matrix<0>(a.w_attn_out, K_AO, DM, WAO, 0, scr, cw_, ncw, lane);
            cvt_matrix<2>(a.w_ffn_gate + SZ_D, DM, DFF, WGU + SZ_GU, 0, scr, cw_, ncw, lane);
            cvt_matrix<3>(a.w_ffn_up + SZ_D, DM, DFF, WGU + SZ_GU, 0, scr, cw_, ncw, lane);
            cvt_matrix<0>(a.w_ffn_down + SZ_D, DFF, DM, WD + SZ_D, 0, scr, cw_, ncw, lane); } }
#elif PROBE == 8
    { pg8::Gemm g{ACT, WD, DFF, DFF, DFF}; pg8::StaticOrder S; S.init(SEQ, DM, G, bx);
      pg8::EpiStore E{Y, DM};
      pg8::gemm_phase<pg8::EpiStore, pg8::StaticOrder, true>(lds, g, S, E); }
#elif PROBE == 4
    { pg8::Gemm g{A2, WCO, K_CO, K_CO, K_CO}; pg8::StaticOrder S; S.init(SEQ, DM, G, bx);
      pg8::EpiStore E{Y, DM};
      pg8::gemm_phase<pg8::EpiStore, pg8::StaticOrder, true>(lds, g, S, E); }
#elif PROBE == 40
    { pg8::Gemm g{A2, WCO, K_CO, K_CO, K_CO}; pg8::SameTileOrder S; S.n = 2;
      pg8::EpiStore E{Y, DM};
      pg8::gemm_phase<pg8::EpiStore, pg8::SameTileOrder, true>(lds, g, S, E); }
#elif PROBE == 6
    { pg8::Gemm g{XN, WGU, DM, DM, DM}; pg8::StaticOrder S; S.init(SEQ, N_GU, G, bx);
      pg8::EpiFfn E{ACT, a.conv_ffn_w, HALOG, FIRSTG, FIRSTU, lds + RING_BYTES};
      pg8::gemm_phase<pg8::EpiFfn, pg8::StaticOrder, true>(lds, g, S, E); }
#elif PROBE == 5
    { float* scratch_x = (float*)(ws + WS_S);
      for (int m = gw; m < SEQ; m += ngw) norm_res_row<true, true, true>(a.x + (size_t)m * DM, Y + (size_t)m * DM, a.g_mix_post, a.g_ffn_pre, scratch_x + (size_t)m * DM, XN + (size_t)m * DM); }
#elif PROBE == 3
    { for (int u = bx; u < 4 * (SEQ / 128); u += G) { const int hd = u / (SEQ / 128), qb = u % (SEQ / 128);
            attn_unit<256, 16, false>(lds, H + (size_t)(128 * qb) * N_CI + 3 * CW + 256 * hd, N_CI, KV + 256 * hd, KV + MW + 256 * hd, 2 * MW, 0,
                                      A2 + (size_t)(128 * qb) * K_CO + CW + 256 * hd, K_CO, nullptr, 0.0625f); }
        conv_gate_phase(H, a.conv_mix_w, A2, gtid, nthreads); }
#endif
#endif
#undef IN
#undef SEAM
}

extern "C" void kernel_launch(void* const* d_in, const int* in_sizes, int n_in, void* d_out, int out_size, void* d_ws, size_t ws_size, hipStream_t stream) {
    static int grid = 0;
    if (grid == 0) {
        if (n_in != 18 || in_sizes[0] != SEQ * DM || out_size != SEQ * DM || ws_size < WS_END) { fprintf(stderr, "kernel_launch: unexpected shapes (n_in %d, in0 %d, out %d, ws %zu < %zu?)\n", n_in, n_in > 0 ? in_sizes[0] : -1, out_size, ws_size, (size_t)WS_END); grid = -1; return; }
        int dev = 0, cus = 0;
        if (hipGetDevice(&dev) != hipSuccess || hipDeviceGetAttribute(&cus, hipDeviceAttributeMultiprocessorCount, dev) != hipSuccess) { grid = -1; return; }
        if (hipFuncSetAttribute((const void*)fwd_kernel, hipFuncAttributeMaxDynamicSharedMemorySize, LDS_BYTES) != hipSuccess) { fprintf(stderr, "kernel_launch: hipFuncSetAttribute failed\n"); grid = -1; return; }
        int per_cu = 0;
        if (hipOccupancyMaxActiveBlocksPerMultiprocessor(&per_cu, (const void*)fwd_kernel, 512, LDS_BYTES) != hipSuccess || per_cu < 1) fprintf(stderr, "kernel_launch: occupancy query says %d\n", per_cu);
        (void)hipGetLastError();
        grid = cus;
        if (grid < 16) { fprintf(stderr, "kernel_launch: needs >= 16 CUs\n"); grid = -1; return; }
    }
    if (grid < 0) return;
    (void)hipMemsetAsync((char*)d_ws + WS_CTL, 0, CTL_ZERO_BYTES, stream);
    Args a{};
    a.x = (const float*)d_in[0]; a.mem = (const float*)d_in[1]; a.pos = (const int*)d_in[2]; a.g_mem = (const float*)d_in[3]; a.w_mem_kv = (const float*)d_in[4];
    a.g_mix_pre = (const float*)d_in[5]; a.g_mix_post = (const float*)d_in[6]; a.g_ffn_pre = (const float*)d_in[7]; a.g_ffn_post = (const float*)d_in[8];
    a.w_conv_in = (const float*)d_in[9]; a.conv_mix_w = (const float*)d_in[10]; a.w_conv_out = (const float*)d_in[11]; a.w_attn_in = (const float*)d_in[12]; a.w_attn_out = (const float*)d_in[13];
    a.w_ffn_gate = (const float*)d_in[14]; a.w_ffn_up = (const float*)d_in[15]; a.conv_ffn_w = (const float*)d_in[16]; a.w_ffn_down = (const float*)d_in[17];
    a.out = (float*)d_out; a.ws = (unsigned char*)d_ws;
#if ONE_LAUNCH
    a.ph_lo = 0; a.ph_hi = NPHASE;
    hipLaunchKernelGGL(fwd_kernel, dim3(grid), dim3(512), LDS_BYTES, stream, a);
#else
    for (int p = 0; p < NPHASE; ++p) { a.ph_lo = p; a.ph_hi = p + 1; hipLaunchKernelGGL(fwd_kernel, dim3(grid), dim3(512), LDS_BYTES, stream, a); }
#endif
}
```

```cpp
#include <hip/hip_runtime.h>
#include <cstdio>
#include <cstdint>

#define LAS __attribute__((address_space(3)))
#define GAS __attribute__((address_space(1)))
typedef unsigned short bf16_t;
typedef short bf16x8 __attribute__((ext_vector_type(8)));
typedef short s16x4 __attribute__((ext_vector_type(4)));
typedef float f32x4 __attribute__((ext_vector_type(4)));
typedef unsigned u32x4 __attribute__((ext_vector_type(4)));
typedef unsigned u32x2 __attribute__((ext_vector_type(2)));

constexpr int SEQ = 8192, DM = 4096, DFF = 11008, CW = 3072, MW = 1024, GW = 2048, NMEM = 256, NHEAD = 16, HDIM = 128;
constexpr int N_CI = 3 * CW + MW;
constexpr int N_AI = 9 * GW + MW;
constexpr int N_GU = 2 * DFF;
constexpr int K_CO = CW + MW;
constexpr int K_AO = GW + MW;
constexpr float EPS = 1e-6f;

#ifndef ONE_LAUNCH
#define ONE_LAUNCH 1
#endif
constexpr int NPHASE = 19;
#ifndef DEFER
#define DEFER 1
#endif
constexpr int D6_WD1_HI = DEFER ? 48 : 0;
constexpr int D15_WD1_HI = DEFER ? 96 : 0;
constexpr int D10_UP1_HI = 0;
constexpr int D10_GATE1 = DEFER ? 64 : 0;

constexpr size_t MiB = 1u << 20;
constexpr size_t WS_CTL = 0, CTL_ZERO_BYTES = 1 * MiB;
constexpr size_t WS_WKV = 1 * MiB;
constexpr size_t WS_WCI = WS_WKV + 16 * MiB;
constexpr size_t WS_WCO = WS_WCI + 80 * MiB;
constexpr size_t WS_WAI = WS_WCO + 32 * MiB;
constexpr size_t WS_WAO = WS_WAI + 152 * MiB;
constexpr size_t WS_WGU = WS_WAO + 24 * MiB;
constexpr size_t WS_WD  = WS_WGU + 2 * 172 * MiB;
constexpr size_t WS_XN  = WS_WD + 2 * 86 * MiB;
constexpr size_t WS_R   = WS_XN + 64 * MiB;
constexpr size_t WS_S   = WS_R + 344 * MiB;
constexpr size_t WS_MEMN = WS_S + 172 * MiB;
constexpr size_t WS_KV  = WS_MEMN + 2 * MiB;
constexpr size_t WS_COS = WS_KV + 1 * MiB;
constexpr size_t WS_SIN = WS_COS + 2 * MiB;
constexpr size_t WS_LSE = WS_SIN + 2 * MiB;
constexpr size_t WS_HALOG = WS_LSE + 2 * MiB;
constexpr size_t WS_FIRSTG = WS_HALOG + 3 * MiB;
constexpr size_t WS_FIRSTU = WS_FIRSTG + 3 * MiB;
constexpr size_t WS_XRES = WS_FIRSTU + 3 * MiB;
constexpr size_t WS_END = WS_XRES + 64 * MiB;
constexpr int CW_BAR = 4096;

constexpr int RING_BYTES = 131072;
constexpr int LDSCTL_OFF = 146432;
constexpr int LDS_BYTES = 147456;

__device__ __forceinline__ unsigned cvt_pk_bf16(float lo, float hi) { unsigned r; asm("v_cvt_pk_bf16_f32 %0, %1, %2" : "=v"(r) : "v"(lo), "v"(hi)); return r; }
__device__ __forceinline__ float bf_lo(unsigned w) { return __uint_as_float(w << 16); }
__device__ __forceinline__ float bf_hi(unsigned w) { return __uint_as_float(w & 0xffff0000u); }
__device__ __forceinline__ int fresh_lane() { int l; asm volatile("v_mbcnt_lo_u32_b32 %0, -1, 0\n\tv_mbcnt_hi_u32_b32 %0, -1, %0" : "=v"(l)); return l; }
__device__ __forceinline__ int fresh_tid() { int t = threadIdx.x; asm volatile("" : "+v"(t)); return t; }
__device__ __forceinline__ float wave_sum(float v) {
#pragma unroll
    for (int o = 1; o < 64; o <<= 1) v += __shfl_xor(v, o);
    return v;
}

__constant__ float INV_FREQ[64] = {
1.000000000e+00f, 8.659643531e-01f, 7.498942018e-01f, 6.493816376e-01f, 5.623413324e-01f, 4.869675338e-01f, 4.216965139e-01f, 3.651741147e-01f, 3.162277639e-01f, 2.738419771e-01f, 2.371373773e-01f, 2.053525001e-01f, 1.778279394e-01f, 1.539926529e-01f, 1.333521456e-01f, 1.154781953e-01f,
1.000000015e-01f, 8.659642935e-02f, 7.498942316e-02f, 6.493816525e-02f, 5.623413250e-02f, 4.869675264e-02f, 4.216964915e-02f, 3.651741147e-02f, 3.162277490e-02f, 2.738419548e-02f, 2.371373773e-02f, 2.053525113e-02f, 1.778279431e-02f, 1.539926510e-02f, 1.333521400e-02f, 1.154781971e-02f,
9.999999776e-03f, 8.659643121e-03f, 7.498942316e-03f, 6.493816152e-03f, 5.623413250e-03f, 4.869675264e-03f, 4.216964822e-03f, 3.651741194e-03f, 3.162277630e-03f, 2.738419687e-03f, 2.371373819e-03f, 2.053525066e-03f, 1.778279431e-03f, 1.539926510e-03f, 1.333521446e-03f, 1.154782018e-03f,
1.000000047e-03f, 8.659643354e-04f, 7.498941850e-04f, 6.493816036e-04f, 5.623413017e-04f, 4.869675322e-04f, 4.216965172e-04f, 3.651741135e-04f, 3.162277571e-04f, 2.738419571e-04f, 2.371373703e-04f, 2.053525095e-04f, 1.778279402e-04f, 1.539926598e-04f, 1.333521504e-04f, 1.154782003e-04f };

namespace pg8 {
constexpr int BM = 256, BK = 64, HALF = 128, HTB = HALF * BK * 2, STAGE_BYTES = 8 * HTB, NXCD = 8, WGM = 8;
__host__ __device__ __forceinline__ int lds_byte(int r, int c) { const int st = (r >> 4) * 2 + (c >> 5), rr = r & 15, cc = c & 31, ob = rr * 64 + cc * 2; return st * 1024 + (ob ^ (((ob >> 9) & 1) << 5)); }
__host__ __device__ __forceinline__ void stage_rc(int b, int& R, int& C) { const int st = b / 1024, sb = b % 1024, swz = sb ^ (((sb >> 9) & 1) << 5); R = (st >> 1) * 16 + swz / 64; C = (st & 1) * 32 + (swz % 64) / 2; }
__host__ __device__ __forceinline__ int perm32(int rho) { const int n = rho >> 4, i = rho & 15; return 8 * (i >> 2) + 4 * n + (i & 3); }

struct Unit { int pm, pn; };
struct SameTileOrder { int n;
    __device__ bool next(int i, Unit& u) const { if (i >= n) return false; u.pm = 0; u.pn = 0; return true; }
    __device__ __forceinline__ void a_ready(const Unit&) const {}
    __device__ __forceinline__ void done(const Unit&) const {} };
struct Gemm { const bf16_t* A; const bf16_t* Bt; int K, lda, ldb; };

struct StaticOrder {
    int nM, nN, nwg, G, c;
    __host__ __device__ void init(int M, int N, int G_, int c_) { nM = M / BM; nN = N / BM; nwg = nM * nN; G = G_; c = c_; }
    __host__ __device__ bool next(int i, Unit& u) const {
        const long L = (long)i * G + c; if (L >= nwg) return false;
        int wgid = (int)L; { const int q = nwg / NXCD, r = nwg % NXCD, xcd = wgid % NXCD, off = wgid / NXCD; wgid = (xcd < r ? xcd * (q + 1) : r * (q + 1) + (xcd - r) * q) + off; }
        const int nig = WGM * nN, gid = wgid / nig, fm = gid * WGM, gsz = (nM - fm) < WGM ? (nM - fm) : WGM;
        u.pm = fm + ((wgid % nig) % gsz); u.pn = (wgid % nig) / gsz; return true;
    }
    __device__ __forceinline__ void a_ready(const Unit&) const {}
    __device__ __forceinline__ void done(const Unit&) const {}
};

struct EpiStore {
    static constexpr bool PERM = true, AFTER_DRAIN = false;
    bf16_t* O; int ldc;
    __device__ __forceinline__ void operator()(const f32x4 (&acc)[2][2][4][2], const Unit& u, int wr, int wc, int fr, int fq) const {
        const int row0 = u.pm * BM + wr * 64 + fr, col0 = u.pn * BM + wc * 32 + 8 * fq;
#pragma unroll
        for (int ai = 0; ai < 2; ++ai)
#pragma unroll
            for (int m = 0; m < 4; ++m) { bf16_t* rowp = O + (size_t)(row0 + ai * HALF + m * 16) * ldc + col0;
#pragma unroll
                for (int bj = 0; bj < 2; ++bj) { const f32x4 v0 = acc[ai][bj][m][0], v1 = acc[ai][bj][m][1];
                    u32x4 w; w.x = cvt_pk_bf16(v0[0], v0[1]); w.y = cvt_pk_bf16(v0[2], v0[3]); w.z = cvt_pk_bf16(v1[0], v1[1]); w.w = cvt_pk_bf16(v1[2], v1[3]);
                    *(u32x4*)(rowp + bj * HALF) = w; } }
    }
};
struct EpiQKV {
    static constexpr bool PERM = true, AFTER_DRAIN = false;
    bf16_t* QKVL; bf16_t* QM; const float* cosT; const float* sinT;
    __device__ __forceinline__ void operator()(const f32x4 (&acc)[2][2][4][2], const Unit& u, int wr, int wc, int fr, int fq) const {
        const int colt = u.pn * BM;
        const int row0 = u.pm * BM + wr * 64 + fr;
        if (colt >= 9 * GW) {
            const int col0 = colt - 9 * GW + wc * 32 + 8 * fq;
#pragma unroll
            for (int ai = 0; ai < 2; ++ai)
#pragma unroll
                for (int m = 0; m < 4; ++m) { bf16_t* rowp = QM + (size_t)(row0 + ai * HALF + m * 16) * MW + col0;
#pragma unroll
                    for (int bj = 0; bj < 2; ++bj) { const f32x4 v0 = acc[ai][bj][m][0], v1 = acc[ai][bj][m][1];
                        u32x4 w; w.x = cvt_pk_bf16(v0[0], v0[1]); w.y = cvt_pk_bf16(v0[2], v0[3]); w.z = cvt_pk_bf16(v1[0], v1[1]); w.w = cvt_pk_bf16(v1[2], v1[3]);
                        *(u32x4*)(rowp + bj * HALF) = w; } }
        } else {
            const int g = colt / (3 * GW), rem = colt % (3 * GW), part = rem / GW, hd0 = (rem % GW) / HDIM, dsh = 2 * g, dm1 = (1 << dsh) - 1;
            bf16_t* slab0 = QKVL + (size_t)((g * 3 + part) * NHEAD + hd0) * SEQ * HDIM;
            if (part == 2) {
#pragma unroll
                for (int ai = 0; ai < 2; ++ai)
#pragma unroll
                    for (int m = 0; m < 4; ++m) { const int row = row0 + ai * HALF + m * 16; const int rp = ((row & dm1) << (13 - dsh)) + (row >> dsh);
#pragma unroll
                        for (int bj = 0; bj < 2; ++bj) { const f32x4 v0 = acc[ai][bj][m][0], v1 = acc[ai][bj][m][1];
                            u32x4 w; w.x = cvt_pk_bf16(v0[0], v0[1]); w.y = cvt_pk_bf16(v0[2], v0[3]); w.z = cvt_pk_bf16(v1[0], v1[1]); w.w = cvt_pk_bf16(v1[2], v1[3]);
                            *(u32x4*)(slab0 + ((size_t)bj * SEQ + rp) * HDIM + wc * 32 + 8 * fq) = w; } }
            } else {
                const int x0 = wc * 32 + 8 * fq, hh = x0 >> 6, d0 = x0 & 63;
#pragma unroll
                for (int ai = 0; ai < 2; ++ai)
#pragma unroll
                    for (int m = 0; m < 4; ++m) { const int row = row0 + ai * HALF + m * 16; const int rp = ((row & dm1) << (13 - dsh)) + (row >> dsh);
                        const f32x4 c0 = *(const f32x4*)(cosT + (size_t)row * 64 + d0), c1 = *(const f32x4*)(cosT + (size_t)row * 64 + d0 + 4);
                        const f32x4 s0 = *(const f32x4*)(sinT + (size_t)row * 64 + d0), s1 = *(const f32x4*)(sinT + (size_t)row * 64 + d0 + 4);
                        const f32x4 a0 = acc[ai][0][m][0], a1 = acc[ai][0][m][1], b0 = acc[ai][1][m][0], b1 = acc[ai][1][m][1];
                        const f32x4 o10 = a0 * c0 - b0 * s0, o11 = a1 * c1 - b1 * s1, o20 = b0 * c0 + a0 * s0, o21 = b1 * c1 + a1 * s1;
                        bf16_t* rowp = slab0 + ((size_t)hh * SEQ + rp) * HDIM + d0;
                        u32x4 w; w.x = cvt_pk_bf16(o10[0], o10[1]); w.y = cvt_pk_bf16(o10[2], o10[3]); w.z = cvt_pk_bf16(o11[0], o11[1]); w.w = cvt_pk_bf16(o11[2], o11[3]);
                        *(u32x4*)(rowp) = w;
                        w.x = cvt_pk_bf16(o20[0], o20[1]); w.y = cvt_pk_bf16(o20[2], o20[3]); w.z = cvt_pk_bf16(o21[0], o21[1]); w.w = cvt_pk_bf16(o21[2], o21[3]);
                        *(u32x4*)(rowp + 64) = w;
                        asm volatile("" ::: "memory"); }
            }
        }
    }
};
__device__ __forceinline__ float dpp_ror1(float v) { return __builtin_bit_cast(float, __builtin_amdgcn_update_dpp(0, __builtin_bit_cast(int, v), 0x121, 0xf, 0xf, false)); }
__device__ __forceinline__ float dpp_ror2(float v) { return __builtin_bit_cast(float, __builtin_amdgcn_update_dpp(0, __builtin_bit_cast(int, v), 0x122, 0xf, 0xf, false)); }
struct EpiFfn {
    static constexpr bool PERM = true, AFTER_DRAIN = false;
    bf16_t* ACT; const float* cw; float* HALOG; float* FIRSTG; float* FIRSTU; LAS unsigned char* xl;
    __device__ __forceinline__ void operator()(const f32x4 (&acc)[2][2][4][2], const Unit& u, int wr, int wc, int fr, int fq) const {
        const int ch0 = u.pn * 128 + wc * 32 + 8 * fq;
        LAS f32x4* hl = (LAS f32x4*)xl;
        if (fr >= 14) {
#pragma unroll
            for (int ai = 0; ai < 2; ++ai) { const int idx = ((((ai * 2 + wr) * 4 + wc) * 2 + (fr - 14)) * 4 + fq) * 2; hl[idx] = acc[ai][0][3][0]; hl[idx + 1] = acc[ai][0][3][1]; }
        }
        float w0[8], w1[8], w2[8];
        { const f32x4 a0 = *(const f32x4*)(cw + ch0), a1 = *(const f32x4*)(cw + ch0 + 4), b0 = *(const f32x4*)(cw + DFF + ch0), b1 = *(const f32x4*)(cw + DFF + ch0 + 4), c0 = *(const f32x4*)(cw + 2 * DFF + ch0), c1 = *(const f32x4*)(cw + 2 * DFF + ch0 + 4);
#pragma unroll
          for (int i = 0; i < 4; ++i) { w0[i] = a0[i]; w0[4 + i] = a1[i]; w1[i] = b0[i]; w1[4 + i] = b1[i]; w2[i] = c0[i]; w2[4 + i] = c1[i]; } }
        asm volatile("s_waitcnt lgkmcnt(0)" ::: "memory"); __builtin_amdgcn_s_barrier(); asm volatile("" ::: "memory");
#pragma unroll
        for (int ai = 0; ai < 2; ++ai) {
            const bool ext = (wr == 0 && ai == 0);
            float x14[8], x15[8];
            if (ext) {
#pragma unroll
                for (int i = 0; i < 8; ++i) { x14[i] = 0.f; x15[i] = 0.f; }
            } else {
                const int sai = (wr == 1) ? ai : 0, swr = (wr == 1) ? 0 : 1;
                const int b = ((((sai * 2 + swr) * 4 + wc) * 2) * 4 + fq) * 2;
                const f32x4 p0 = hl[b], p1 = hl[b + 1], q0 = hl[b + 8], q1 = hl[b + 9];
#pragma unroll
                for (int i = 0; i < 4; ++i) { x14[i] = p0[i]; x14[4 + i] = p1[i]; x15[i] = q0[i]; x15[4 + i] = q1[i]; }
            }
            float r1p[8], r2p[8];
#pragma unroll
            for (int i = 0; i < 8; ++i) { r1p[i] = x15[i]; r2p[i] = (fr == 0) ? x14[i] : x15[i]; }
#pragma unroll
            for (int m = 0; m < 4; ++m) {
                float cur[8], up[8], o[8];
#pragma unroll
                for (int i = 0; i < 4; ++i) { cur[i] = acc[ai][0][m][0][i]; cur[4 + i] = acc[ai][0][m][1][i]; up[i] = acc[ai][1][m][0][i]; up[4 + i] = acc[ai][1][m][1][i]; }
                const int row = u.pm * BM + ai * HALF + wr * 64 + m * 16 + fr;
#pragma unroll
                for (int i = 0; i < 8; ++i) {
                    const float r1 = dpp_ror1(cur[i]), r2 = dpp_ror2(cur[i]);
                    const float p1 = (fr >= 1) ? r1 : r1p[i], p2 = (fr >= 2) ? r2 : r2p[i];
                    const float g = w0[i] * p2 + w1[i] * p1 + w2[i] * cur[i];
                    o[i] = g * __builtin_amdgcn_rcpf(1.0f + __builtin_amdgcn_exp2f(-1.4426950408889634f * g)) * up[i];
                    r1p[i] = r1; r2p[i] = r2;
                }
                const bool first2 = ext && m == 0 && fr < 2 && u.pm > 0;
                if (!first2) {
                    u32x4 w; w.x = cvt_pk_bf16(o[0], o[1]); w.y = cvt_pk_bf16(o[2], o[3]); w.z = cvt_pk_bf16(o[4], o[5]); w.w = cvt_pk_bf16(o[6], o[7]);
                    *(u32x4*)(ACT + (size_t)row * DFF + ch0) = w;
                } else {
                    float* fg = FIRSTG + (size_t)(u.pm * 2 + fr) * DFF + ch0; float* fu = FIRSTU + (size_t)(u.pm * 2 + fr) * DFF + ch0;
                    *(f32x4*)fg = acc[ai][0][m][0]; *(f32x4*)(fg + 4) = acc[ai][0][m][1]; *(f32x4*)fu = acc[ai][1][m][0]; *(f32x4*)(fu + 4) = acc[ai][1][m][1];
                }
                if (ai == 1 && wr == 1 && m == 3 && fr >= 14) { float* hg = HALOG + (size_t)(u.pm * 2 + fr - 14) * DFF + ch0; *(f32x4*)hg = acc[ai][0][m][0]; *(f32x4*)(hg + 4) = acc[ai][0][m][1]; }
            }
        }
    }
};

template <class Epi, class Sched, bool ALIGN_EPI>
__device__ __forceinline__ void gemm_phase(LAS unsigned char* lds, const Gemm g, const Sched& S, const Epi& E) {
    const int tid = fresh_tid(), wid = __builtin_amdgcn_readfirstlane(tid >> 6), lane = tid & 63, wr = wid >> 2, wc = wid & 3, fr = lane & 15, fq = lane >> 4;
    const int K = g.K, nt = K / BK;
    unsigned voffA[2], voffB[2];
#pragma unroll
    for (int i = 0; i < 2; ++i) { int R, C; stage_rc(tid * 16 + i * 8192, R, C); const int Rb = Epi::PERM ? ((R & ~31) + perm32(R & 31)) : R;
        voffA[i] = (unsigned)(R * g.lda + C) * 2u; voffB[i] = (unsigned)(Rb * g.ldb + C) * 2u; }
    const size_t kstep = (size_t)(BK * 2);
    const size_t hstepA = (size_t)HALF * g.lda * 2, hstepB = (size_t)HALF * g.ldb * 2;
    const size_t tstepA = 2 * hstepA, tstepB = 2 * hstepB;
    const unsigned ldsw = (unsigned)wid * 1024u;
    const int aoff = lds_byte(wr * 64 + fr, fq * 8), boff = lds_byte(wc * 32 + fr, fq * 8);
#define PG8_SA(b, h) (((b) * 2 + (h)) * HTB)
#define PG8_SB(b, h) ((4 + (b) * 2 + (h)) * HTB)
#define PG8_STAGE(bufoff, gbase, voff) do { _Pragma("unroll") for (int _i = 0; _i < 2; ++_i) \
        __builtin_amdgcn_global_load_lds((const unsigned*)((const char*)(gbase) + (voff)[_i]), (LAS unsigned*)(lds + (bufoff) + ldsw + _i * 8192), 16, 0, 0); } while (0)
#define PG8_LDA(dst, b, h) do { _Pragma("unroll") for (int m = 0; m < 4; ++m) _Pragma("unroll") for (int k = 0; k < 2; ++k) dst[m][k] = *(const LAS bf16x8*)(lds + PG8_SA(b, h) + aoff + m * 2048 + k * 1024); } while (0)
#define PG8_LDB(dst, b, h) do { _Pragma("unroll") for (int n = 0; n < 2; ++n) _Pragma("unroll") for (int k = 0; k < 2; ++k) dst[n][k] = *(const LAS bf16x8*)(lds + PG8_SB(b, h) + boff + n * 2048 + k * 1024); } while (0)
#define PG8_MMA(ai, bj, At, Bt) do { __builtin_amdgcn_s_setprio(1); _Pragma("unroll") for (int m = 0; m < 4; ++m) _Pragma("unroll") for (int n = 0; n < 2; ++n) _Pragma("unroll") for (int k = 0; k < 2; ++k) \
        acc[ai][bj][m][n] = __builtin_amdgcn_mfma_f32_16x16x32_bf16(Bt[n][k], At[m][k], acc[ai][bj][m][n], 0, 0, 0); __builtin_amdgcn_s_setprio(0); } while (0)
#define PG8_WAIT_V(n) asm volatile("s_waitcnt vmcnt(" #n ")" ::: "memory")
#define PG8_WAIT_L(n) asm volatile("s_waitcnt lgkmcnt(" #n ")" ::: "memory")
#define PG8_BAR __builtin_amdgcn_s_barrier()
#define PG8_SCHED __builtin_amdgcn_sched_barrier(0)
    Unit cur, nxt; int ui = 0;
    if (!S.next(0, cur)) return;
    f32x4 acc[2][2][4][2];
#pragma unroll
    for (int a = 0; a < 2; ++a)
#pragma unroll
        for (int b = 0; b < 2; ++b)
#pragma unroll
            for (int m = 0; m < 4; ++m)
#pragma unroll
                for (int n = 0; n < 2; ++n) acc[a][b][m][n] = (f32x4){0.f, 0.f, 0.f, 0.f};
    bf16x8 At[4][2], B0[2][2], B1[2][2];
    const char* cA = (const char*)g.A + (size_t)cur.pm * tstepA; const char* cB = (const char*)g.Bt + (size_t)cur.pn * tstepB;
    S.a_ready(cur);
    PG8_STAGE(PG8_SB(0, 0), cB, voffB); PG8_STAGE(PG8_SB(0, 1), cB + hstepB, voffB); PG8_STAGE(PG8_SA(0, 0), cA, voffA); PG8_STAGE(PG8_SA(0, 1), cA + hstepA, voffA);
    if (wr == 1) PG8_BAR;
    PG8_WAIT_V(2); PG8_BAR;
    PG8_STAGE(PG8_SB(1, 0), cB + kstep, voffB); PG8_STAGE(PG8_SA(1, 0), cA + kstep, voffA); PG8_STAGE(PG8_SB(1, 1), cB + hstepB + kstep, voffB);
    PG8_WAIT_V(6); PG8_BAR;
    for (;;) {
        const bool has_next = S.next(ui + 1, nxt);
        const char* nA = has_next ? (const char*)g.A + (size_t)nxt.pm * tstepA : cA; const char* nB = has_next ? (const char*)g.Bt + (size_t)nxt.pn * tstepB : cB;
        for (int t = 0; t < nt; t += 2) {
            const bool last = (t == nt - 2);
            const char* a1 = cA + (size_t)(t + 1) * kstep;
            const char* a2 = last ? nA : cA + (size_t)(t + 2) * kstep; const char* b2 = last ? nB : cB + (size_t)(t + 2) * kstep;
            const char* a3 = a2 + kstep; const char* b3 = b2 + kstep;
            if (last && has_next) S.a_ready(nxt);
            PG8_LDB(B0, 0, 0); PG8_LDB(B1, 0, 1); PG8_SCHED; PG8_LDA(At, 0, 0); PG8_STAGE(PG8_SA(1, 1), a1 + hstepA, voffA);
            PG8_WAIT_V(8); PG8_WAIT_L(0); PG8_BAR; PG8_MMA(0, 0, At, B0); PG8_MMA(0, 1, At, B1); PG8_BAR; PG8_SCHED;
            PG8_LDA(At, 0, 1); PG8_STAGE(PG8_SB(0, 0), b2, voffB); PG8_STAGE(PG8_SB(0, 1), b2 + hstepB, voffB); PG8_STAGE(PG8_SA(0, 0), a2, voffA);
            PG8_WAIT_V(8); PG8_WAIT_L(0); PG8_BAR; PG8_MMA(1, 0, At, B0); PG8_MMA(1, 1, At, B1); PG8_BAR; PG8_SCHED;
            PG8_LDB(B0, 1, 0); PG8_LDB(B1, 1, 1); PG8_SCHED; PG8_LDA(At, 1, 0); PG8_STAGE(PG8_SA(0, 1), a2 + hstepA, voffA);
            PG8_WAIT_V(8); PG8_WAIT_L(0); PG8_BAR; PG8_MMA(0, 0, At, B0); PG8_MMA(0, 1, At, B1); PG8_BAR; PG8_SCHED;
            PG8_LDA(At, 1, 1); PG8_STAGE(PG8_SB(1, 0), b3, voffB); PG8_STAGE(PG8_SB(1, 1), b3 + hstepB, voffB); PG8_STAGE(PG8_SA(1, 0), a3, voffA);
            PG8_WAIT_V(8); PG8_WAIT_L(0); PG8_BAR; PG8_MMA(1, 0, At, B0); PG8_MMA(1, 1, At, B1); PG8_BAR; PG8_SCHED;
        }
        if constexpr (ALIGN_EPI) { if (wr == 0) PG8_BAR; }
        E(acc, cur, wr, wc, fr, fq); S.done(cur);
        if (!has_next) break;
#pragma unroll
        for (int a = 0; a < 2; ++a)
#pragma unroll
            for (int b = 0; b < 2; ++b)
#pragma unroll
                for (int m = 0; m < 4; ++m)
#pragma unroll
                    for (int n = 0; n < 2; ++n) acc[a][b][m][n] = (f32x4){0.f, 0.f, 0.f, 0.f};
        cur = nxt; cA = nA; cB = nB; ++ui;
        if constexpr (ALIGN_EPI) { if (wr == 1) PG8_BAR; }
    }
    PG8_WAIT_V(0);
    if constexpr (!ALIGN_EPI) { if (wr == 0) PG8_BAR; }
    PG8_BAR;
#undef PG8_SA
#undef PG8_SB
#undef PG8_STAGE
#undef PG8_LDA
#undef PG8_LDB
#undef PG8_MMA
#undef PG8_WAIT_V
#undef PG8_WAIT_L
#undef PG8_BAR
#undef PG8_SCHED
}
}

#define XB_TMO      128
#define XB_XCNT(j)  (256  + 64 * (j))
#define XB_XSUB(j)  (1280 + 64 * (j))
#define XB_XGEN(j)  (2304 + 64 * (j))
#define XB_TOP      3328
#define XB_TOPGEN   3392
#define XCD_BAR_WORDS 3456
#define XB_SPIN_CAP (1u << 18)
__device__ __forceinline__ unsigned xb_ld(unsigned* p)              { return __hip_atomic_load(p, __ATOMIC_RELAXED, __HIP_MEMORY_SCOPE_AGENT); }
__device__ __forceinline__ unsigned xb_add(unsigned* p, unsigned v) { return __hip_atomic_fetch_add(p, v, __ATOMIC_RELAXED, __HIP_MEMORY_SCOPE_AGENT); }
__device__ __forceinline__ unsigned xb_xcc_id() { return (unsigned)__builtin_amdgcn_s_getreg((3 << 11) | 20) & 0xFu; }
#define XB_SPIN(cond, bar) do { unsigned _sp = 0; while (cond) { __builtin_amdgcn_s_sleep(1); \
    if ((++_sp & 255u) == 0u) { if (xb_ld(&(bar)[XB_TMO])) break; if (_sp > XB_SPIN_CAP) { atomicAdd(&(bar)[XB_TMO], 1u); break; } } } } while (0)
struct XcdBarrier { unsigned* bar; unsigned x; volatile LAS unsigned* st; };
__device__ __forceinline__ XcdBarrier xcd_barrier_post(unsigned* bar, volatile LAS unsigned* st) {
    XcdBarrier b; b.bar = bar; b.x = xb_xcc_id(); b.st = st;
    if (threadIdx.x == 0) (void)xb_add(&bar[XB_XCNT(b.x)], 1u);
    return b;
}
__device__ __forceinline__ void xcd_barrier_complete(unsigned* bar, unsigned x, unsigned& nloc, unsigned& nx) {
    const unsigned G = gridDim.x * gridDim.y * gridDim.z;
    unsigned sum, cnt, mine, sp = 0u;
    for (;;) {
        sum = 0u; cnt = 0u; mine = 0u;
#pragma unroll
        for (unsigned j = 0; j < 16; ++j) { const unsigned c = xb_ld(&bar[XB_XCNT(j)]); sum += c; cnt += (c > 0u) ? 1u : 0u; mine = (j == x) ? c : mine; }
        if (sum == G) break;
        __builtin_amdgcn_s_sleep(1);
        if ((++sp & 255u) == 0u) { if (xb_ld(&bar[XB_TMO])) break; if (sp > XB_SPIN_CAP) { atomicAdd(&bar[XB_TMO], 1u); break; } }
    }
    nloc = mine > 0u ? mine : 1u; nx = cnt > 0u ? cnt : 1u;
}
__device__ __forceinline__ void xcd_barrier(const XcdBarrier& b) {
    asm volatile("s_waitcnt vmcnt(0)" ::: "memory");
    __syncthreads();
    if (threadIdx.x == 0) {
        unsigned* bar = b.bar;
        __builtin_amdgcn_s_waitcnt(0);
        unsigned nloc = b.st[0], nx = b.st[1];
        if (nloc == 0u) { xcd_barrier_complete(bar, b.x, nloc, nx); b.st[0] = nloc; b.st[1] = nx; }
        const unsigned old = xb_add(&bar[XB_XSUB(b.x)], 1u);
        const unsigned gen = old / nloc;
        if (old + 1u == (gen + 1u) * nloc) {
            __builtin_amdgcn_fence(__ATOMIC_RELEASE, "agent");
            asm volatile("s_waitcnt vmcnt(0)" ::: "memory");
            const unsigned og = xb_add(&bar[XB_TOP], 1u);
            const unsigned tg = og / nx;
            if (og + 1u == (tg + 1u) * nx) xb_add(&bar[XB_TOPGEN], 1u);
            else XB_SPIN(xb_ld(&bar[XB_TOPGEN]) == tg, bar);
            __builtin_amdgcn_fence(__ATOMIC_ACQUIRE, "agent");
            xb_add(&bar[XB_XGEN(b.x)], 1u);
            asm volatile("s_waitcnt vmcnt(0)" ::: "memory");
        } else {
            XB_SPIN(xb_ld(&bar[XB_XGEN(b.x)]) == gen, bar);
            __builtin_amdgcn_fence(__ATOMIC_ACQUIRE, "agent");
            asm volatile("s_waitcnt vmcnt(0)" ::: "memory");
        }
    }
    __syncthreads();
}

template <int MODE  >
__device__ __forceinline__ void cvt_matrix(const float* W, int K, int N, bf16_t* WT, int row_off, LAS float* scr, int gw, int ngw, int, int kb_lo = 0, int kb_hi = -1) {
    const int lane = fresh_lane();
    if (kb_hi < 0) kb_hi = K / 64;
    const int nblk = N / 32, nitems = (kb_hi - kb_lo) * nblk;
    for (int item = gw; item < nitems; item += ngw) {
        const int kb = kb_lo + item / nblk, nb = item % nblk, k0 = 64 * kb, n0 = 32 * nb;
#pragma unroll 8
        for (int i = 0; i < 32; ++i) { const int kk = 2 * i + (lane >> 5); scr[kk * 33 + (lane & 31)] = W[(size_t)(k0 + kk) * N + n0 + (lane & 31)]; }
        asm volatile("s_waitcnt lgkmcnt(0)" ::: "memory");
        int d0 = n0;
        if (MODE == 1) { if (n0 < 9 * GW && (n0 % (3 * GW)) < 2 * GW) d0 = (n0 & ~0xC0) | ((n0 & 0x40) << 1) | ((n0 & 0x80) >> 1); }
        if (MODE == 2) d0 = (n0 >> 7) * 256 + (n0 & 127);
        if (MODE == 3) d0 = (n0 >> 7) * 256 + 128 + (n0 & 127);
        const int c = lane & 7;
#pragma unroll
        for (int j = 0; j < 4; ++j) { const int n = (lane >> 3) + 8 * j; const LAS float* s = scr + (8 * c) * 33 + n;
            u32x4 o; o.x = cvt_pk_bf16(s[0 * 33], s[1 * 33]); o.y = cvt_pk_bf16(s[2 * 33], s[3 * 33]); o.z = cvt_pk_bf16(s[4 * 33], s[5 * 33]); o.w = cvt_pk_bf16(s[6 * 33], s[7 * 33]);
            *(u32x4*)(WT + (size_t)(row_off + d0 + n) * K + k0 + 8 * c) = o; }
        asm volatile("s_waitcnt lgkmcnt(0)" ::: "memory");
    }
}
template <int MODE>
__device__ __forceinline__ void cvt_matrix2(const float* W, int K, int N, bf16_t* WT, LAS unsigned char* scr, int gw, int ngw, int kb_lo, int kb_hi) {
    constexpr int P = 144;
    const int lane = fresh_lane(), l16 = lane & 15, g4 = lane >> 4, q = l16 >> 2, p = l16 & 3;
    const int nblk = N / 64, nitems = (kb_hi - kb_lo) * nblk;
    const unsigned tra = (unsigned)(size_t)scr + (unsigned)((8 * g4 + q) * P + p * 8);
    if (gw >= nitems) return;
    f32x4 vn[16];
    { const int kb = kb_lo + gw / nblk, nb = gw % nblk; const float* src = W + (size_t)(64 * kb + g4) * N + 64 * nb + l16 * 4;
#pragma unroll
      for (int i = 0; i < 16; ++i) vn[i] = *(const f32x4*)(src + (size_t)(4 * i) * N); }
    for (int item = gw; item < nitems; item += ngw) {
        const int kb = kb_lo + item / nblk, nb = item % nblk, k0 = 64 * kb, n0 = 64 * nb;
        f32x4 v[16];
#pragma unroll
        for (int i = 0; i < 16; ++i) v[i] = vn[i];
        if (item + ngw < nitems) {
            const int it2 = item + ngw, kb2 = kb_lo + it2 / nblk, nb2 = it2 % nblk; const float* src = W + (size_t)(64 * kb2 + g4) * N + 64 * nb2 + l16 * 4;
#pragma unroll
            for (int i = 0; i < 16; ++i) vn[i] = *(const f32x4*)(src + (size_t)(4 * i) * N);
        }
#pragma unroll
        for (int i = 0; i < 16; ++i) { u32x2 w; w.x = cvt_pk_bf16(v[i].x, v[i].y); w.y = cvt_pk_bf16(v[i].z, v[i].w); *(LAS u32x2*)(scr + (4 * i + g4) * P + l16 * 8) = w; }
        asm volatile("s_waitcnt lgkmcnt(0)" ::: "memory");
        int d0 = n0;
        if (MODE == 1) { if (n0 < 9 * GW && (n0 % (3 * GW)) < 2 * GW) d0 = (n0 & ~0xC0) | ((n0 & 0x40) << 1) | ((n0 & 0x80) >> 1); }
        if (MODE == 2) d0 = (n0 >> 7) * 256 + (n0 & 127);
        if (MODE == 3) d0 = (n0 >> 7) * 256 + 128 + (n0 & 127);
        bf16_t* dst = WT + (size_t)(d0 + l16) * K + k0 + 8 * g4;
#define TRRD(dst_, off) asm volatile("ds_read_b64_tr_b16 %0, %1 offset:%2" : "=&v"(dst_) : "v"(tra), "i"(off) : "memory")
#define CVT_OUT(nbk, h) do { s16x4 lo_, hi_; TRRD(lo_, (32 * (h)) * P + (nbk) * 32); TRRD(hi_, (32 * (h) + 4) * P + (nbk) * 32); asm volatile("s_waitcnt lgkmcnt(0)" ::: "memory"); \
        *(bf16x8*)(dst + (size_t)(16 * (nbk)) * K + 32 * (h)) = (bf16x8){lo_[0], lo_[1], lo_[2], lo_[3], hi_[0], hi_[1], hi_[2], hi_[3]}; } while (0)
        CVT_OUT(0, 0); CVT_OUT(0, 1); CVT_OUT(1, 0); CVT_OUT(1, 1); CVT_OUT(2, 0); CVT_OUT(2, 1); CVT_OUT(3, 0); CVT_OUT(3, 1);
#undef CVT_OUT
#undef TRRD
        asm volatile("s_waitcnt lgkmcnt(0)" ::: "memory");
    }
}
__device__ __forceinline__ void rms_row_to_bf16(const float* xrow, const float* g, bf16_t* orow, int) {
    const int lane = fresh_lane();
    const f32x4* xr = (const f32x4*)xrow + lane;
    f32x4 v[16]; float s = 0.f;
#pragma unroll
    for (int j = 0; j < 16; ++j) { v[j] = xr[64 * j]; s += (v[j].x * v[j].x + v[j].y * v[j].y) + (v[j].z * v[j].z + v[j].w * v[j].w); }
    const float rstd = 1.0f / sqrtf(wave_sum(s) * (1.f / DM) + EPS);
    const f32x4* gr = (const f32x4*)g + lane; u32x2* o8 = (u32x2*)orow + lane;
#pragma unroll
    for (int j = 0; j < 16; ++j) { const f32x4 gv = gr[64 * j]; u32x2 w; w.x = cvt_pk_bf16(v[j].x * rstd * gv.x, v[j].y * rstd * gv.y); w.y = cvt_pk_bf16(v[j].z * rstd * gv.z, v[j].w * rstd * gv.w); o8[64 * j] = w; }
}
template <bool SRC_F32, bool DST_F32, bool HAS_XN>
__device__ __forceinline__ void norm_res_row(const void* xsrc, const bf16_t* yrow, const float* gpost, const float* gpre, void* xout, bf16_t* xn) {
    const int lane = fresh_lane();
    const u32x2* yr = (const u32x2*)yrow + lane; f32x4 y[16]; float s = 0.f;
#pragma unroll
    for (int j = 0; j < 16; ++j) { const u32x2 w = yr[64 * j]; y[j] = (f32x4){bf_lo(w.x), bf_hi(w.x), bf_lo(w.y), bf_hi(w.y)}; s += (y[j].x * y[j].x + y[j].y * y[j].y) + (y[j].z * y[j].z + y[j].w * y[j].w); }
    const float rstd = 1.0f / sqrtf(wave_sum(s) * (1.f / DM) + EPS);
    const f32x4* gp = (const f32x4*)gpost + lane; float s2 = 0.f;
#pragma unroll
    for (int j = 0; j < 16; ++j) { f32x4 xv;
        if (SRC_F32) xv = ((const f32x4*)xsrc + lane)[64 * j]; else { const u32x2 w = ((const u32x2*)xsrc + lane)[64 * j]; xv = (f32x4){bf_lo(w.x), bf_hi(w.x), bf_lo(w.y), bf_hi(w.y)}; }
        const f32x4 gv = gp[64 * j]; y[j] = xv + y[j] * rstd * gv;
        if (DST_F32) ((f32x4*)xout + lane)[64 * j] = y[j];
        else { u32x2 w; w.x = cvt_pk_bf16(y[j].x, y[j].y); w.y = cvt_pk_bf16(y[j].z, y[j].w); ((u32x2*)xout + lane)[64 * j] = w; y[j] = (f32x4){bf_lo(w.x), bf_hi(w.x), bf_lo(w.y), bf_hi(w.y)}; }
        s2 += (y[j].x * y[j].x + y[j].y * y[j].y) + (y[j].z * y[j].z + y[j].w * y[j].w); }
    if (HAS_XN) {
        const float rstd2 = 1.0f / sqrtf(wave_sum(s2) * (1.f / DM) + EPS);
        const f32x4* gr = (const f32x4*)gpre + lane; u32x2* o8 = (u32x2*)xn + lane;
#pragma unroll
        for (int j = 0; j < 16; ++j) { const f32x4 gv = gr[64 * j]; u32x2 w; w.x = cvt_pk_bf16(y[j].x * rstd2 * gv.x, y[j].y * rstd2 * gv.y); w.y = cvt_pk_bf16(y[j].z * rstd2 * gv.z, y[j].w * rstd2 * gv.w); o8[64 * j] = w; }
    }
}
__device__ __forceinline__ void unpack8(const u32x4 w, float (&f)[8]) { f[0] = bf_lo(w.x); f[1] = bf_hi(w.x); f[2] = bf_lo(w.y); f[3] = bf_hi(w.y); f[4] = bf_lo(w.z); f[5] = bf_hi(w.z); f[6] = bf_lo(w.w); f[7] = bf_hi(w.w); }
__device__ __forceinline__ u32x4 pack8f(const float (&f)[8]) { u32x4 w; w.x = cvt_pk_bf16(f[0], f[1]); w.y = cvt_pk_bf16(f[2], f[3]); w.z = cvt_pk_bf16(f[4], f[5]); w.w = cvt_pk_bf16(f[6], f[7]); return w; }

__device__ __forceinline__ void conv_gate_phase(const bf16_t* H, const float* cw  , bf16_t* A2  , int gtid, int nthreads) {
    constexpr int RB = 32, NCG = CW / 8, NIT = (SEQ / RB) * NCG;
    asm volatile("" : "+v"(gtid));
    for (int it = gtid; it < NIT; it += nthreads) {
        const int cg = it % NCG, rb = it / NCG, c0 = cg * 8, t0 = rb * RB;
        float w0[8], w1[8], w2[8], m2[8], m1[8];
#pragma unroll
        for (int i = 0; i < 8; ++i) { w0[i] = cw[c0 + i]; w1[i] = cw[CW + c0 + i]; w2[i] = cw[2 * CW + c0 + i]; m2[i] = 0.f; m1[i] = 0.f; }
        if (t0 >= 2) {
            float a[8], b[8];
            unpack8(*(const u32x4*)(H + (size_t)(t0 - 2) * N_CI + CW + c0), a); unpack8(*(const u32x4*)(H + (size_t)(t0 - 2) * N_CI + 2 * CW + c0), b);
#pragma unroll
            for (int i = 0; i < 8; ++i) m2[i] = a[i] * b[i];
            unpack8(*(const u32x4*)(H + (size_t)(t0 - 1) * N_CI + CW + c0), a); unpack8(*(const u32x4*)(H + (size_t)(t0 - 1) * N_CI + 2 * CW + c0), b);
#pragma unroll
            for (int i = 0; i < 8; ++i) m1[i] = a[i] * b[i];
        }
#pragma unroll 4
        for (int r = 0; r < RB; ++r) {
            const bf16_t* hr = H + (size_t)(t0 + r) * N_CI + c0;
            float bg[8], cgt[8], uu[8], o[8];
            unpack8(*(const u32x4*)(hr), bg); unpack8(*(const u32x4*)(hr + CW), cgt); unpack8(*(const u32x4*)(hr + 2 * CW), uu);
#pragma unroll
            for (int i = 0; i < 8; ++i) { const float cu = cgt[i] * uu[i]; o[i] = bg[i] * (w0[i] * m2[i] + w1[i] * m1[i] + w2[i] * cu); m2[i] = m1[i]; m1[i] = cu; }
            *(u32x4*)(A2 + (size_t)(t0 + r) * K_CO + c0) = pack8f(o);
        }
    }
}
__device__ __forceinline__ void ffn_fix_phase(const float* HALOG, const float* FIRSTG, const float* FIRSTU, const float* cw, bf16_t* ACT, int gtid, int nthreads) {
    constexpr int NC4 = DFF / 4, NIT = 31 * NC4;
    asm volatile("" : "+v"(gtid));
    for (int it = gtid; it < NIT; it += nthreads) {
        const int pm = 1 + it / NC4, c = (it % NC4) * 4;
        const f32x4 gm2 = *(const f32x4*)(HALOG + (size_t)((pm - 1) * 2 + 0) * DFF + c), gm1 = *(const f32x4*)(HALOG + (size_t)((pm - 1) * 2 + 1) * DFF + c);
        const f32x4 g0 = *(const f32x4*)(FIRSTG + (size_t)(pm * 2 + 0) * DFF + c), g1 = *(const f32x4*)(FIRSTG + (size_t)(pm * 2 + 1) * DFF + c);
        const f32x4 u0 = *(const f32x4*)(FIRSTU + (size_t)(pm * 2 + 0) * DFF + c), u1 = *(const f32x4*)(FIRSTU + (size_t)(pm * 2 + 1) * DFF + c);
        const f32x4 w0 = *(const f32x4*)(cw + c), w1 = *(const f32x4*)(cw + DFF + c), w2 = *(const f32x4*)(cw + 2 * DFF + c);
        float o0[4], o1[4];
#pragma unroll
        for (int i = 0; i < 4; ++i) { const float a = w0[i] * gm2[i] + w1[i] * gm1[i] + w2[i] * g0[i], b = w0[i] * gm1[i] + w1[i] * g0[i] + w2[i] * g1[i];
            o0[i] = a / (1.0f + __expf(-a)) * u0[i]; o1[i] = b / (1.0f + __expf(-b)) * u1[i]; }
        u32x2 w; w.x = cvt_pk_bf16(o0[0], o0[1]); w.y = cvt_pk_bf16(o0[2], o0[3]); *(u32x2*)(ACT + (size_t)(256 * pm) * DFF + c) = w;
        w.x = cvt_pk_bf16(o1[0], o1[1]); w.y = cvt_pk_bf16(o1[2], o1[3]); *(u32x2*)(ACT + (size_t)(256 * pm + 1) * DFF + c) = w;
    }
}
__device__ __forceinline__ void merge_phase(const bf16_t* OG  , const float* LSE  , bf16_t* A2  , int gtid, int nthreads) {
    constexpr int NIT = SEQ * (GW / 8);
    asm volatile("" : "+v"(gtid));
    for (int it = gtid; it < NIT; it += nthreads) {
        const int ch = it % (GW / 8), t = it / (GW / 8), hd = ch >> 4, d8 = (ch & 15) * 8;
        const int r0 = t, r1 = (t & 3) * (SEQ / 4) + (t >> 2), r2 = (t & 15) * (SEQ / 16) + (t >> 4);
        const float l0 = LSE[(size_t)(0 * 16 + hd) * SEQ + r0], l1 = LSE[(size_t)(1 * 16 + hd) * SEQ + r1], l2 = LSE[(size_t)(2 * 16 + hd) * SEQ + r2];
        const float mx = fmaxf(l0, fmaxf(l1, l2));
        const float e0 = __expf(l0 - mx), e1 = __expf(l1 - mx), e2 = __expf(l2 - mx), inv = 1.0f / (e0 + e1 + e2);
        float a[8], b[8], c[8], o[8];
        unpack8(*(const u32x4*)(OG + ((size_t)(0 * 16 + hd) * SEQ + r0) * HDIM + d8), a); unpack8(*(const u32x4*)(OG + ((size_t)(1 * 16 + hd) * SEQ + r1) * HDIM + d8), b); unpack8(*(const u32x4*)(OG + ((size_t)(2 * 16 + hd) * SEQ + r2) * HDIM + d8), c);
#pragma unroll
        for (int i = 0; i < 8; ++i) o[i] = (e0 * a[i] + e1 * b[i] + e2 * c[i]) * inv;
        *(u32x4*)(A2 + (size_t)t * K_AO + ch * 8) = pack8f(o);
    }
}

template <int HD, int STR>
__device__ __forceinline__ void attn_load_tile(LAS unsigned char* dst, const bf16_t* src, long stride, int valid_from, int tid) {
    constexpr int CPR = HD / 8, PER = 256 * CPR / 512;
    u32x4 v[PER];
#pragma unroll
    for (int j = 0; j < PER; ++j) { const int idx = tid + 512 * j, row = idx / CPR, ch = idx % CPR;
        v[j] = (u32x4){0u, 0u, 0u, 0u}; if (row >= valid_from) v[j] = *(const u32x4*)(src + (long)row * stride + ch * 8); }
#pragma unroll
    for (int j = 0; j < PER; ++j) { const int idx = tid + 512 * j, row = idx / CPR, ch = idx % CPR; *(LAS u32x4*)(dst + row * STR + ch * 16) = v[j]; }
}
template <int HD, int NT, bool DIL>
__device__ __forceinline__ void attn_unit(LAS unsigned char* lds, const bf16_t* Qp, long qstride, const bf16_t* Kp, const bf16_t* Vp, long kvstride, int valid_from,
                                          bf16_t* Op, long ostride, float* lsep, float scale) {
    constexpr int KSTR = HD * 2 + 16, VSTR = HD * 2 + 32, NC = (NT + 1) / 2, NDT = HD / 16, NQC = HD / 32;
    constexpr bool BOTH = (256 * KSTR + 256 * VSTR) <= LDSCTL_OFF;
    const int tid = fresh_tid(), w = __builtin_amdgcn_readfirstlane(tid >> 6), lane = tid & 63, lq = lane & 15, g4 = lane >> 4;
    LAS unsigned char* Kl = lds; LAS unsigned char* Vl = BOTH ? lds + 256 * KSTR : lds;
    __syncthreads();
    attn_load_tile<HD, KSTR>(Kl, Kp, kvstride, valid_from, tid);
    if (BOTH) attn_load_tile<HD, VSTR>(Vl, Vp, kvstride, valid_from, tid);
    bf16x8 qf[NQC];
#pragma unroll
    for (int c = 0; c < NQC; ++c) qf[c] = *(const bf16x8*)(Qp + (long)(16 * w + lq) * qstride + 32 * c + 8 * g4);
    __syncthreads();
    const int jt0 = DIL ? w : 0;
    f32x4 s[NT];
#pragma unroll
    for (int j = 0; j < NT; ++j) { s[j] = (f32x4){0.f, 0.f, 0.f, 0.f}; const LAS unsigned char* kr = Kl + (16 * (jt0 + j) + lq) * KSTR + 16 * g4;
#pragma unroll
        for (int c = 0; c < NQC; ++c) { const bf16x8 kf = *(const LAS bf16x8*)(kr + 64 * c); s[j] = __builtin_amdgcn_mfma_f32_16x16x32_bf16(kf, qf[c], s[j], 0, 0, 0); } }
    if (!BOTH) { __syncthreads(); attn_load_tile<HD, VSTR>(Vl, Vp, kvstride, valid_from, tid); }
    const float NEG = -__builtin_inff();
    float mx = NEG;
    const int qi = 16 * w + lq;
#pragma unroll
    for (int j = 0; j < NT; ++j)
#pragma unroll
        for (int e = 0; e < 4; ++e) { if (DIL) { const int kr = 16 * (jt0 + j) + 4 * g4 + e; const bool ok = (kr >= qi) && (kr <= qi + 128) && (kr >= valid_from); s[j][e] = ok ? s[j][e] : NEG; } mx = fmaxf(mx, s[j][e]); }
    mx = fmaxf(mx, __shfl_xor(mx, 16)); mx = fmaxf(mx, __shfl_xor(mx, 32));
    const float c2 = scale * 1.4426950408889634f, mb = -mx * c2; float sum = 0.f;
#pragma unroll
    for (int j = 0; j < NT; ++j)
#pragma unroll
        for (int e = 0; e < 4; ++e) { const float p = __builtin_amdgcn_exp2f(fmaf(s[j][e], c2, mb)); s[j][e] = p; sum += p; }
    sum += __shfl_xor(sum, 16); sum += __shfl_xor(sum, 32);
    const float inv = 1.0f / sum;
    bf16x8 pf[NC];
#pragma unroll
    for (int cc = 0; cc < NC; ++cc) { u32x4 wv; wv.x = cvt_pk_bf16(s[2 * cc][0], s[2 * cc][1]); wv.y = cvt_pk_bf16(s[2 * cc][2], s[2 * cc][3]);
        if (2 * cc + 1 < NT) { wv.z = cvt_pk_bf16(s[(2 * cc + 1) % NT][0], s[(2 * cc + 1) % NT][1]); wv.w = cvt_pk_bf16(s[(2 * cc + 1) % NT][2], s[(2 * cc + 1) % NT][3]); } else { wv.z = 0u; wv.w = 0u; }
        pf[cc] = __builtin_bit_cast(bf16x8, wv); }
    if (!BOTH) __syncthreads();
    f32x4 o[NDT];
#pragma unroll
    for (int dt = 0; dt < NDT; ++dt) o[dt] = (f32x4){0.f, 0.f, 0.f, 0.f};
    const unsigned vbase = (unsigned)(size_t)Vl + (unsigned)((16 * jt0 + 4 * g4 + (lq >> 2)) * VSTR + (lq & 3) * 8);
#pragma unroll
    for (int cc = 0; cc < NC; ++cc) {
        const unsigned va = vbase + (unsigned)(cc * 32 * VSTR);
        constexpr int T1OFF = 16 * VSTR;
        const bool has1 = (2 * cc + 1 < NT);
#pragma unroll
        for (int d4 = 0; d4 < NDT; d4 += 4) {
            s16x4 a0, a1, a2, a3, b0, b1, b2, b3;
#define TRRD(dst, addr, off) asm volatile("ds_read_b64_tr_b16 %0, %1 offset:%2" : "=&v"(dst) : "v"(addr), "i"(off) : "memory")
            if (has1) {
                TRRD(a0, va, (d4 + 0) * 32); TRRD(b0, va, (d4 + 0) * 32 + T1OFF); TRRD(a1, va, (d4 + 1) * 32); TRRD(b1, va, (d4 + 1) * 32 + T1OFF);
                TRRD(a2, va, (d4 + 2) * 32); TRRD(b2, va, (d4 + 2) * 32 + T1OFF); TRRD(a3, va, (d4 + 3) * 32); TRRD(b3, va, (d4 + 3) * 32 + T1OFF);
            } else {
                TRRD(a0, va, (d4 + 0) * 32); TRRD(b0, va, (d4 + 0) * 32); TRRD(a1, va, (d4 + 1) * 32); TRRD(b1, va, (d4 + 1) * 32);
                TRRD(a2, va, (d4 + 2) * 32); TRRD(b2, va, (d4 + 2) * 32); TRRD(a3, va, (d4 + 3) * 32); TRRD(b3, va, (d4 + 3) * 32);
            }
#undef TRRD
            asm volatile("s_waitcnt lgkmcnt(0)" ::: "memory"); __builtin_amdgcn_sched_barrier(0);
            o[d4 + 0] = __builtin_amdgcn_mfma_f32_16x16x32_bf16((bf16x8){a0[0], a0[1], a0[2], a0[3], b0[0], b0[1], b0[2], b0[3]}, pf[cc], o[d4 + 0], 0, 0, 0);
            o[d4 + 1] = __builtin_amdgcn_mfma_f32_16x16x32_bf16((bf16x8){a1[0], a1[1], a1[2], a1[3], b1[0], b1[1], b1[2], b1[3]}, pf[cc], o[d4 + 1], 0, 0, 0);
            o[d4 + 2] = __builtin_amdgcn_mfma_f32_16x16x32_bf16((bf16x8){a2[0], a2[1], a2[2], a2[3], b2[0], b2[1], b2[2], b2[3]}, pf[cc], o[d4 + 2], 0, 0, 0);
            o[d4 + 3] = __builtin_amdgcn_mfma_f32_16x16x32_bf16((bf16x8){a3[0], a3[1], a3[2], a3[3], b3[0], b3[1], b3[2], b3[3]}, pf[cc], o[d4 + 3], 0, 0, 0);
        }
    }
    bf16_t* orow = Op + (long)qi * ostride + 4 * g4;
#pragma unroll
    for (int dt = 0; dt < NDT; ++dt) { u32x2 wv; wv.x = cvt_pk_bf16(o[dt][0] * inv, o[dt][1] * inv); wv.y = cvt_pk_bf16(o[dt][2] * inv, o[dt][3] * inv); *(u32x2*)(orow + 16 * dt) = wv; }
    if (lsep && g4 == 0) lsep[qi] = mx * scale + __logf(sum);
}


__device__ __forceinline__ void attn_dil_unit(LAS unsigned char* lds, const bf16_t* Qs, const bf16_t* Ks, const bf16_t* Vs, int valid_from, bf16_t* Os, float* lsep, float scale) {
    constexpr int NT = 9, NC = 5, NDT = 8;
    const int tid = fresh_tid(), w = __builtin_amdgcn_readfirstlane(tid >> 6), lane = tid & 63, lq = lane & 15, g4 = lane >> 4;
    LAS unsigned char* Kl = lds; LAS unsigned char* Vl = lds + 65536;
    __syncthreads();
#pragma unroll
    for (int i = 0; i < 8; ++i) { const int row = 32 * w + 4 * i + g4;
        __builtin_amdgcn_global_load_lds((const unsigned*)(Ks + (size_t)row * HDIM + ((lq ^ (row & 15)) << 3)), (LAS unsigned*)(Kl + (w * 8 + i) * 1024), 16, 0, 0);
        __builtin_amdgcn_global_load_lds((const unsigned*)(Vs + (size_t)row * HDIM + ((lq ^ ((row & 7) << 1)) << 3)), (LAS unsigned*)(Vl + (w * 8 + i) * 1024), 16, 0, 0); }
    bf16x8 qf[4];
#pragma unroll
    for (int c = 0; c < 4; ++c) qf[c] = *(const bf16x8*)(Qs + (size_t)(16 * w + lq) * HDIM + 32 * c + 8 * g4);
    asm volatile("s_waitcnt vmcnt(0)" ::: "memory");
    __syncthreads();
    f32x4 s[NT];
    { unsigned ko[4];
#pragma unroll
      for (int c = 0; c < 4; ++c) ko[c] = (unsigned)(((4 * c + g4) ^ lq) << 4);
      const LAS unsigned char* kb = Kl + (16 * w + lq) * 256;
#pragma unroll
      for (int j = 0; j < NT; ++j) { s[j] = (f32x4){0.f, 0.f, 0.f, 0.f};
#pragma unroll
        for (int c = 0; c < 4; ++c) { const bf16x8 kf = *(const LAS bf16x8*)(kb + j * 4096 + ko[c]); s[j] = __builtin_amdgcn_mfma_f32_16x16x32_bf16(kf, qf[c], s[j], 0, 0, 0); } } }
    const float NEG = -__builtin_inff();
    float mx = NEG;
    const int qi = 16 * w + lq;
#pragma unroll
    for (int j = 0; j < NT; ++j)
#pragma unroll
        for (int e = 0; e < 4; ++e) { const int kr = 16 * (w + j) + 4 * g4 + e; const bool ok = (kr >= qi) && (kr <= qi + 128) && (kr >= valid_from); s[j][e] = ok ? s[j][e] : NEG; mx = fmaxf(mx, s[j][e]); }
    mx = fmaxf(mx, __shfl_xor(mx, 16)); mx = fmaxf(mx, __shfl_xor(mx, 32));
    const float c2 = scale * 1.4426950408889634f, mb = -mx * c2; float sum = 0.f;
#pragma unroll
    for (int j = 0; j < NT; ++j)
#pragma unroll
        for (int e = 0; e < 4; ++e) { const float p = __builtin_amdgcn_exp2f(fmaf(s[j][e], c2, mb)); s[j][e] = p; sum += p; }
    sum += __shfl_xor(sum, 16); sum += __shfl_xor(sum, 32);
    const float inv = 1.0f / sum;
    bf16x8 pf[NC];
#pragma unroll
    for (int cc = 0; cc < NC; ++cc) { u32x4 wv; wv.x = cvt_pk_bf16(s[2 * cc][0], s[2 * cc][1]); wv.y = cvt_pk_bf16(s[2 * cc][2], s[2 * cc][3]);
        if (2 * cc + 1 < NT) { wv.z = cvt_pk_bf16(s[(2 * cc + 1) % NT][0], s[(2 * cc + 1) % NT][1]); wv.w = cvt_pk_bf16(s[(2 * cc + 1) % NT][2], s[(2 * cc + 1) % NT][3]); } else { wv.z = 0u; wv.w = 0u; }
        pf[cc] = __builtin_bit_cast(bf16x8, wv); }
    f32x4 o[NDT];
#pragma unroll
    for (int dt = 0; dt < NDT; ++dt) o[dt] = (f32x4){0.f, 0.f, 0.f, 0.f};
    const int q4 = lq >> 2, p4 = lq & 3, kx = ((4 * g4 + q4) & 7) << 5;
    const unsigned vb = (unsigned)(size_t)Vl + (unsigned)((16 * w + 4 * g4 + q4) * 256 + ((p4 >> 1) << 4) + ((p4 & 1) << 3));
    unsigned va[NDT];
#pragma unroll
    for (int dt = 0; dt < NDT; ++dt) va[dt] = vb + (unsigned)((dt << 5) ^ kx);
#define TRRD(dst, addr, off) asm volatile("ds_read_b64_tr_b16 %0, %1 offset:%2" : "=&v"(dst) : "v"(addr), "i"(off) : "memory")
#pragma unroll
    for (int cc = 0; cc < NC; ++cc) {
        const int o0 = cc * 32 * 256, o1 = (2 * cc + 1 < NT) ? o0 + 16 * 256 : o0;
#pragma unroll
        for (int d4 = 0; d4 < NDT; d4 += 4) {
            s16x4 a0, a1, a2, a3, b0, b1, b2, b3;
            if (cc == 0) { TRRD(a0, va[d4 + 0], 0 * 8192); TRRD(b0, va[d4 + 0], 0 * 8192 + 4096); TRRD(a1, va[d4 + 1], 0 * 8192); TRRD(b1, va[d4 + 1], 0 * 8192 + 4096); TRRD(a2, va[d4 + 2], 0 * 8192); TRRD(b2, va[d4 + 2], 0 * 8192 + 4096); TRRD(a3, va[d4 + 3], 0 * 8192); TRRD(b3, va[d4 + 3], 0 * 8192 + 4096); }
            if (cc == 1) { TRRD(a0, va[d4 + 0], 1 * 8192); TRRD(b0, va[d4 + 0], 1 * 8192 + 4096); TRRD(a1, va[d4 + 1], 1 * 8192); TRRD(b1, va[d4 + 1], 1 * 8192 + 4096); TRRD(a2, va[d4 + 2], 1 * 8192); TRRD(b2, va[d4 + 2], 1 * 8192 + 4096); TRRD(a3, va[d4 + 3], 1 * 8192); TRRD(b3, va[d4 + 3], 1 * 8192 + 4096); }
            if (cc == 2) { TRRD(a0, va[d4 + 0], 2 * 8192); TRRD(b0, va[d4 + 0], 2 * 8192 + 4096); TRRD(a1, va[d4 + 1], 2 * 8192); TRRD(b1, va[d4 + 1], 2 * 8192 + 4096); TRRD(a2, va[d4 + 2], 2 * 8192); TRRD(b2, va[d4 + 2], 2 * 8192 + 4096); TRRD(a3, va[d4 + 3], 2 * 8192); TRRD(b3, va[d4 + 3], 2 * 8192 + 4096); }
            if (cc == 3) { TRRD(a0, va[d4 + 0], 3 * 8192); TRRD(b0, va[d4 + 0], 3 * 8192 + 4096); TRRD(a1, va[d4 + 1], 3 * 8192); TRRD(b1, va[d4 + 1], 3 * 8192 + 4096); TRRD(a2, va[d4 + 2], 3 * 8192); TRRD(b2, va[d4 + 2], 3 * 8192 + 4096); TRRD(a3, va[d4 + 3], 3 * 8192); TRRD(b3, va[d4 + 3], 3 * 8192 + 4096); }
            if (cc == 4) { TRRD(a0, va[d4 + 0], 4 * 8192); TRRD(b0, va[d4 + 0], 4 * 8192); TRRD(a1, va[d4 + 1], 4 * 8192); TRRD(b1, va[d4 + 1], 4 * 8192); TRRD(a2, va[d4 + 2], 4 * 8192); TRRD(b2, va[d4 + 2], 4 * 8192); TRRD(a3, va[d4 + 3], 4 * 8192); TRRD(b3, va[d4 + 3], 4 * 8192); }
            (void)o0; (void)o1;
            asm volatile("s_waitcnt lgkmcnt(0)" ::: "memory"); __builtin_amdgcn_sched_barrier(0);
            o[d4 + 0] = __builtin_amdgcn_mfma_f32_16x16x32_bf16((bf16x8){a0[0], a0[1], a0[2], a0[3], b0[0], b0[1], b0[2], b0[3]}, pf[cc], o[d4 + 0], 0, 0, 0);
            o[d4 + 1] = __builtin_amdgcn_mfma_f32_16x16x32_bf16((bf16x8){a1[0], a1[1], a1[2], a1[3], b1[0], b1[1], b1[2], b1[3]}, pf[cc], o[d4 + 1], 0, 0, 0);
            o[d4 + 2] = __builtin_amdgcn_mfma_f32_16x16x32_bf16((bf16x8){a2[0], a2[1], a2[2], a2[3], b2[0], b2[1], b2[2], b2[3]}, pf[cc], o[d4 + 2], 0, 0, 0);
            o[d4 + 3] = __builtin_amdgcn_mfma_f32_16x16x32_bf16((bf16x8){a3[0], a3[1], a3[2], a3[3], b3[0], b3[1], b3[2], b3[3]}, pf[cc], o[d4 + 3], 0, 0, 0);
        }
    }
#undef TRRD
    bf16_t* orow = Os + (size_t)qi * HDIM + 4 * g4;
#pragma unroll
    for (int dt = 0; dt < NDT; ++dt) { u32x2 wv; wv.x = cvt_pk_bf16(o[dt][0] * inv, o[dt][1] * inv); wv.y = cvt_pk_bf16(o[dt][2] * inv, o[dt][3] * inv); *(u32x2*)(orow + 16 * dt) = wv; }
    if (g4 == 0) lsep[qi] = mx * scale + __logf(sum);
}

struct Args {
    const float* x; const float* mem; const int* pos; const float* g_mem; const float* w_mem_kv; const float* g_mix_pre; const float* g_mix_post; const float* g_ffn_pre; const float* g_ffn_post;
    const float* w_conv_in; const float* conv_mix_w; const float* w_conv_out; const float* w_attn_in; const float* w_attn_out; const float* w_ffn_gate; const float* w_ffn_up; const float* conv_ffn_w; const float* w_ffn_down;
    float* out; unsigned char* ws; int ph_lo, ph_hi;
};

__global__ void __launch_bounds__(512, 2) fwd_kernel(Args a) {
    extern __shared__ __attribute__((aligned(16))) unsigned char lds_raw[];
    LAS unsigned char* lds = (LAS unsigned char*)lds_raw;
    volatile LAS unsigned* MISC = (volatile LAS unsigned*)(lds + LDSCTL_OFF);
    const int tid = threadIdx.x, lane = tid & 63, wave = __builtin_amdgcn_readfirstlane(tid >> 6);
    const int G = gridDim.x, bx = blockIdx.x;
    const int gtid = bx * 512 + tid, nthreads = G * 512, gw = bx * 8 + wave, ngw = G * 8;
    unsigned char* ws = a.ws;
    unsigned* ctl = (unsigned*)(ws + WS_CTL);
    bf16_t* WKV = (bf16_t*)(ws + WS_WKV); bf16_t* WCI = (bf16_t*)(ws + WS_WCI); bf16_t* WCO = (bf16_t*)(ws + WS_WCO); bf16_t* WAI = (bf16_t*)(ws + WS_WAI); bf16_t* WAO = (bf16_t*)(ws + WS_WAO);
    bf16_t* WGU = (bf16_t*)(ws + WS_WGU); bf16_t* WD = (bf16_t*)(ws + WS_WD);
    bf16_t* XN = (bf16_t*)(ws + WS_XN); bf16_t* H = (bf16_t*)(ws + WS_R); bf16_t* GU = (bf16_t*)(ws + WS_R); bf16_t* Y = (bf16_t*)(ws + WS_R);
    bf16_t* QKVL = (bf16_t*)(ws + WS_R); bf16_t* QM = (bf16_t*)(ws + WS_R + 288 * MiB);
    bf16_t* ACT = (bf16_t*)(ws + WS_S); bf16_t* A2 = (bf16_t*)(ws + WS_S); bf16_t* OG = (bf16_t*)(ws + WS_S + 64 * MiB);
    bf16_t* MEMN = (bf16_t*)(ws + WS_MEMN); bf16_t* KV = (bf16_t*)(ws + WS_KV); float* COS = (float*)(ws + WS_COS); float* SIN = (float*)(ws + WS_SIN); float* LSE = (float*)(ws + WS_LSE);
    bf16_t* XRES = (bf16_t*)(ws + WS_XRES);
    float* HALOG = (float*)(ws + WS_HALOG); float* FIRSTG = (float*)(ws + WS_FIRSTG); float* FIRSTU = (float*)(ws + WS_FIRSTU);

    for (int u = tid; u < (LDS_BYTES - LDSCTL_OFF) / 4; u += 512) ((LAS unsigned*)(lds + LDSCTL_OFF))[u] = 0u;
    __syncthreads();
    XcdBarrier bar; bar.bar = ctl + CW_BAR; bar.x = 0; bar.st = nullptr;
    if (ONE_LAUNCH) bar = xcd_barrier_post(ctl + CW_BAR, MISC + 8);
    const int lo = a.ph_lo, hi = a.ph_hi;
#define IN(k) (lo <= (k) && (k) < hi)
#define SEAM(k) do { if (IN(k) && IN((k) + 1)) xcd_barrier(bar); } while (0)
    constexpr size_t SZ_GU = (size_t)N_GU * DM, SZ_D = (size_t)DM * DFF;

    if (IN(0)) {
        LAS float* scr = (LAS float*)(lds + wave * 16384);
        cvt_matrix<0>(a.w_mem_kv, DM, 2 * MW, WKV, 0, scr, gw, ngw, lane);
        for (int m = gw; m < NMEM; m += ngw) rms_row_to_bf16(a.mem + (size_t)m * DM, a.g_mem, MEMN + (size_t)m * DM, lane);
        for (int m = gw; m < SEQ; m += ngw) rms_row_to_bf16(a.x + (size_t)m * DM, a.g_mix_pre, XN + (size_t)m * DM, lane);
        for (int idx = gtid; idx < SEQ * 64; idx += nthreads) { const int t = idx >> 6, i = idx & 63;
            const float ang = (float)a.pos[t] * INV_FREQ[i];
            const double kq = rint((double)ang * 0.15915494309189535); double r = fma(-kq, 6.283185307179586, (double)ang); r = fma(-kq, 2.4492935982947064e-16, r);
            const float rf = (float)r; COS[idx] = cosf(rf); SIN[idx] = sinf(rf); }
    }
    SEAM(0);
    if (IN(1)) {
        if (bx < 8) {
            pg8::Gemm g{MEMN, WKV, DM, DM, DM}; pg8::StaticOrder S; S.init(NMEM, 2 * MW, 8, bx);
            pg8::EpiStore E{KV, 2 * MW};
            pg8::gemm_phase<pg8::EpiStore, pg8::StaticOrder, true>(lds, g, S, E);
        } else {
            LAS float* scr = (LAS float*)(lds + wave * 16384);
            const int cw_ = (bx - 8) * 8 + wave, ncw = (G - 8) * 8;
            cvt_matrix<0>(a.w_conv_in, DM, N_CI, WCI, 0, scr, cw_, ncw, lane);
            cvt_matrix<0>(a.w_conv_out, K_CO, DM, WCO, 0, scr, cw_, ncw, lane);
            cvt_matrix<2>(a.w_ffn_gate, DM, DFF, WGU, 0, scr, cw_, ncw, lane);
            cvt_matrix<3>(a.w_ffn_up, DM, DFF, WGU, 0, scr, cw_, ncw, lane);
            cvt_matrix<0>(a.w_ffn_down, DFF, DM, WD, 0, scr, cw_, ncw, lane);
            cvt_matrix<1>(a.w_attn_in, DM, N_AI, WAI, 0, scr, cw_, ncw, lane);
            cvt_matrix<0>(a.w_attn_out, K_AO, DM, WAO, 0, scr, cw_, ncw, lane);
            cvt_matrix<2>(a.w_ffn_gate + SZ_D, DM, DFF, WGU + SZ_GU, 0, scr, cw_, ncw, lane, D10_GATE1, 64);
            cvt_matrix<3>(a.w_ffn_up + SZ_D, DM, DFF, WGU + SZ_GU, 0, scr, cw_, ncw, lane, D10_UP1_HI, 64);
            cvt_matrix<0>(a.w_ffn_down + SZ_D, DFF, DM, WD + SZ_D, 0, scr, cw_, ncw, lane, D15_WD1_HI, 172);
        }
    }
    SEAM(1);
    if (IN(2)) {
        pg8::Gemm g{XN, WCI, DM, DM, DM}; pg8::StaticOrder S; S.init(SEQ, N_CI, G, bx);
        pg8::EpiStore E{H, N_CI};
        pg8::gemm_phase<pg8::EpiStore, pg8::StaticOrder, true>(lds, g, S, E);
    }
    SEAM(2);
    if (IN(3)) {
        for (int u = bx; u < 4 * (SEQ / 128); u += G) { const int hd = u / (SEQ / 128), qb = u % (SEQ / 128);
            attn_unit<256, 16, false>(lds, H + (size_t)(128 * qb) * N_CI + 3 * CW + 256 * hd, N_CI, KV + 256 * hd, KV + MW + 256 * hd, 2 * MW, 0,
                                      A2 + (size_t)(128 * qb) * K_CO + CW + 256 * hd, K_CO, nullptr, 0.0625f); }
        conv_gate_phase(H, a.conv_mix_w, A2, gtid, nthreads);
    }
    SEAM(3);
    if (IN(4)) {
        pg8::Gemm g{A2, WCO, K_CO, K_CO, K_CO}; pg8::StaticOrder S; S.init(SEQ, DM, G, bx);
        pg8::EpiStore E{Y, DM};
        pg8::gemm_phase<pg8::EpiStore, pg8::StaticOrder, true>(lds, g, S, E);
    }
    SEAM(4);
    if (IN(5)) { for (int m = gw; m < SEQ; m += ngw) norm_res_row<true, false, true>(a.x + (size_t)m * DM, Y + (size_t)m * DM, a.g_mix_post, a.g_ffn_pre, XRES + (size_t)m * DM, XN + (size_t)m * DM); }
    SEAM(5);
    if (IN(6)) {
        pg8::Gemm g{XN, WGU, DM, DM, DM}; pg8::StaticOrder S; S.init(SEQ, N_GU, G, bx);
        pg8::EpiFfn E{ACT, a.conv_ffn_w, HALOG, FIRSTG, FIRSTU, lds + RING_BYTES};
        pg8::gemm_phase<pg8::EpiFfn, pg8::StaticOrder, true>(lds, g, S, E);
        if (DEFER && bx >= 192) cvt_matrix2<0>(a.w_ffn_down + SZ_D, DFF, DM, WD + SZ_D, lds + wave * 9216, (bx - 192) * 8 + wave, (G - 192) * 8, 0, D6_WD1_HI);
    }
    SEAM(6);
    if (IN(7)) ffn_fix_phase(HALOG, FIRSTG, FIRSTU, a.conv_ffn_w, ACT, gtid, nthreads);
    SEAM(7);
    if (IN(8)) {
        pg8::Gemm g{ACT, WD, DFF, DFF, DFF}; pg8::StaticOrder S; S.init(SEQ, DM, G, bx);
        pg8::EpiStore E{Y, DM};
        pg8::gemm_phase<pg8::EpiStore, pg8::StaticOrder, true>(lds, g, S, E);
    }
    SEAM(8);
    if (IN(9)) { for (int m = gw; m < SEQ; m += ngw) norm_res_row<false, false, true>(XRES + (size_t)m * DM, Y + (size_t)m * DM, a.g_ffn_post, a.g_mix_pre + DM, XRES + (size_t)m * DM, XN + (size_t)m * DM); }
    SEAM(9);
    if (IN(10)) {
        pg8::Gemm g{XN, WAI, DM, DM, DM}; pg8::StaticOrder S; S.init(SEQ, N_AI, G, bx);
        pg8::EpiQKV E{QKVL, QM, COS, SIN};
        pg8::gemm_phase<pg8::EpiQKV, pg8::StaticOrder, true>(lds, g, S, E);
        if (DEFER && bx >= 128) { cvt_matrix2<2>(a.w_ffn_gate + SZ_D, DM, DFF, WGU + SZ_GU, lds + wave * 9216, (bx - 128) * 8 + wave, (G - 128) * 8, 0, D10_GATE1);
                                  cvt_matrix2<3>(a.w_ffn_up + SZ_D, DM, DFF, WGU + SZ_GU, lds + wave * 9216, (bx - 128) * 8 + wave, (G - 128) * 8, 0, D10_UP1_HI); }
    }
    SEAM(10);
    if (IN(11)) {
        const int per = (3 * 16 * 64 + G - 1) / G;
        for (int k = 0; k < per; ++k) {
            const int u = bx * per + k; if (u >= 3 * 16 * 64) break;
            const int grp = u >> 10, rem = u & 1023, hd = rem >> 6, blk = rem & 63;
            const int dsh = 2 * grp, nbr = 64 >> dsh, r = blk / nbr, nb = blk % nbr;
            const size_t rowq = (size_t)r * (SEQ >> dsh) + 128 * nb;
            const bf16_t* qs = QKVL + ((size_t)((grp * 3 + 0) * NHEAD + hd) * SEQ + rowq) * HDIM;
            const bf16_t* ks = QKVL + ((size_t)((grp * 3 + 1) * NHEAD + hd) * SEQ + rowq) * HDIM - 128 * HDIM;
            const bf16_t* vs = QKVL + ((size_t)((grp * 3 + 2) * NHEAD + hd) * SEQ + rowq) * HDIM - 128 * HDIM;
            attn_dil_unit(lds, qs, ks, vs, nb == 0 ? 128 : 0, OG + ((size_t)(grp * NHEAD + hd) * SEQ + rowq) * HDIM, LSE + (size_t)(grp * NHEAD + hd) * SEQ + rowq, 0.08838834764831845f);
        }
        for (int u = bx; u < 4 * (SEQ / 128); u += G) { const int hd = u / (SEQ / 128), qb = u % (SEQ / 128);
            attn_unit<256, 16, false>(lds, QM + (size_t)(128 * qb) * MW + 256 * hd, MW, KV + 256 * hd, KV + MW + 256 * hd, 2 * MW, 0,
                                      A2 + (size_t)(128 * qb) * K_AO + GW + 256 * hd, K_AO, nullptr, 0.0625f); }
    }
    SEAM(11);
    if (IN(12)) merge_phase(OG, LSE, A2, gtid, nthreads);
    SEAM(12);
    if (IN(13)) {
        pg8::Gemm g{A2, WAO, K_AO, K_AO, K_AO}; pg8::StaticOrder S; S.init(SEQ, DM, G, bx);
        pg8::EpiStore E{Y, DM};
        pg8::gemm_phase<pg8::EpiStore, pg8::StaticOrder, true>(lds, g, S, E);
    }
    SEAM(13);
    if (IN(14)) { for (int m = gw; m < SEQ; m += ngw) norm_res_row<false, false, true>(XRES + (size_t)m * DM, Y + (size_t)m * DM, a.g_mix_post + DM, a.g_ffn_pre + DM, XRES + (size_t)m * DM, XN + (size_t)m * DM); }
    SEAM(14);
    if (IN(15)) {
        pg8::Gemm g{XN, WGU + SZ_GU, DM, DM, DM}; pg8::StaticOrder S; S.init(SEQ, N_GU, G, bx);
        pg8::EpiFfn E{ACT, a.conv_ffn_w + 3 * DFF, HALOG, FIRSTG, FIRSTU, lds + RING_BYTES};
        pg8::gemm_phase<pg8::EpiFfn, pg8::StaticOrder, true>(lds, g, S, E);
        if (DEFER && bx >= 192) cvt_matrix2<0>(a.w_ffn_down + SZ_D, DFF, DM, WD + SZ_D, lds + wave * 9216, (bx - 192) * 8 + wave, (G - 192) * 8, D6_WD1_HI, D15_WD1_HI);
    }
    SEAM(15);
    if (IN(16)) ffn_fix_phase(HALOG, FIRSTG, FIRSTU, a.conv_ffn_w + 3 * DFF, ACT, gtid, nthreads);
    SEAM(16);
    if (IN(17)) {
        pg8::Gemm g{ACT, WD + SZ_D, DFF, DFF, DFF}; pg8::StaticOrder S; S.init(SEQ, DM, G, bx);
        pg8::EpiStore E{Y, DM};
        pg8::gemm_phase<pg8::EpiStore, pg8::StaticOrder, true>(lds, g, S, E);
    }
    SEAM(17);
    if (IN(18)) { for (int m = gw; m < SEQ; m += ngw) norm_res_row<false, true, false>(XRES + (size_t)m * DM, Y + (size_t)m * DM, a.g_ffn_post + DM, nullptr, a.out + (size_t)m * DM, nullptr); }

#ifdef PROBE
    xcd_barrier(bar);
#if PROBE == 1
    { LAS float* scr = (LAS float*)(lds + wave * 16384);
      if (bx >= 8) { const int cw_ = (bx - 8) * 8 + wave, ncw = (G - 8) * 8;
            cvt_matrix<0>(a.w_conv_in, DM, N_CI, WCI, 0, scr, cw_, ncw, lane);
            cvt_matrix<0>(a.w_conv_out, K_CO, DM, WCO, 0, scr, cw_, ncw, lane);
            cvt_matrix<2>(a.w_ffn_gate, DM, DFF, WGU, 0, scr, cw_, ncw, lane);
            cvt_matrix<3>(a.w_ffn_up, DM, DFF, WGU, 0, scr, cw_, ncw, lane);
            cvt_matrix<0>(a.w_ffn_down, DFF, DM, WD, 0, scr, cw_, ncw, lane);
            cvt_matrix<1>(a.w_attn_in, DM, N_AI, WAI, 0, scr, cw_, ncw, lane);
            cvt_matrix<0>(a.w_attn_out, K_AO, DM, WAO, 0, scr, cw_, ncw, lane);
            cvt_matrix<2>(a.w_ffn_gate + SZ_D, DM, DFF, WGU + SZ_GU, 0, scr, cw_, ncw, lane);
            cvt_matrix<3>(a.w_ffn_up + SZ_D, DM, DFF, WGU + SZ_GU, 0, scr, cw_, ncw, lane);
            cvt_matrix<0>(a.w_ffn_down + SZ_D, DFF, DM, WD + SZ_D, 0, scr, cw_, ncw, lane); } }
#elif PROBE == 8
    { pg8::Gemm g{ACT, WD, DFF, DFF, DFF}; pg8::StaticOrder S; S.init(SEQ, DM, G, bx);
      pg8::EpiStore E{Y, DM};
      pg8::gemm_phase<pg8::EpiStore, pg8::StaticOrder, true>(lds, g, S, E); }
#elif PROBE == 4
    { pg8::Gemm g{A2, WCO, K_CO, K_CO, K_CO}; pg8::StaticOrder S; S.init(SEQ, DM, G, bx);
      pg8::EpiStore E{Y, DM};
      pg8::gemm_phase<pg8::EpiStore, pg8::StaticOrder, true>(lds, g, S, E); }
#elif PROBE == 40
    { pg8::Gemm g{A2, WCO, K_CO, K_CO, K_CO}; pg8::SameTileOrder S; S.n = 2;
      pg8::EpiStore E{Y, DM};
      pg8::gemm_phase<pg8::EpiStore, pg8::SameTileOrder, true>(lds, g, S, E); }
#elif PROBE == 6
    { pg8::Gemm g{XN, WGU, DM, DM, DM}; pg8::StaticOrder S; S.init(SEQ, N_GU, G, bx);
      pg8::EpiFfn E{ACT, a.conv_ffn_w, HALOG, FIRSTG, FIRSTU, lds + RING_BYTES};
      pg8::gemm_phase<pg8::EpiFfn, pg8::StaticOrder, true>(lds, g, S, E); }
#elif PROBE == 5
    { float* scratch_x = (float*)(ws + WS_S);
      for (int m = gw; m < SEQ; m += ngw) norm_res_row<true, true, true>(a.x + (size_t)m * DM, Y + (size_t)m * DM, a.g_mix_post, a.g_ffn_pre, scratch_x + (size_t)m * DM, XN + (size_t)m * DM); }
#elif PROBE == 3
    { for (int u = bx; u < 4 * (SEQ / 128); u += G) { const int hd = u / (SEQ / 128), qb = u % (SEQ / 128);
            attn_unit<256, 16, false>(lds, H + (size_t)(128 * qb) * N_CI + 3 * CW + 256 * hd, N_CI, KV + 256 * hd, KV + MW + 256 * hd, 2 * MW, 0,
                                      A2 + (size_t)(128 * qb) * K_CO + CW + 256 * hd, K_CO, nullptr, 0.0625f); }
        conv_gate_phase(H, a.conv_mix_w, A2, gtid, nthreads); }
#endif
#endif
#undef IN
#undef SEAM
}

extern "C" void kernel_launch(void* const* d_in, const int* in_sizes, int n_in, void* d_out, int out_size, void* d_ws, size_t ws_size, hipStream_t stream) {
    static int grid = 0;
    if (grid == 0) {
        if (n_in != 18 || in_sizes[0] != SEQ * DM || out_size != SEQ * DM || ws_size < WS_END) { fprintf(stderr, "kernel_launch: unexpected shapes (n_in %d, in0 %d, out %d, ws %zu < %zu?)\n", n_in, n_in > 0 ? in_sizes[0] : -1, out_size, ws_size, (size_t)WS_END); grid = -1; return; }
        int dev = 0, cus = 0;
        if (hipGetDevice(&dev) != hipSuccess || hipDeviceGetAttribute(&cus, hipDeviceAttributeMultiprocessorCount, dev) != hipSuccess) { grid = -1; return; }
        if (hipFuncSetAttribute((const void*)fwd_kernel, hipFuncAttributeMaxDynamicSharedMemorySize, LDS_BYTES) != hipSuccess) { fprintf(stderr, "kernel_launch: hipFuncSetAttribute failed\n"); grid = -1; return; }
        int per_cu = 0;
        if (hipOccupancyMaxActiveBlocksPerMultiprocessor(&per_cu, (const void*)fwd_kernel, 512, LDS_BYTES) != hipSuccess || per_cu < 1) fprintf(stderr, "kernel_launch: occupancy query says %d\n", per_cu);
        (void)hipGetLastError();
        grid = cus;
        if (grid < 16) { fprintf(stderr, "kernel_launch: needs >= 16 CUs\n"); grid = -1; return; }
    }
    if (grid < 0) return;
    (void)hipMemsetAsync((char*)d_ws + WS_CTL, 0, CTL_ZERO_BYTES, stream);
    Args a{};
    a.x = (const float*)d_in[0]; a.mem = (const float*)d_in[1]; a.pos = (const int*)d_in[2]; a.g_mem = (const float*)d_in[3]; a.w_mem_kv = (const float*)d_in[4];
    a.g_mix_pre = (const float*)d_in[5]; a.g_mix_post = (const float*)d_in[6]; a.g_ffn_pre = (const float*)d_in[7]; a.g_ffn_post = (const float*)d_in[8];
    a.w_conv_in = (const float*)d_in[9]; a.conv_mix_w = (const float*)d_in[10]; a.w_conv_out = (const float*)d_in[11]; a.w_attn_in = (const float*)d_in[12]; a.w_attn_out = (const float*)d_in[13];
    a.w_ffn_gate = (const float*)d_in[14]; a.w_ffn_up = (const float*)d_in[15]; a.conv_ffn_w = (const float*)d_in[16]; a.w_ffn_down = (const float*)d_in[17];
    a.out = (float*)d_out; a.ws = (unsigned char*)d_ws;
#if ONE_LAUNCH
    a.ph_lo = 0; a.ph_hi = NPHASE;
    hipLaunchKernelGGL(fwd_kernel, dim3(grid), dim3(512), LDS_BYTES, stream, a);
#else
    for (int p = 0; p < NPHASE; ++p) { a.ph_lo = p; a.ph_hi = p + 1; hipLaunchKernelGGL(fwd_kernel, dim3(grid), dim3(512), LDS_BYTES, stream, a); }
#endif
}
```

```cpp
#include <hip/hip_runtime.h>
#include <cstdio>
#include <cstdint>

#define LAS __attribute__((address_space(3)))
#define GAS __attribute__((address_space(1)))
typedef unsigned short bf16_t;
typedef short bf16x8 __attribute__((ext_vector_type(8)));
typedef short s16x4 __attribute__((ext_vector_type(4)));
typedef float f32x4 __attribute__((ext_vector_type(4)));
typedef unsigned u32x4 __attribute__((ext_vector_type(4)));
typedef unsigned u32x2 __attribute__((ext_vector_type(2)));

constexpr int SEQ = 8192, DM = 4096, DFF = 11008, CW = 3072, MW = 1024, GW = 2048, NMEM = 256, NHEAD = 16, HDIM = 128;
constexpr int N_CI = 3 * CW + MW;
constexpr int N_AI = 9 * GW + MW;
constexpr int N_GU = 2 * DFF;
constexpr int K_CO = CW + MW;
constexpr int K_AO = GW + MW;
constexpr float EPS = 1e-6f;

#ifndef ONE_LAUNCH
#define ONE_LAUNCH 1
#endif
constexpr int NPHASE = 19;
#ifndef DEFER
#define DEFER 1
#endif
constexpr int D6_WD1_HI = DEFER ? 48 : 0;
constexpr int D15_WD1_HI = DEFER ? 96 : 0;
constexpr int D10_UP1_HI = 0;
constexpr int D10_GATE1 = DEFER ? 64 : 0;

constexpr size_t MiB = 1u << 20;
constexpr size_t WS_CTL = 0, CTL_ZERO_BYTES = 1 * MiB;
constexpr size_t WS_WKV = 1 * MiB;
constexpr size_t WS_WCI = WS_WKV + 16 * MiB;
constexpr size_t WS_WCO = WS_WCI + 80 * MiB;
constexpr size_t WS_WAI = WS_WCO + 32 * MiB;
constexpr size_t WS_WAO = WS_WAI + 152 * MiB;
constexpr size_t WS_WGU = WS_WAO + 24 * MiB;
constexpr size_t WS_WD  = WS_WGU + 2 * 172 * MiB;
constexpr size_t WS_XN  = WS_WD + 2 * 86 * MiB;
constexpr size_t WS_R   = WS_XN + 64 * MiB;
constexpr size_t WS_S   = WS_R + 344 * MiB;
constexpr size_t WS_MEMN = WS_S + 172 * MiB;
constexpr size_t WS_KV  = WS_MEMN + 2 * MiB;
constexpr size_t WS_COS = WS_KV + 1 * MiB;
constexpr size_t WS_SIN = WS_COS + 2 * MiB;
constexpr size_t WS_LSE = WS_SIN + 2 * MiB;
constexpr size_t WS_HALOG = WS_LSE + 2 * MiB;
constexpr size_t WS_FIRSTG = WS_HALOG + 3 * MiB;
constexpr size_t WS_FIRSTU = WS_FIRSTG + 3 * MiB;
constexpr size_t WS_XRES = WS_FIRSTU + 3 * MiB;
constexpr size_t WS_END = WS_XRES + 64 * MiB;
constexpr int CW_BAR = 4096;

constexpr int RING_BYTES = 131072;
constexpr int LDSCTL_OFF = 146432;
constexpr int LDS_BYTES = 147456;

__device__ __forceinline__ unsigned cvt_pk_bf16(float lo, float hi) { unsigned r; asm("v_cvt_pk_bf16_f32 %0, %1, %2" : "=v"(r) : "v"(lo), "v"(hi)); return r; }
__device__ __forceinline__ float bf_lo(unsigned w) { return __uint_as_float(w << 16); }
__device__ __forceinline__ float bf_hi(unsigned w) { return __uint_as_float(w & 0xffff0000u); }
__device__ __forceinline__ int fresh_lane() { int l; asm volatile("v_mbcnt_lo_u32_b32 %0, -1, 0\n\tv_mbcnt_hi_u32_b32 %0, -1, %0" : "=v"(l)); return l; }
__device__ __forceinline__ int fresh_tid() { int t = threadIdx.x; asm volatile("" : "+v"(t)); return t; }
__device__ __forceinline__ float wave_sum(float v) {
#pragma unroll
    for (int o = 1; o < 64; o <<= 1) v += __shfl_xor(v, o);
    return v;
}

__constant__ float INV_FREQ[64] = {
1.000000000e+00f, 8.659643531e-01f, 7.498942018e-01f, 6.493816376e-01f, 5.623413324e-01f, 4.869675338e-01f, 4.216965139e-01f, 3.651741147e-01f, 3.162277639e-01f, 2.738419771e-01f, 2.371373773e-01f, 2.053525001e-01f, 1.778279394e-01f, 1.539926529e-01f, 1.333521456e-01f, 1.154781953e-01f,
1.000000015e-01f, 8.659642935e-02f, 7.498942316e-02f, 6.493816525e-02f, 5.623413250e-02f, 4.869675264e-02f, 4.216964915e-02f, 3.651741147e-02f, 3.162277490e-02f, 2.738419548e-02f, 2.371373773e-02f, 2.053525113e-02f, 1.778279431e-02f, 1.539926510e-02f, 1.333521400e-02f, 1.154781971e-02f,
9.999999776e-03f, 8.659643121e-03f, 7.498942316e-03f, 6.493816152e-03f, 5.623413250e-03f, 4.869675264e-03f, 4.216964822e-03f, 3.651741194e-03f, 3.162277630e-03f, 2.738419687e-03f, 2.371373819e-03f, 2.053525066e-03f, 1.778279431e-03f, 1.539926510e-03f, 1.333521446e-03f, 1.154782018e-03f,
1.000000047e-03f, 8.659643354e-04f, 7.498941850e-04f, 6.493816036e-04f, 5.623413017e-04f, 4.869675322e-04f, 4.216965172e-04f, 3.651741135e-04f, 3.162277571e-04f, 2.738419571e-04f, 2.371373703e-04f, 2.053525095e-04f, 1.778279402e-04f, 1.539926598e-04f, 1.333521504e-04f, 1.154782003e-04f };

namespace pg8 {
constexpr int BM = 256, BK = 64, HALF = 128, HTB = HALF * BK * 2, STAGE_BYTES = 8 * HTB, NXCD = 8, WGM = 8;
__host__ __device__ __forceinline__ int lds_byte(int r, int c) { const int st = (r >> 4) * 2 + (c >> 5), rr = r & 15, cc = c & 31, ob = rr * 64 + cc * 2; return st * 1024 + (ob ^ (((ob >> 9) & 1) << 5)); }
__host__ __device__ __forceinline__ void stage_rc(int b, int& R, int& C) { const int st = b / 1024, sb = b % 1024, swz = sb ^ (((sb >> 9) & 1) << 5); R = (st >> 1) * 16 + swz / 64; C = (st & 1) * 32 + (swz % 64) / 2; }
__host__ __device__ __forceinline__ int perm32(int rho) { const int n = rho >> 4, i = rho & 15; return 8 * (i >> 2) + 4 * n + (i & 3); }

struct Unit { int pm, pn; };
struct SameTileOrder { int n;
    __device__ bool next(int i, Unit& u) const { if (i >= n) return false; u.pm = 0; u.pn = 0; return true; }
    __device__ __forceinline__ void a_ready(const Unit&) const {}
    __device__ __forceinline__ void done(const Unit&) const {} };
struct Gemm { const bf16_t* A; const bf16_t* Bt; int K, lda, ldb; };

struct StaticOrder {
    int nM, nN, nwg, G, c;
    __host__ __device__ void init(int M, int N, int G_, int c_) { nM = M / BM; nN = N / BM; nwg = nM * nN; G = G_; c = c_; }
    __host__ __device__ bool next(int i, Unit& u) const {
        const long L = (long)i * G + c; if (L >= nwg) return false;
        int wgid = (int)L; { const int q = nwg / NXCD, r = nwg % NXCD, xcd = wgid % NXCD, off = wgid / NXCD; wgid = (xcd < r ? xcd * (q + 1) : r * (q + 1) + (xcd - r) * q) + off; }
        const int nig = WGM * nN, gid = wgid / nig, fm = gid * WGM, gsz = (nM - fm) < WGM ? (nM - fm) : WGM;
        u.pm = fm + ((wgid % nig) % gsz); u.pn = (wgid % nig) / gsz; return true;
    }
    __device__ __forceinline__ void a_ready(const Unit&) const {}
    __device__ __forceinline__ void done(const Unit&) const {}
};

struct EpiStore {
    static constexpr bool PERM = true, AFTER_DRAIN = false, PREFETCH = false;
    bf16_t* O; int ldc;
    __device__ __forceinline__ void operator()(const f32x4 (&acc)[2][2][4][2], const Unit& u, int wr, int wc, int fr, int fq) const {
        const int row0 = u.pm * BM + wr * 64 + fr, col0 = u.pn * BM + wc * 32 + 8 * fq;
#pragma unroll
        for (int ai = 0; ai < 2; ++ai)
#pragma unroll
            for (int m = 0; m < 4; ++m) { bf16_t* rowp = O + (size_t)(row0 + ai * HALF + m * 16) * ldc + col0;
#pragma unroll
                for (int bj = 0; bj < 2; ++bj) { const f32x4 v0 = acc[ai][bj][m][0], v1 = acc[ai][bj][m][1];
                    u32x4 w; w.x = cvt_pk_bf16(v0[0], v0[1]); w.y = cvt_pk_bf16(v0[2], v0[3]); w.z = cvt_pk_bf16(v1[0], v1[1]); w.w = cvt_pk_bf16(v1[2], v1[3]);
                    *(u32x4*)(rowp + bj * HALF) = w; } }
    }
};
struct EpiQKV {
    static constexpr bool PERM = true, AFTER_DRAIN = false, PREFETCH = false;
    bf16_t* QKVL; bf16_t* QM; const float* cosT; const float* sinT;
    __device__ __forceinline__ void operator()(const f32x4 (&acc)[2][2][4][2], const Unit& u, int wr, int wc, int fr, int fq) const {
        const int colt = u.pn * BM;
        const int row0 = u.pm * BM + wr * 64 + fr;
        if (colt >= 9 * GW) {
            const int col0 = colt - 9 * GW + wc * 32 + 8 * fq;
#pragma unroll
            for (int ai = 0; ai < 2; ++ai)
#pragma unroll
                for (int m = 0; m < 4; ++m) { bf16_t* rowp = QM + (size_t)(row0 + ai * HALF + m * 16) * MW + col0;
#pragma unroll
                    for (int bj = 0; bj < 2; ++bj) { const f32x4 v0 = acc[ai][bj][m][0], v1 = acc[ai][bj][m][1];
                        u32x4 w; w.x = cvt_pk_bf16(v0[0], v0[1]); w.y = cvt_pk_bf16(v0[2], v0[3]); w.z = cvt_pk_bf16(v1[0], v1[1]); w.w = cvt_pk_bf16(v1[2], v1[3]);
                        *(u32x4*)(rowp + bj * HALF) = w; } }
        } else {
            const int g = colt / (3 * GW), rem = colt % (3 * GW), part = rem / GW, hd0 = (rem % GW) / HDIM, dsh = 2 * g, dm1 = (1 << dsh) - 1;
            bf16_t* slab0 = QKVL + (size_t)((g * 3 + part) * NHEAD + hd0) * SEQ * HDIM;
            if (part == 2) {
#pragma unroll
                for (int ai = 0; ai < 2; ++ai)
#pragma unroll
                    for (int m = 0; m < 4; ++m) { const int row = row0 + ai * HALF + m * 16; const int rp = ((row & dm1) << (13 - dsh)) + (row >> dsh);
#pragma unroll
                        for (int bj = 0; bj < 2; ++bj) { const f32x4 v0 = acc[ai][bj][m][0], v1 = acc[ai][bj][m][1];
                            u32x4 w; w.x = cvt_pk_bf16(v0[0], v0[1]); w.y = cvt_pk_bf16(v0[2], v0[3]); w.z = cvt_pk_bf16(v1[0], v1[1]); w.w = cvt_pk_bf16(v1[2], v1[3]);
                            *(u32x4*)(slab0 + ((size_t)bj * SEQ + rp) * HDIM + wc * 32 + 8 * fq) = w; } }
            } else {
                const int x0 = wc * 32 + 8 * fq, hh = x0 >> 6, d0 = x0 & 63;
                f32x4 tc[2][2], ts[2][2];
                { const size_t o = (size_t)row0 * 64 + d0; tc[0][0] = *(const f32x4*)(cosT + o); tc[0][1] = *(const f32x4*)(cosT + o + 4); ts[0][0] = *(const f32x4*)(sinT + o); ts[0][1] = *(const f32x4*)(sinT + o + 4); }
#pragma unroll
                for (int k = 0; k < 8; ++k) { const int ai = k >> 2, m = k & 3; const int row = row0 + ai * HALF + m * 16; const int rp = ((row & dm1) << (13 - dsh)) + (row >> dsh);
                    if (k < 7) { const int k2 = k + 1; const size_t o = (size_t)(row0 + (k2 >> 2) * HALF + (k2 & 3) * 16) * 64 + d0;
                        tc[k2 & 1][0] = *(const f32x4*)(cosT + o); tc[k2 & 1][1] = *(const f32x4*)(cosT + o + 4); ts[k2 & 1][0] = *(const f32x4*)(sinT + o); ts[k2 & 1][1] = *(const f32x4*)(sinT + o + 4); }
                    const f32x4 c0 = tc[k & 1][0], c1 = tc[k & 1][1], s0 = ts[k & 1][0], s1 = ts[k & 1][1];
                    const f32x4 a0 = acc[ai][0][m][0], a1 = acc[ai][0][m][1], b0 = acc[ai][1][m][0], b1 = acc[ai][1][m][1];
                    const f32x4 o10 = a0 * c0 - b0 * s0, o11 = a1 * c1 - b1 * s1, o20 = b0 * c0 + a0 * s0, o21 = b1 * c1 + a1 * s1;
                    bf16_t* rowp = slab0 + ((size_t)hh * SEQ + rp) * HDIM + d0;
                    u32x4 w; w.x = cvt_pk_bf16(o10[0], o10[1]); w.y = cvt_pk_bf16(o10[2], o10[3]); w.z = cvt_pk_bf16(o11[0], o11[1]); w.w = cvt_pk_bf16(o11[2], o11[3]);
                    *(u32x4*)(rowp) = w;
                    w.x = cvt_pk_bf16(o20[0], o20[1]); w.y = cvt_pk_bf16(o20[2], o20[3]); w.z = cvt_pk_bf16(o21[0], o21[1]); w.w = cvt_pk_bf16(o21[2], o21[3]);
                    *(u32x4*)(rowp + 64) = w;
                    asm volatile("" ::: "memory"); }
            }
        }
    }
};
typedef float f32x2 __attribute__((ext_vector_type(2)));
__device__ __forceinline__ float dpp_ror1(float v) { return __builtin_bit_cast(float, __builtin_amdgcn_mov_dpp(__builtin_bit_cast(int, v), 0x121, 0xf, 0xf, true)); }
__device__ __forceinline__ float dpp_ror2(float v) { return __builtin_bit_cast(float, __builtin_amdgcn_mov_dpp(__builtin_bit_cast(int, v), 0x122, 0xf, 0xf, true)); }
struct EpiFfn {
    static constexpr bool PERM = true, AFTER_DRAIN = false, PREFETCH = true;
    bf16_t* ACT; const float* cw; float* HALOG; float* FIRSTG; float* FIRSTU; LAS unsigned char* xl;
    __device__ __forceinline__ void prefetch(const Unit& u, int par, int wid, int lane) const {
        if (wid == 0) {
            LAS unsigned char* dst = xl + 4096 + par * 1536;
            __builtin_amdgcn_global_load_lds((const unsigned*)(cw + (lane >> 5) * DFF + u.pn * 128 + (lane & 31) * 4), (LAS unsigned*)dst, 16, 0, 0);
            if (lane < 32) __builtin_amdgcn_global_load_lds((const unsigned*)(cw + 2 * DFF + u.pn * 128 + lane * 4), (LAS unsigned*)(dst + 1024), 16, 0, 0);
        }
    }
    __device__ __forceinline__ void operator()(const f32x4 (&acc)[2][2][4][2], const Unit& u, int wr, int wc, int fr, int fq, int par) const {
        const int ch0 = u.pn * 128 + wc * 32 + 8 * fq;
        LAS f32x4* hl = (LAS f32x4*)xl;
        if (fr >= 14) {
#pragma unroll
            for (int ai = 0; ai < 2; ++ai) { const int idx = ((((ai * 2 + wr) * 4 + wc) * 2 + (fr - 14)) * 4 + fq) * 2; hl[idx] = acc[ai][0][3][0]; hl[idx + 1] = acc[ai][0][3][1]; }
        }
        f32x2 w0[4], w1[4], w2[4];
        { const LAS f32x4* wl = (const LAS f32x4*)(xl + 4096 + par * 1536) + (wc * 32 + 8 * fq) / 4;
          const f32x4 a0 = wl[0], a1 = wl[1], b0 = wl[32], b1 = wl[33], c0 = wl[64], c1 = wl[65];
          w0[0] = (f32x2){a0[0], a0[1]}; w0[1] = (f32x2){a0[2], a0[3]}; w0[2] = (f32x2){a1[0], a1[1]}; w0[3] = (f32x2){a1[2], a1[3]};
          w1[0] = (f32x2){b0[0], b0[1]}; w1[1] = (f32x2){b0[2], b0[3]}; w1[2] = (f32x2){b1[0], b1[1]}; w1[3] = (f32x2){b1[2], b1[3]};
          w2[0] = (f32x2){c0[0], c0[1]}; w2[1] = (f32x2){c0[2], c0[3]}; w2[2] = (f32x2){c1[0], c1[1]}; w2[3] = (f32x2){c1[2], c1[3]}; }
        asm volatile("s_waitcnt lgkmcnt(0)" ::: "memory"); __builtin_amdgcn_s_barrier(); asm volatile("" ::: "memory");
#pragma unroll
        for (int ai = 0; ai < 2; ++ai) {
            const bool ext = (wr == 0 && ai == 0);
            f32x2 r1p[4], r2p[4];
            if (ext) {
#pragma unroll
                for (int i = 0; i < 4; ++i) { r1p[i] = (f32x2){0.f, 0.f}; r2p[i] = (f32x2){0.f, 0.f}; }
            } else {
                const int sai = (wr == 1) ? ai : 0, swr = (wr == 1) ? 0 : 1;
                const int b = ((((sai * 2 + swr) * 4 + wc) * 2) * 4 + fq) * 2;
                const f32x4 p0 = hl[b], p1 = hl[b + 1], q0 = hl[b + 8], q1 = hl[b + 9];
                const f32x4 s0 = (fr == 0) ? p0 : q0, s1 = (fr == 0) ? p1 : q1;
                r1p[0] = (f32x2){q0[0], q0[1]}; r1p[1] = (f32x2){q0[2], q0[3]}; r1p[2] = (f32x2){q1[0], q1[1]}; r1p[3] = (f32x2){q1[2], q1[3]};
                r2p[0] = (f32x2){s0[0], s0[1]}; r2p[1] = (f32x2){s0[2], s0[3]}; r2p[2] = (f32x2){s1[0], s1[1]}; r2p[3] = (f32x2){s1[2], s1[3]};
            }
#pragma unroll
            for (int m = 0; m < 4; ++m) {
                const int row = u.pm * BM + ai * HALF + wr * 64 + m * 16 + fr;
                f32x2 o[4];
#pragma unroll
                for (int i = 0; i < 4; ++i) {
                    const f32x2 cur = (f32x2){acc[ai][0][m][i >> 1][2 * (i & 1)], acc[ai][0][m][i >> 1][2 * (i & 1) + 1]};
                    const f32x2 up = (f32x2){acc[ai][1][m][i >> 1][2 * (i & 1)], acc[ai][1][m][i >> 1][2 * (i & 1) + 1]};
                    const f32x2 r1 = (f32x2){dpp_ror1(cur.x), dpp_ror1(cur.y)}, r2 = (f32x2){dpp_ror2(cur.x), dpp_ror2(cur.y)};
                    const f32x2 p1 = (fr >= 1) ? r1 : r1p[i], p2 = (fr >= 2) ? r2 : r2p[i];
                    const f32x2 g = __builtin_elementwise_fma(w0[i], p2, __builtin_elementwise_fma(w1[i], p1, w2[i] * cur));
                    const f32x2 ng = g * -1.4426950408889634f;
                    f32x2 e; e.x = __builtin_amdgcn_exp2f(ng.x); e.y = __builtin_amdgcn_exp2f(ng.y);
                    const f32x2 d = e + 1.0f;
                    f32x2 rc; rc.x = __builtin_amdgcn_rcpf(d.x); rc.y = __builtin_amdgcn_rcpf(d.y);
                    o[i] = (g * rc) * up;
                    r1p[i] = r1; r2p[i] = r2;
                }
                const bool first2 = ext && m == 0 && fr < 2 && u.pm > 0;
                if (!first2) {
                    u32x4 w; w.x = cvt_pk_bf16(o[0].x, o[0].y); w.y = cvt_pk_bf16(o[1].x, o[1].y); w.z = cvt_pk_bf16(o[2].x, o[2].y); w.w = cvt_pk_bf16(o[3].x, o[3].y);
                    *(u32x4*)(ACT + (size_t)row * DFF + ch0) = w;
                } else {
                    float* fg = FIRSTG + (size_t)(u.pm * 2 + fr) * DFF + ch0; float* fu = FIRSTU + (size_t)(u.pm * 2 + fr) * DFF + ch0;
                    *(f32x4*)fg = acc[ai][0][m][0]; *(f32x4*)(fg + 4) = acc[ai][0][m][1]; *(f32x4*)fu = acc[ai][1][m][0]; *(f32x4*)(fu + 4) = acc[ai][1][m][1];
                }
                if (ai == 1 && wr == 1 && m == 3 && fr >= 14) { float* hg = HALOG + (size_t)(u.pm * 2 + fr - 14) * DFF + ch0; *(f32x4*)hg = acc[ai][0][m][0]; *(f32x4*)(hg + 4) = acc[ai][0][m][1]; }
            }
        }
    }
};

template <class Epi, class Sched, bool ALIGN_EPI>
__device__ __forceinline__ void gemm_phase(LAS unsigned char* lds, const Gemm g, const Sched& S, const Epi& E) {
    const int tid = fresh_tid(), wid = __builtin_amdgcn_readfirstlane(tid >> 6), lane = tid & 63, wr = wid >> 2, wc = wid & 3, fr = lane & 15, fq = lane >> 4;
    const int K = g.K, nt = K / BK;
    unsigned voffA[2], voffB[2];
#pragma unroll
    for (int i = 0; i < 2; ++i) { int R, C; stage_rc(tid * 16 + i * 8192, R, C); const int Rb = Epi::PERM ? ((R & ~31) + perm32(R & 31)) : R;
        voffA[i] = (unsigned)(R * g.lda + C) * 2u; voffB[i] = (unsigned)(Rb * g.ldb + C) * 2u; }
    const size_t kstep = (size_t)(BK * 2);
    const size_t hstepA = (size_t)HALF * g.lda * 2, hstepB = (size_t)HALF * g.ldb * 2;
    const size_t tstepA = 2 * hstepA, tstepB = 2 * hstepB;
    const unsigned ldsw = (unsigned)wid * 1024u;
    const int aoff = lds_byte(wr * 64 + fr, fq * 8), boff = lds_byte(wc * 32 + fr, fq * 8);
#define PG8_SA(b, h) (((b) * 2 + (h)) * HTB)
#define PG8_SB(b, h) ((4 + (b) * 2 + (h)) * HTB)
#define PG8_STAGE(bufoff, gbase, voff) do { _Pragma("unroll") for (int _i = 0; _i < 2; ++_i) \
        __builtin_amdgcn_global_load_lds((const unsigned*)((const char*)(gbase) + (voff)[_i]), (LAS unsigned*)(lds + (bufoff) + ldsw + _i * 8192), 16, 0, 0); } while (0)
#define PG8_LDA(dst, b, h) do { _Pragma("unroll") for (int m = 0; m < 4; ++m) _Pragma("unroll") for (int k = 0; k < 2; ++k) dst[m][k] = *(const LAS bf16x8*)(lds + PG8_SA(b, h) + aoff + m * 2048 + k * 1024); } while (0)
#define PG8_LDB(dst, b, h) do { _Pragma("unroll") for (int n = 0; n < 2; ++n) _Pragma("unroll") for (int k = 0; k < 2; ++k) dst[n][k] = *(const LAS bf16x8*)(lds + PG8_SB(b, h) + boff + n * 2048 + k * 1024); } while (0)
#define PG8_MMA(ai, bj, At, Bt) do { __builtin_amdgcn_s_setprio(1); _Pragma("unroll") for (int m = 0; m < 4; ++m) _Pragma("unroll") for (int n = 0; n < 2; ++n) _Pragma("unroll") for (int k = 0; k < 2; ++k) \
        acc[ai][bj][m][n] = __builtin_amdgcn_mfma_f32_16x16x32_bf16(Bt[n][k], At[m][k], acc[ai][bj][m][n], 0, 0, 0); __builtin_amdgcn_s_setprio(0); } while (0)
#define PG8_WAIT_V(n) asm volatile("s_waitcnt vmcnt(" #n ")" ::: "memory")
#define PG8_WAIT_L(n) asm volatile("s_waitcnt lgkmcnt(" #n ")" ::: "memory")
#define PG8_BAR __builtin_amdgcn_s_barrier()
#define PG8_SCHED __builtin_amdgcn_sched_barrier(0)
    Unit cur, nxt; int ui = 0;
    if (!S.next(0, cur)) return;
    f32x4 acc[2][2][4][2];
#pragma unroll
    for (int a = 0; a < 2; ++a)
#pragma unroll
        for (int b = 0; b < 2; ++b)
#pragma unroll
            for (int m = 0; m < 4; ++m)
#pragma unroll
                for (int n = 0; n < 2; ++n) acc[a][b][m][n] = (f32x4){0.f, 0.f, 0.f, 0.f};
    bf16x8 At[4][2], B0[2][2], B1[2][2];
    const char* cA = (const char*)g.A + (size_t)cur.pm * tstepA; const char* cB = (const char*)g.Bt + (size_t)cur.pn * tstepB;
    S.a_ready(cur);
    if constexpr (Epi::PREFETCH) E.prefetch(cur, 0, wid, lane);
    PG8_STAGE(PG8_SB(0, 0), cB, voffB); PG8_STAGE(PG8_SB(0, 1), cB + hstepB, voffB); PG8_STAGE(PG8_SA(0, 0), cA, voffA); PG8_STAGE(PG8_SA(0, 1), cA + hstepA, voffA);
    if (wr == 1) PG8_BAR;
    PG8_WAIT_V(2); PG8_BAR;
    PG8_STAGE(PG8_SB(1, 0), cB + kstep, voffB); PG8_STAGE(PG8_SA(1, 0), cA + kstep, voffA); PG8_STAGE(PG8_SB(1, 1), cB + hstepB + kstep, voffB);
    PG8_WAIT_V(6); PG8_BAR;
    for (;;) {
        const bool has_next = S.next(ui + 1, nxt);
        const char* nA = has_next ? (const char*)g.A + (size_t)nxt.pm * tstepA : cA; const char* nB = has_next ? (const char*)g.Bt + (size_t)nxt.pn * tstepB : cB;
        for (int t = 0; t < nt; t += 2) {
            const bool last = (t == nt - 2);
            const char* a1 = cA + (size_t)(t + 1) * kstep;
            const char* a2 = last ? nA : cA + (size_t)(t + 2) * kstep; const char* b2 = last ? nB : cB + (size_t)(t + 2) * kstep;
            const char* a3 = a2 + kstep; const char* b3 = b2 + kstep;
            if (last && has_next) S.a_ready(nxt);
            PG8_LDB(B0, 0, 0); PG8_LDB(B1, 0, 1); PG8_SCHED; PG8_LDA(At, 0, 0); PG8_STAGE(PG8_SA(1, 1), a1 + hstepA, voffA);
            PG8_WAIT_V(8); PG8_WAIT_L(0); PG8_BAR; PG8_MMA(0, 0, At, B0); PG8_MMA(0, 1, At, B1); PG8_BAR; PG8_SCHED;
            PG8_LDA(At, 0, 1); PG8_STAGE(PG8_SB(0, 0), b2, voffB); PG8_STAGE(PG8_SB(0, 1), b2 + hstepB, voffB); PG8_STAGE(PG8_SA(0, 0), a2, voffA);
            PG8_WAIT_V(8); PG8_WAIT_L(0); PG8_BAR; PG8_MMA(1, 0, At, B0); PG8_MMA(1, 1, At, B1); PG8_BAR; PG8_SCHED;
            PG8_LDB(B0, 1, 0); PG8_LDB(B1, 1, 1); PG8_SCHED; PG8_LDA(At, 1, 0); PG8_STAGE(PG8_SA(0, 1), a2 + hstepA, voffA);
            PG8_WAIT_V(8); PG8_WAIT_L(0); PG8_BAR; PG8_MMA(0, 0, At, B0); PG8_MMA(0, 1, At, B1); PG8_BAR; PG8_SCHED;
            PG8_LDA(At, 1, 1); PG8_STAGE(PG8_SB(1, 0), b3, voffB); PG8_STAGE(PG8_SB(1, 1), b3 + hstepB, voffB); PG8_STAGE(PG8_SA(1, 0), a3, voffA);
            PG8_WAIT_V(8); PG8_WAIT_L(0); PG8_BAR; PG8_MMA(1, 0, At, B0); PG8_MMA(1, 1, At, B1); PG8_BAR; PG8_SCHED;
        }
        if constexpr (ALIGN_EPI) { if (wr == 0) PG8_BAR; }
        if constexpr (Epi::PREFETCH) { E(acc, cur, wr, wc, fr, fq, ui & 1); if (has_next) E.prefetch(nxt, (ui + 1) & 1, wid, lane); } else E(acc, cur, wr, wc, fr, fq);
        S.done(cur);
        if (!has_next) break;
#pragma unroll
        for (int a = 0; a < 2; ++a)
#pragma unroll
            for (int b = 0; b < 2; ++b)
#pragma unroll
                for (int m = 0; m < 4; ++m)
#pragma unroll
                    for (int n = 0; n < 2; ++n) acc[a][b][m][n] = (f32x4){0.f, 0.f, 0.f, 0.f};
        cur = nxt; cA = nA; cB = nB; ++ui;
        if constexpr (ALIGN_EPI) { if (wr == 1) PG8_BAR; }
    }
    PG8_WAIT_V(0);
    if constexpr (!ALIGN_EPI) { if (wr == 0) PG8_BAR; }
    PG8_BAR;
#undef PG8_SA
#undef PG8_SB
#undef PG8_STAGE
#undef PG8_LDA
#undef PG8_LDB
#undef PG8_MMA
#undef PG8_WAIT_V
#undef PG8_WAIT_L
#undef PG8_BAR
#undef PG8_SCHED
}
}

#define XB_TMO      128
#define XB_XCNT(j)  (256  + 64 * (j))
#define XB_XSUB(j)  (1280 + 64 * (j))
#define XB_XGEN(j)  (2304 + 64 * (j))
#define XB_TOP      3328
#define XB_TOPGEN   3392
#define XCD_BAR_WORDS 3456
#define XB_SPIN_CAP (1u << 18)
__device__ __forceinline__ unsigned xb_ld(unsigned* p)              { return __hip_atomic_load(p, __ATOMIC_RELAXED, __HIP_MEMORY_SCOPE_AGENT); }
__device__ __forceinline__ unsigned xb_add(unsigned* p, unsigned v) { return __hip_atomic_fetch_add(p, v, __ATOMIC_RELAXED, __HIP_MEMORY_SCOPE_AGENT); }
__device__ __forceinline__ unsigned xb_xcc_id() { return (unsigned)__builtin_amdgcn_s_getreg((3 << 11) | 20) & 0xFu; }
#define XB_SPIN(cond, bar) do { unsigned _sp = 0; while (cond) { __builtin_amdgcn_s_sleep(1); \
    if ((++_sp & 255u) == 0u) { if (xb_ld(&(bar)[XB_TMO])) break; if (_sp > XB_SPIN_CAP) { atomicAdd(&(bar)[XB_TMO], 1u); break; } } } } while (0)
struct XcdBarrier { unsigned* bar; unsigned x; volatile LAS unsigned* st; };
__device__ __forceinline__ XcdBarrier xcd_barrier_post(unsigned* bar, volatile LAS unsigned* st) {
    XcdBarrier b; b.bar = bar; b.x = xb_xcc_id(); b.st = st;
    if (threadIdx.x == 0) (void)xb_add(&bar[XB_XCNT(b.x)], 1u);
    return b;
}
__device__ __forceinline__ void xcd_barrier_complete(unsigned* bar, unsigned x, unsigned& nloc, unsigned& nx) {
    const unsigned G = gridDim.x * gridDim.y * gridDim.z;
    unsigned sum, cnt, mine, sp = 0u;
    for (;;) {
        sum = 0u; cnt = 0u; mine = 0u;
#pragma unroll
        for (unsigned j = 0; j < 16; ++j) { const unsigned c = xb_ld(&bar[XB_XCNT(j)]); sum += c; cnt += (c > 0u) ? 1u : 0u; mine = (j == x) ? c : mine; }
        if (sum == G) break;
        __builtin_amdgcn_s_sleep(1);
        if ((++sp & 255u) == 0u) { if (xb_ld(&bar[XB_TMO])) break; if (sp > XB_SPIN_CAP) { atomicAdd(&bar[XB_TMO], 1u); break; } }
    }
    nloc = mine > 0u ? mine : 1u; nx = cnt > 0u ? cnt : 1u;
}
__device__ __forceinline__ void xcd_barrier(const XcdBarrier& b) {
    asm volatile("s_waitcnt vmcnt(0)" ::: "memory");
    __syncthreads();
    if (threadIdx.x == 0) {
        unsigned* bar = b.bar;
        __builtin_amdgcn_s_waitcnt(0);
        unsigned nloc = b.st[0], nx = b.st[1];
        if (nloc == 0u) { xcd_barrier_complete(bar, b.x, nloc, nx); b.st[0] = nloc; b.st[1] = nx; }
        const unsigned old = xb_add(&bar[XB_XSUB(b.x)], 1u);
        const unsigned gen = old / nloc;
        if (old + 1u == (gen + 1u) * nloc) {
            __builtin_amdgcn_fence(__ATOMIC_RELEASE, "agent");
            asm volatile("s_waitcnt vmcnt(0)" ::: "memory");
            const unsigned og = xb_add(&bar[XB_TOP], 1u);
            const unsigned tg = og / nx;
            if (og + 1u == (tg + 1u) * nx) xb_add(&bar[XB_TOPGEN], 1u);
            else XB_SPIN(xb_ld(&bar[XB_TOPGEN]) == tg, bar);
            __builtin_amdgcn_fence(__ATOMIC_ACQUIRE, "agent");
            xb_add(&bar[XB_XGEN(b.x)], 1u);
            asm volatile("s_waitcnt vmcnt(0)" ::: "memory");
        } else {
            XB_SPIN(xb_ld(&bar[XB_XGEN(b.x)]) == gen, bar);
            __builtin_amdgcn_fence(__ATOMIC_ACQUIRE, "agent");
            asm volatile("s_waitcnt vmcnt(0)" ::: "memory");
        }
    }
    __syncthreads();
}

template <int MODE  >
__device__ __forceinline__ void cvt_matrix(const float* W, int K, int N, bf16_t* WT, int row_off, LAS float* scr, int gw, int ngw, int, int kb_lo = 0, int kb_hi = -1) {
    const int lane = fresh_lane();
    if (kb_hi < 0) kb_hi = K / 64;
    const int nblk = N / 32, nitems = (kb_hi - kb_lo) * nblk;
    for (int item = gw; item < nitems; item += ngw) {
        const int kb = kb_lo + item / nblk, nb = item % nblk, k0 = 64 * kb, n0 = 32 * nb;
#pragma unroll 8
        for (int i = 0; i < 32; ++i) { const int kk = 2 * i + (lane >> 5); scr[kk * 33 + (lane & 31)] = W[(size_t)(k0 + kk) * N + n0 + (lane & 31)]; }
        asm volatile("s_waitcnt lgkmcnt(0)" ::: "memory");
        int d0 = n0;
        if (MODE == 1) { if (n0 < 9 * GW && (n0 % (3 * GW)) < 2 * GW) d0 = (n0 & ~0xC0) | ((n0 & 0x40) << 1) | ((n0 & 0x80) >> 1); }
        if (MODE == 2) d0 = (n0 >> 7) * 256 + (n0 & 127);
        if (MODE == 3) d0 = (n0 >> 7) * 256 + 128 + (n0 & 127);
        const int c = lane & 7;
#pragma unroll
        for (int j = 0; j < 4; ++j) { const int n = (lane >> 3) + 8 * j; const LAS float* s = scr + (8 * c) * 33 + n;
            u32x4 o; o.x = cvt_pk_bf16(s[0 * 33], s[1 * 33]); o.y = cvt_pk_bf16(s[2 * 33], s[3 * 33]); o.z = cvt_pk_bf16(s[4 * 33], s[5 * 33]); o.w = cvt_pk_bf16(s[6 * 33], s[7 * 33]);
            *(u32x4*)(WT + (size_t)(row_off + d0 + n) * K + k0 + 8 * c) = o; }
        asm volatile("s_waitcnt lgkmcnt(0)" ::: "memory");
    }
}
template <int MODE>
__device__ __forceinline__ void cvt_matrix2(const float* W, int K, int N, bf16_t* WT, LAS unsigned char* scr, int gw, int ngw, int kb_lo, int kb_hi) {
    constexpr int P = 144;
    const int lane = fresh_lane(), l16 = lane & 15, g4 = lane >> 4, q = l16 >> 2, p = l16 & 3;
    const int nblk = N / 64, nitems = (kb_hi - kb_lo) * nblk;
    const unsigned tra = (unsigned)(size_t)scr + (unsigned)((8 * g4 + q) * P + p * 8);
    if (gw >= nitems) return;
    f32x4 vn[16];
    { const int kb = kb_lo + gw / nblk, nb = gw % nblk; const float* src = W + (size_t)(64 * kb + g4) * N + 64 * nb + l16 * 4;
#pragma unroll
      for (int i = 0; i < 16; ++i) vn[i] = *(const f32x4*)(src + (size_t)(4 * i) * N); }
    for (int item = gw; item < nitems; item += ngw) {
        const int kb = kb_lo + item / nblk, nb = item % nblk, k0 = 64 * kb, n0 = 64 * nb;
        f32x4 v[16];
#pragma unroll
        for (int i = 0; i < 16; ++i) v[i] = vn[i];
        if (item + ngw < nitems) {
            const int it2 = item + ngw, kb2 = kb_lo + it2 / nblk, nb2 = it2 % nblk; const float* src = W + (size_t)(64 * kb2 + g4) * N + 64 * nb2 + l16 * 4;
#pragma unroll
            for (int i = 0; i < 16; ++i) vn[i] = *(const f32x4*)(src + (size_t)(4 * i) * N);
        }
#pragma unroll
        for (int i = 0; i < 16; ++i) { u32x2 w; w.x = cvt_pk_bf16(v[i].x, v[i].y); w.y = cvt_pk_bf16(v[i].z, v[i].w); *(LAS u32x2*)(scr + (4 * i + g4) * P + l16 * 8) = w; }
        asm volatile("s_waitcnt lgkmcnt(0)" ::: "memory");
        int d0 = n0;
        if (MODE == 1) { if (n0 < 9 * GW && (n0 % (3 * GW)) < 2 * GW) d0 = (n0 & ~0xC0) | ((n0 & 0x40) << 1) | ((n0 & 0x80) >> 1); }
        if (MODE == 2) d0 = (n0 >> 7) * 256 + (n0 & 127);
        if (MODE == 3) d0 = (n0 >> 7) * 256 + 128 + (n0 & 127);
        bf16_t* dst = WT + (size_t)(d0 + l16) * K + k0 + 8 * g4;
#define TRRD(dst_, off) asm volatile("ds_read_b64_tr_b16 %0, %1 offset:%2" : "=&v"(dst_) : "v"(tra), "i"(off) : "memory")
#define CVT_OUT(nbk, h) do { s16x4 lo_, hi_; TRRD(lo_, (32 * (h)) * P + (nbk) * 32); TRRD(hi_, (32 * (h) + 4) * P + (nbk) * 32); asm volatile("s_waitcnt lgkmcnt(0)" ::: "memory"); \
        *(bf16x8*)(dst + (size_t)(16 * (nbk)) * K + 32 * (h)) = (bf16x8){lo_[0], lo_[1], lo_[2], lo_[3], hi_[0], hi_[1], hi_[2], hi_[3]}; } while (0)
        CVT_OUT(0, 0); CVT_OUT(0, 1); CVT_OUT(1, 0); CVT_OUT(1, 1); CVT_OUT(2, 0); CVT_OUT(2, 1); CVT_OUT(3, 0); CVT_OUT(3, 1);
#undef CVT_OUT
#undef TRRD
        asm volatile("s_waitcnt lgkmcnt(0)" ::: "memory");
    }
}
__device__ __forceinline__ void rms_row_to_bf16(const float* xrow, const float* g, bf16_t* orow, int) {
    const int lane = fresh_lane();
    const f32x4* xr = (const f32x4*)xrow + lane;
    f32x4 v[16]; float s = 0.f;
#pragma unroll
    for (int j = 0; j < 16; ++j) { v[j] = xr[64 * j]; s += (v[j].x * v[j].x + v[j].y * v[j].y) + (v[j].z * v[j].z + v[j].w * v[j].w); }
    const float rstd = 1.0f / sqrtf(wave_sum(s) * (1.f / DM) + EPS);
    const f32x4* gr = (const f32x4*)g + lane; u32x2* o8 = (u32x2*)orow + lane;
#pragma unroll
    for (int j = 0; j < 16; ++j) { const f32x4 gv = gr[64 * j]; u32x2 w; w.x = cvt_pk_bf16(v[j].x * rstd * gv.x, v[j].y * rstd * gv.y); w.y = cvt_pk_bf16(v[j].z * rstd * gv.z, v[j].w * rstd * gv.w); o8[64 * j] = w; }
}
template <bool SRC_F32, bool DST_F32, bool HAS_XN>
__device__ __forceinline__ void norm_res_row(const void* xsrc, const bf16_t* yrow, const float* gpost, const float* gpre, void* xout, bf16_t* xn) {
    const int lane = fresh_lane();
    const u32x2* yr = (const u32x2*)yrow + lane; f32x4 y[16]; float s = 0.f;
#pragma unroll
    for (int j = 0; j < 16; ++j) { const u32x2 w = yr[64 * j]; y[j] = (f32x4){bf_lo(w.x), bf_hi(w.x), bf_lo(w.y), bf_hi(w.y)}; s += (y[j].x * y[j].x + y[j].y * y[j].y) + (y[j].z * y[j].z + y[j].w * y[j].w); }
    const float rstd = 1.0f / sqrtf(wave_sum(s) * (1.f / DM) + EPS);
    const f32x4* gp = (const f32x4*)gpost + lane; float s2 = 0.f;
#pragma unroll
    for (int j = 0; j < 16; ++j) { f32x4 xv;
        if (SRC_F32) xv = ((const f32x4*)xsrc + lane)[64 * j]; else { const u32x2 w = ((const u32x2*)xsrc + lane)[64 * j]; xv = (f32x4){bf_lo(w.x), bf_hi(w.x), bf_lo(w.y), bf_hi(w.y)}; }
        const f32x4 gv = gp[64 * j]; y[j] = xv + y[j] * rstd * gv;
        if (DST_F32) ((f32x4*)xout + lane)[64 * j] = y[j];
        else { u32x2 w; w.x = cvt_pk_bf16(y[j].x, y[j].y); w.y = cvt_pk_bf16(y[j].z, y[j].w); ((u32x2*)xout + lane)[64 * j] = w; y[j] = (f32x4){bf_lo(w.x), bf_hi(w.x), bf_lo(w.y), bf_hi(w.y)}; }
        s2 += (y[j].x * y[j].x + y[j].y * y[j].y) + (y[j].z * y[j].z + y[j].w * y[j].w); }
    if (HAS_XN) {
        const float rstd2 = 1.0f / sqrtf(wave_sum(s2) * (1.f / DM) + EPS);
        const f32x4* gr = (const f32x4*)gpre + lane; u32x2* o8 = (u32x2*)xn + lane;
#pragma unroll
        for (int j = 0; j < 16; ++j) { const f32x4 gv = gr[64 * j]; u32x2 w; w.x = cvt_pk_bf16(y[j].x * rstd2 * gv.x, y[j].y * rstd2 * gv.y); w.y = cvt_pk_bf16(y[j].z * rstd2 * gv.z, y[j].w * rstd2 * gv.w); o8[64 * j] = w; }
    }
}
__device__ __forceinline__ void unpack8(const u32x4 w, float (&f)[8]) { f[0] = bf_lo(w.x); f[1] = bf_hi(w.x); f[2] = bf_lo(w.y); f[3] = bf_hi(w.y); f[4] = bf_lo(w.z); f[5] = bf_hi(w.z); f[6] = bf_lo(w.w); f[7] = bf_hi(w.w); }
__device__ __forceinline__ u32x4 pack8f(const float (&f)[8]) { u32x4 w; w.x = cvt_pk_bf16(f[0], f[1]); w.y = cvt_pk_bf16(f[2], f[3]); w.z = cvt_pk_bf16(f[4], f[5]); w.w = cvt_pk_bf16(f[6], f[7]); return w; }

__device__ __forceinline__ void conv_gate_phase(const bf16_t* H, const float* cw  , bf16_t* A2  , int gtid, int nthreads) {
    constexpr int RB = 32, NCG = CW / 8, NIT = (SEQ / RB) * NCG;
    asm volatile("" : "+v"(gtid));
    for (int it = gtid; it < NIT; it += nthreads) {
        const int cg = it % NCG, rb = it / NCG, c0 = cg * 8, t0 = rb * RB;
        float w0[8], w1[8], w2[8], m2[8], m1[8];
#pragma unroll
        for (int i = 0; i < 8; ++i) { w0[i] = cw[c0 + i]; w1[i] = cw[CW + c0 + i]; w2[i] = cw[2 * CW + c0 + i]; m2[i] = 0.f; m1[i] = 0.f; }
        if (t0 >= 2) {
            float a[8], b[8];
            unpack8(*(const u32x4*)(H + (size_t)(t0 - 2) * N_CI + CW + c0), a); unpack8(*(const u32x4*)(H + (size_t)(t0 - 2) * N_CI + 2 * CW + c0), b);
#pragma unroll
            for (int i = 0; i < 8; ++i) m2[i] = a[i] * b[i];
            unpack8(*(const u32x4*)(H + (size_t)(t0 - 1) * N_CI + CW + c0), a); unpack8(*(const u32x4*)(H + (size_t)(t0 - 1) * N_CI + 2 * CW + c0), b);
#pragma unroll
            for (int i = 0; i < 8; ++i) m1[i] = a[i] * b[i];
        }
#pragma unroll 4
        for (int r = 0; r < RB; ++r) {
            const bf16_t* hr = H + (size_t)(t0 + r) * N_CI + c0;
            float bg[8], cgt[8], uu[8], o[8];
            unpack8(*(const u32x4*)(hr), bg); unpack8(*(const u32x4*)(hr + CW), cgt); unpack8(*(const u32x4*)(hr + 2 * CW), uu);
#pragma unroll
            for (int i = 0; i < 8; ++i) { const float cu = cgt[i] * uu[i]; o[i] = bg[i] * (w0[i] * m2[i] + w1[i] * m1[i] + w2[i] * cu); m2[i] = m1[i]; m1[i] = cu; }
            *(u32x4*)(A2 + (size_t)(t0 + r) * K_CO + c0) = pack8f(o);
        }
    }
}
__device__ __forceinline__ void ffn_fix_phase(const float* HALOG, const float* FIRSTG, const float* FIRSTU, const float* cw, bf16_t* ACT, int gtid, int nthreads) {
    constexpr int NC4 = DFF / 4, NIT = 31 * NC4;
    asm volatile("" : "+v"(gtid));
    for (int it = gtid; it < NIT; it += nthreads) {
        const int pm = 1 + it / NC4, c = (it % NC4) * 4;
        const f32x4 gm2 = *(const f32x4*)(HALOG + (size_t)((pm - 1) * 2 + 0) * DFF + c), gm1 = *(const f32x4*)(HALOG + (size_t)((pm - 1) * 2 + 1) * DFF + c);
        const f32x4 g0 = *(const f32x4*)(FIRSTG + (size_t)(pm * 2 + 0) * DFF + c), g1 = *(const f32x4*)(FIRSTG + (size_t)(pm * 2 + 1) * DFF + c);
        const f32x4 u0 = *(const f32x4*)(FIRSTU + (size_t)(pm * 2 + 0) * DFF + c), u1 = *(const f32x4*)(FIRSTU + (size_t)(pm * 2 + 1) * DFF + c);
        const f32x4 w0 = *(const f32x4*)(cw + c), w1 = *(const f32x4*)(cw + DFF + c), w2 = *(const f32x4*)(cw + 2 * DFF + c);
        float o0[4], o1[4];
#pragma unroll
        for (int i = 0; i < 4; ++i) { const float a = w0[i] * gm2[i] + w1[i] * gm1[i] + w2[i] * g0[i], b = w0[i] * gm1[i] + w1[i] * g0[i] + w2[i] * g1[i];
            o0[i] = a / (1.0f + __expf(-a)) * u0[i]; o1[i] = b / (1.0f + __expf(-b)) * u1[i]; }
        u32x2 w; w.x = cvt_pk_bf16(o0[0], o0[1]); w.y = cvt_pk_bf16(o0[2], o0[3]); *(u32x2*)(ACT + (size_t)(256 * pm) * DFF + c) = w;
        w.x = cvt_pk_bf16(o1[0], o1[1]); w.y = cvt_pk_bf16(o1[2], o1[3]); *(u32x2*)(ACT + (size_t)(256 * pm + 1) * DFF + c) = w;
    }
}
__device__ __forceinline__ void merge_phase(const bf16_t* OG  , const float* LSE  , bf16_t* A2  , int gtid, int nthreads) {
    constexpr int NIT = SEQ * (GW / 8);
    asm volatile("" : "+v"(gtid));
    for (int it = gtid; it < NIT; it += nthreads) {
        const int ch = it % (GW / 8), t = it / (GW / 8), hd = ch >> 4, d8 = (ch & 15) * 8;
        const int r0 = t, r1 = (t & 3) * (SEQ / 4) + (t >> 2), r2 = (t & 15) * (SEQ / 16) + (t >> 4);
        const float l0 = LSE[(size_t)(0 * 16 + hd) * SEQ + r0], l1 = LSE[(size_t)(1 * 16 + hd) * SEQ + r1], l2 = LSE[(size_t)(2 * 16 + hd) * SEQ + r2];
        const float mx = fmaxf(l0, fmaxf(l1, l2));
        const float e0 = __expf(l0 - mx), e1 = __expf(l1 - mx), e2 = __expf(l2 - mx), inv = 1.0f / (e0 + e1 + e2);
        float a[8], b[8], c[8], o[8];
        unpack8(*(const u32x4*)(OG + ((size_t)(0 * 16 + hd) * SEQ + r0) * HDIM + d8), a); unpack8(*(const u32x4*)(OG + ((size_t)(1 * 16 + hd) * SEQ + r1) * HDIM + d8), b); unpack8(*(const u32x4*)(OG + ((size_t)(2 * 16 + hd) * SEQ + r2) * HDIM + d8), c);
#pragma unroll
        for (int i = 0; i < 8; ++i) o[i] = (e0 * a[i] + e1 * b[i] + e2 * c[i]) * inv;
        *(u32x4*)(A2 + (size_t)t * K_AO + ch * 8) = pack8f(o);
    }
}

template <int HD, int STR>
__device__ __forceinline__ void attn_load_tile(LAS unsigned char* dst, const bf16_t* src, long stride, int valid_from, int tid) {
    constexpr int CPR = HD / 8, PER = 256 * CPR / 512;
    u32x4 v[PER];
#pragma unroll
    for (int j = 0; j < PER; ++j) { const int idx = tid + 512 * j, row = idx / CPR, ch = idx % CPR;
        v[j] = (u32x4){0u, 0u, 0u, 0u}; if (row >= valid_from) v[j] = *(const u32x4*)(src + (long)row * stride + ch * 8); }
#pragma unroll
    for (int j = 0; j < PER; ++j) { const int idx = tid + 512 * j, row = idx / CPR, ch = idx % CPR; *(LAS u32x4*)(dst + row * STR + ch * 16) = v[j]; }
}
template <int HD, int NT, bool DIL>
__device__ __forceinline__ void attn_unit(LAS unsigned char* lds, const bf16_t* Qp, long qstride, const bf16_t* Kp, const bf16_t* Vp, long kvstride, int valid_from,
                                          bf16_t* Op, long ostride, float* lsep, float scale) {
    constexpr int KSTR = HD * 2 + 16, VSTR = HD * 2 + 32, NC = (NT + 1) / 2, NDT = HD / 16, NQC = HD / 32;
    constexpr bool BOTH = (256 * KSTR + 256 * VSTR) <= LDSCTL_OFF;
    const int tid = fresh_tid(), w = __builtin_amdgcn_readfirstlane(tid >> 6), lane = tid & 63, lq = lane & 15, g4 = lane >> 4;
    LAS unsigned char* Kl = lds; LAS unsigned char* Vl = BOTH ? lds + 256 * KSTR : lds;
    __syncthreads();
    attn_load_tile<HD, KSTR>(Kl, Kp, kvstride, valid_from, tid);
    if (BOTH) attn_load_tile<HD, VSTR>(Vl, Vp, kvstride, valid_from, tid);
    bf16x8 qf[NQC];
#pragma unroll
    for (int c = 0; c < NQC; ++c) qf[c] = *(const bf16x8*)(Qp + (long)(16 * w + lq) * qstride + 32 * c + 8 * g4);
    __syncthreads();
    const int jt0 = DIL ? w : 0;
    f32x4 s[NT];
#pragma unroll
    for (int j = 0; j < NT; ++j) { s[j] = (f32x4){0.f, 0.f, 0.f, 0.f}; const LAS unsigned char* kr = Kl + (16 * (jt0 + j) + lq) * KSTR + 16 * g4;
#pragma unroll
        for (int c = 0; c < NQC; ++c) { const bf16x8 kf = *(const LAS bf16x8*)(kr + 64 * c); s[j] = __builtin_amdgcn_mfma_f32_16x16x32_bf16(kf, qf[c], s[j], 0, 0, 0); } }
    if (!BOTH) { __syncthreads(); attn_load_tile<HD, VSTR>(Vl, Vp, kvstride, valid_from, tid); }
    const float NEG = -__builtin_inff();
    float mx = NEG;
    const int qi = 16 * w + lq;
#pragma unroll
    for (int j = 0; j < NT; ++j)
#pragma unroll
        for (int e = 0; e < 4; ++e) { if (DIL) { const int kr = 16 * (jt0 + j) + 4 * g4 + e; const bool ok = (kr >= qi) && (kr <= qi + 128) && (kr >= valid_from); s[j][e] = ok ? s[j][e] : NEG; } mx = fmaxf(mx, s[j][e]); }
    mx = fmaxf(mx, __shfl_xor(mx, 16)); mx = fmaxf(mx, __shfl_xor(mx, 32));
    const float c2 = scale * 1.4426950408889634f, mb = -mx * c2; float sum = 0.f;
#pragma unroll
    for (int j = 0; j < NT; ++j)
#pragma unroll
        for (int e = 0; e < 4; ++e) { const float p = __builtin_amdgcn_exp2f(fmaf(s[j][e], c2, mb)); s[j][e] = p; sum += p; }
    sum += __shfl_xor(sum, 16); sum += __shfl_xor(sum, 32);
    const float inv = 1.0f / sum;
    bf16x8 pf[NC];
#pragma unroll
    for (int cc = 0; cc < NC; ++cc) { u32x4 wv; wv.x = cvt_pk_bf16(s[2 * cc][0], s[2 * cc][1]); wv.y = cvt_pk_bf16(s[2 * cc][2], s[2 * cc][3]);
        if (2 * cc + 1 < NT) { wv.z = cvt_pk_bf16(s[(2 * cc + 1) % NT][0], s[(2 * cc + 1) % NT][1]); wv.w = cvt_pk_bf16(s[(2 * cc + 1) % NT][2], s[(2 * cc + 1) % NT][3]); } else { wv.z = 0u; wv.w = 0u; }
        pf[cc] = __builtin_bit_cast(bf16x8, wv); }
    if (!BOTH) __syncthreads();
    f32x4 o[NDT];
#pragma unroll
    for (int dt = 0; dt < NDT; ++dt) o[dt] = (f32x4){0.f, 0.f, 0.f, 0.f};
    const unsigned vbase = (unsigned)(size_t)Vl + (unsigned)((16 * jt0 + 4 * g4 + (lq >> 2)) * VSTR + (lq & 3) * 8);
#pragma unroll
    for (int cc = 0; cc < NC; ++cc) {
        const unsigned va = vbase + (unsigned)(cc * 32 * VSTR);
        constexpr int T1OFF = 16 * VSTR;
        const bool has1 = (2 * cc + 1 < NT);
#pragma unroll
        for (int d4 = 0; d4 < NDT; d4 += 4) {
            s16x4 a0, a1, a2, a3, b0, b1, b2, b3;
#define TRRD(dst, addr, off) asm volatile("ds_read_b64_tr_b16 %0, %1 offset:%2" : "=&v"(dst) : "v"(addr), "i"(off) : "memory")
            if (has1) {
                TRRD(a0, va, (d4 + 0) * 32); TRRD(b0, va, (d4 + 0) * 32 + T1OFF); TRRD(a1, va, (d4 + 1) * 32); TRRD(b1, va, (d4 + 1) * 32 + T1OFF);
                TRRD(a2, va, (d4 + 2) * 32); TRRD(b2, va, (d4 + 2) * 32 + T1OFF); TRRD(a3, va, (d4 + 3) * 32); TRRD(b3, va, (d4 + 3) * 32 + T1OFF);
            } else {
                TRRD(a0, va, (d4 + 0) * 32); TRRD(b0, va, (d4 + 0) * 32); TRRD(a1, va, (d4 + 1) * 32); TRRD(b1, va, (d4 + 1) * 32);
                TRRD(a2, va, (d4 + 2) * 32); TRRD(b2, va, (d4 + 2) * 32); TRRD(a3, va, (d4 + 3) * 32); TRRD(b3, va, (d4 + 3) * 32);
            }
#undef TRRD
            asm volatile("s_waitcnt lgkmcnt(0)" ::: "memory"); __builtin_amdgcn_sched_barrier(0);
            o[d4 + 0] = __builtin_amdgcn_mfma_f32_16x16x32_bf16((bf16x8){a0[0], a0[1], a0[2], a0[3], b0[0], b0[1], b0[2], b0[3]}, pf[cc], o[d4 + 0], 0, 0, 0);
            o[d4 + 1] = __builtin_amdgcn_mfma_f32_16x16x32_bf16((bf16x8){a1[0], a1[1], a1[2], a1[3], b1[0], b1[1], b1[2], b1[3]}, pf[cc], o[d4 + 1], 0, 0, 0);
            o[d4 + 2] = __builtin_amdgcn_mfma_f32_16x16x32_bf16((bf16x8){a2[0], a2[1], a2[2], a2[3], b2[0], b2[1], b2[2], b2[3]}, pf[cc], o[d4 + 2], 0, 0, 0);
            o[d4 + 3] = __builtin_amdgcn_mfma_f32_16x16x32_bf16((bf16x8){a3[0], a3[1], a3[2], a3[3], b3[0], b3[1], b3[2], b3[3]}, pf[cc], o[d4 + 3], 0, 0, 0);
        }
    }
    bf16_t* orow = Op + (long)qi * ostride + 4 * g4;
#pragma unroll
    for (int dt = 0; dt < NDT; ++dt) { u32x2 wv; wv.x = cvt_pk_bf16(o[dt][0] * inv, o[dt][1] * inv); wv.y = cvt_pk_bf16(o[dt][2] * inv, o[dt][3] * inv); *(u32x2*)(orow + 16 * dt) = wv; }
    if (lsep && g4 == 0) lsep[qi] = mx * scale + __logf(sum);
}


struct DilUnit { const bf16_t* qs; const bf16_t* ks; const bf16_t* vs; bf16_t* os; float* lse; int valid_from; };
__device__ __forceinline__ DilUnit dil_unit(int u, const bf16_t* QKVL, bf16_t* OG, float* LSE) {
    const int grp = u >> 10, rem = u & 1023, hd = rem >> 6, blk = rem & 63;
    const int dsh = 2 * grp, nbr = 64 >> dsh, r = blk / nbr, nb = blk % nbr;
    const size_t rowq = (size_t)r * (SEQ >> dsh) + 128 * nb;
    DilUnit d;
    d.qs = QKVL + ((size_t)((grp * 3 + 0) * NHEAD + hd) * SEQ + rowq) * HDIM;
    d.ks = QKVL + ((size_t)((grp * 3 + 1) * NHEAD + hd) * SEQ + rowq) * HDIM - 128 * HDIM;
    d.vs = QKVL + ((size_t)((grp * 3 + 2) * NHEAD + hd) * SEQ + rowq) * HDIM - 128 * HDIM;
    d.os = OG + ((size_t)(grp * NHEAD + hd) * SEQ + rowq) * HDIM; d.lse = LSE + (size_t)(grp * NHEAD + hd) * SEQ + rowq; d.valid_from = (nb == 0) ? 128 : 0;
    return d;
}
__device__ __forceinline__ void attn_dil_phase(LAS unsigned char* lds, const bf16_t* QKVL, bf16_t* OG, float* LSE, int u0, int nu, float scale) {
    constexpr int NT = 9, NC = 5, NDT = 8;
    const int tid = fresh_tid(), w = __builtin_amdgcn_readfirstlane(tid >> 6), lane = tid & 63, lq = lane & 15, g4 = lane >> 4;
    LAS unsigned char* Kl = lds; LAS unsigned char* Vl = lds + 65536;
    if (nu <= 0) return;
    __syncthreads();
    DilUnit U = dil_unit(u0, QKVL, OG, LSE);
    bf16x8 qf[4];
#define DIL_LOAD_K(UU) do { _Pragma("unroll") for (int i = 0; i < 8; ++i) { const int row = 32 * w + 4 * i + g4; \
        __builtin_amdgcn_global_load_lds((const unsigned*)((UU).ks + (size_t)row * HDIM + ((lq ^ (row & 15)) << 3)), (LAS unsigned*)(Kl + (w * 8 + i) * 1024), 16, 0, 0); } \
        _Pragma("unroll") for (int c = 0; c < 4; ++c) qf[c] = *(const bf16x8*)((UU).qs + (size_t)(16 * w + lq) * HDIM + 32 * c + 8 * g4); } while (0)
#define DIL_LOAD_V(UU) do { _Pragma("unroll") for (int i = 0; i < 8; ++i) { const int row = 32 * w + 4 * i + g4; \
        __builtin_amdgcn_global_load_lds((const unsigned*)((UU).vs + (size_t)row * HDIM + ((lq ^ ((row & 7) << 1)) << 3)), (LAS unsigned*)(Vl + (w * 8 + i) * 1024), 16, 0, 0); } } while (0)
    DIL_LOAD_K(U);
    unsigned ko[4];
#pragma unroll
    for (int c = 0; c < 4; ++c) ko[c] = (unsigned)(((4 * c + g4) ^ lq) << 4);
    const LAS unsigned char* kb = Kl + (16 * w + lq) * 256;
    const int qi = 16 * w + lq;
    const int q4 = lq >> 2, p4 = lq & 3, kx = ((4 * g4 + q4) & 7) << 5;
    const unsigned vb = (unsigned)(size_t)Vl + (unsigned)((16 * w + 4 * g4 + q4) * 256 + ((p4 >> 1) << 4) + ((p4 & 1) << 3));
    unsigned va[NDT];
#pragma unroll
    for (int dt = 0; dt < NDT; ++dt) va[dt] = vb + (unsigned)((dt << 5) ^ kx);
    const float c2 = scale * 1.4426950408889634f;
    for (int k = 0; k < nu; ++k) {
        asm volatile("s_waitcnt vmcnt(0)" ::: "memory");
        __syncthreads();
        DIL_LOAD_V(U);
        f32x4 s[NT];
#pragma unroll
        for (int j = 0; j < NT; ++j) { s[j] = (f32x4){0.f, 0.f, 0.f, 0.f};
#pragma unroll
            for (int c = 0; c < 4; ++c) { const bf16x8 kf = *(const LAS bf16x8*)(kb + j * 4096 + ko[c]); s[j] = __builtin_amdgcn_mfma_f32_16x16x32_bf16(kf, qf[c], s[j], 0, 0, 0); } }
        const float NEG = -__builtin_inff();
        float mx = NEG;
#pragma unroll
        for (int j = 0; j < NT; ++j)
#pragma unroll
            for (int e = 0; e < 4; ++e) { const int kr = 16 * (w + j) + 4 * g4 + e; const bool ok = (kr >= qi) && (kr <= qi + 128) && (kr >= U.valid_from); s[j][e] = ok ? s[j][e] : NEG; mx = fmaxf(mx, s[j][e]); }
        mx = fmaxf(mx, __shfl_xor(mx, 16)); mx = fmaxf(mx, __shfl_xor(mx, 32));
        const float mb = -mx * c2; float sum = 0.f;
#pragma unroll
        for (int j = 0; j < NT; ++j)
#pragma unroll
            for (int e = 0; e < 4; ++e) { const float p = __builtin_amdgcn_exp2f(fmaf(s[j][e], c2, mb)); s[j][e] = p; sum += p; }
        sum += __shfl_xor(sum, 16); sum += __shfl_xor(sum, 32);
        const float inv = __builtin_amdgcn_rcpf(sum);
        bf16x8 pf[NC];
#pragma unroll
        for (int cc = 0; cc < NC; ++cc) { u32x4 wv; wv.x = cvt_pk_bf16(s[2 * cc][0], s[2 * cc][1]); wv.y = cvt_pk_bf16(s[2 * cc][2], s[2 * cc][3]);
            if (2 * cc + 1 < NT) { wv.z = cvt_pk_bf16(s[(2 * cc + 1) % NT][0], s[(2 * cc + 1) % NT][1]); wv.w = cvt_pk_bf16(s[(2 * cc + 1) % NT][2], s[(2 * cc + 1) % NT][3]); } else { wv.z = 0u; wv.w = 0u; }
            pf[cc] = __builtin_bit_cast(bf16x8, wv); }
        asm volatile("s_waitcnt vmcnt(0)" ::: "memory");
        __syncthreads();
        bf16_t* const os = U.os; float* const lsep = U.lse;
        if (k + 1 < nu) { U = dil_unit(u0 + k + 1, QKVL, OG, LSE); DIL_LOAD_K(U); }
        f32x4 o[NDT];
#pragma unroll
        for (int dt = 0; dt < NDT; ++dt) o[dt] = (f32x4){0.f, 0.f, 0.f, 0.f};
#define TRRD(dst, addr, off) asm volatile("ds_read_b64_tr_b16 %0, %1 offset:%2" : "=&v"(dst) : "v"(addr), "i"(off) : "memory")
#define DIL_PV(CC, OA, OB) do { _Pragma("unroll") for (int d4 = 0; d4 < NDT; d4 += 4) { s16x4 a0, a1, a2, a3, b0, b1, b2, b3; \
            TRRD(a0, va[d4 + 0], OA); TRRD(b0, va[d4 + 0], OB); TRRD(a1, va[d4 + 1], OA); TRRD(b1, va[d4 + 1], OB); TRRD(a2, va[d4 + 2], OA); TRRD(b2, va[d4 + 2], OB); TRRD(a3, va[d4 + 3], OA); TRRD(b3, va[d4 + 3], OB); \
            asm volatile("s_waitcnt lgkmcnt(0)" ::: "memory"); __builtin_amdgcn_sched_barrier(0); \
            o[d4 + 0] = __builtin_amdgcn_mfma_f32_16x16x32_bf16((bf16x8){a0[0], a0[1], a0[2], a0[3], b0[0], b0[1], b0[2], b0[3]}, pf[CC], o[d4 + 0], 0, 0, 0); \
            o[d4 + 1] = __builtin_amdgcn_mfma_f32_16x16x32_bf16((bf16x8){a1[0], a1[1], a1[2], a1[3], b1[0], b1[1], b1[2], b1[3]}, pf[CC], o[d4 + 1], 0, 0, 0); \
            o[d4 + 2] = __builtin_amdgcn_mfma_f32_16x16x32_bf16((bf16x8){a2[0], a2[1], a2[2], a2[3], b2[0], b2[1], b2[2], b2[3]}, pf[CC], o[d4 + 2], 0, 0, 0); \
            o[d4 + 3] = __builtin_amdgcn_mfma_f32_16x16x32_bf16((bf16x8){a3[0], a3[1], a3[2], a3[3], b3[0], b3[1], b3[2], b3[3]}, pf[CC], o[d4 + 3], 0, 0, 0); } } while (0)
        DIL_PV(0, 0 * 8192, 0 * 8192 + 4096); DIL_PV(1, 1 * 8192, 1 * 8192 + 4096); DIL_PV(2, 2 * 8192, 2 * 8192 + 4096); DIL_PV(3, 3 * 8192, 3 * 8192 + 4096); DIL_PV(4, 4 * 8192, 4 * 8192);
#undef DIL_PV
#undef TRRD
        bf16_t* orow = os + (size_t)qi * HDIM + 4 * g4;
#pragma unroll
        for (int dt = 0; dt < NDT; ++dt) { u32x2 wv; wv.x = cvt_pk_bf16(o[dt][0] * inv, o[dt][1] * inv); wv.y = cvt_pk_bf16(o[dt][2] * inv, o[dt][3] * inv); *(u32x2*)(orow + 16 * dt) = wv; }
        if (g4 == 0) lsep[qi] = mx * scale + __logf(sum);
    }
#undef DIL_LOAD_K
#undef DIL_LOAD_V
}

struct Args {
    const float* x; const float* mem; const int* pos; const float* g_mem; const float* w_mem_kv; const float* g_mix_pre; const float* g_mix_post; const float* g_ffn_pre; const float* g_ffn_post;
    const float* w_conv_in; const float* conv_mix_w; const float* w_conv_out; const float* w_attn_in; const float* w_attn_out; const float* w_ffn_gate; const float* w_ffn_up; const float* conv_ffn_w; const float* w_ffn_down;
    float* out; unsigned char* ws; int ph_lo, ph_hi;
};

__global__ void __launch_bounds__(512, 2) fwd_kernel(Args a) {
    extern __shared__ __attribute__((aligned(16))) unsigned char lds_raw[];
    LAS unsigned char* lds = (LAS unsigned char*)lds_raw;
    volatile LAS unsigned* MISC = (volatile LAS unsigned*)(lds + LDSCTL_OFF);
    const int tid = threadIdx.x, lane = tid & 63, wave = __builtin_amdgcn_readfirstlane(tid >> 6);
    const int G = gridDim.x, bx = blockIdx.x;
    const int gtid = bx * 512 + tid, nthreads = G * 512, gw = bx * 8 + wave, ngw = G * 8;
    unsigned char* ws = a.ws;
    unsigned* ctl = (unsigned*)(ws + WS_CTL);
    bf16_t* WKV = (bf16_t*)(ws + WS_WKV); bf16_t* WCI = (bf16_t*)(ws + WS_WCI); bf16_t* WCO = (bf16_t*)(ws + WS_WCO); bf16_t* WAI = (bf16_t*)(ws + WS_WAI); bf16_t* WAO = (bf16_t*)(ws + WS_WAO);
    bf16_t* WGU = (bf16_t*)(ws + WS_WGU); bf16_t* WD = (bf16_t*)(ws + WS_WD);
    bf16_t* XN = (bf16_t*)(ws + WS_XN); bf16_t* H = (bf16_t*)(ws + WS_R); bf16_t* GU = (bf16_t*)(ws + WS_R); bf16_t* Y = (bf16_t*)(ws + WS_R);
    bf16_t* QKVL = (bf16_t*)(ws + WS_R); bf16_t* QM = (bf16_t*)(ws + WS_R + 288 * MiB);
    bf16_t* ACT = (bf16_t*)(ws + WS_S); bf16_t* A2 = (bf16_t*)(ws + WS_S); bf16_t* OG = (bf16_t*)(ws + WS_S + 64 * MiB);
    bf16_t* MEMN = (bf16_t*)(ws + WS_MEMN); bf16_t* KV = (bf16_t*)(ws + WS_KV); float* COS = (float*)(ws + WS_COS); float* SIN = (float*)(ws + WS_SIN); float* LSE = (float*)(ws + WS_LSE);
    bf16_t* XRES = (bf16_t*)(ws + WS_XRES);
    float* HALOG = (float*)(ws + WS_HALOG); float* FIRSTG = (float*)(ws + WS_FIRSTG); float* FIRSTU = (float*)(ws + WS_FIRSTU);

    for (int u = tid; u < (LDS_BYTES - LDSCTL_OFF) / 4; u += 512) ((LAS unsigned*)(lds + LDSCTL_OFF))[u] = 0u;
    __syncthreads();
    XcdBarrier bar; bar.bar = ctl + CW_BAR; bar.x = 0; bar.st = nullptr;
    if (ONE_LAUNCH) bar = xcd_barrier_post(ctl + CW_BAR, MISC + 8);
    const int lo = a.ph_lo, hi = a.ph_hi;
#define IN(k) (lo <= (k) && (k) < hi)
#define SEAM(k) do { if (IN(k) && IN((k) + 1)) xcd_barrier(bar); } while (0)
    constexpr size_t SZ_GU = (size_t)N_GU * DM, SZ_D = (size_t)DM * DFF;

    if (IN(0)) {
        LAS float* scr = (LAS float*)(lds + wave * 16384);
        cvt_matrix<0>(a.w_mem_kv, DM, 2 * MW, WKV, 0, scr, gw, ngw, lane);
        for (int m = gw; m < NMEM; m += ngw) rms_row_to_bf16(a.mem + (size_t)m * DM, a.g_mem, MEMN + (size_t)m * DM, lane);
        for (int m = gw; m < SEQ; m += ngw) rms_row_to_bf16(a.x + (size_t)m * DM, a.g_mix_pre, XN + (size_t)m * DM, lane);
        for (int idx = gtid; idx < SEQ * 64; idx += nthreads) { const int t = idx >> 6, i = idx & 63;
            const float ang = (float)a.pos[t] * INV_FREQ[i];
            const double kq = rint((double)ang * 0.15915494309189535); double r = fma(-kq, 6.283185307179586, (double)ang); r = fma(-kq, 2.4492935982947064e-16, r);
            const float rf = (float)r; COS[idx] = cosf(rf); SIN[idx] = sinf(rf); }
    }
    SEAM(0);
    if (IN(1)) {
        if (bx < 8) {
            pg8::Gemm g{MEMN, WKV, DM, DM, DM}; pg8::StaticOrder S; S.init(NMEM, 2 * MW, 8, bx);
            pg8::EpiStore E{KV, 2 * MW};
            pg8::gemm_phase<pg8::EpiStore, pg8::StaticOrder, true>(lds, g, S, E);
        } else {
            LAS float* scr = (LAS float*)(lds + wave * 16384);
            const int cw_ = (bx - 8) * 8 + wave, ncw = (G - 8) * 8;
            cvt_matrix<0>(a.w_conv_in, DM, N_CI, WCI, 0, scr, cw_, ncw, lane);
            cvt_matrix<0>(a.w_conv_out, K_CO, DM, WCO, 0, scr, cw_, ncw, lane);
            cvt_matrix<2>(a.w_ffn_gate, DM, DFF, WGU, 0, scr, cw_, ncw, lane);
            cvt_matrix<3>(a.w_ffn_up, DM, DFF, WGU, 0, scr, cw_, ncw, lane);
            cvt_matrix<0>(a.w_ffn_down, DFF, DM, WD, 0, scr, cw_, ncw, lane);
            cvt_matrix<1>(a.w_attn_in, DM, N_AI, WAI, 0, scr, cw_, ncw, lane);
            cvt_matrix<0>(a.w_attn_out, K_AO, DM, WAO, 0, scr, cw_, ncw, lane);
            cvt_matrix<2>(a.w_ffn_gate + SZ_D, DM, DFF, WGU + SZ_GU, 0, scr, cw_, ncw, lane, D10_GATE1, 64);
            cvt_matrix<3>(a.w_ffn_up + SZ_D, DM, DFF, WGU + SZ_GU, 0, scr, cw_, ncw, lane, D10_UP1_HI, 64);
            cvt_matrix<0>(a.w_ffn_down + SZ_D, DFF, DM, WD + SZ_D, 0, scr, cw_, ncw, lane, D15_WD1_HI, 172);
        }
    }
    SEAM(1);
    if (IN(2)) {
        pg8::Gemm g{XN, WCI, DM, DM, DM}; pg8::StaticOrder S; S.init(SEQ, N_CI, G, bx);
        pg8::EpiStore E{H, N_CI};
        pg8::gemm_phase<pg8::EpiStore, pg8::StaticOrder, true>(lds, g, S, E);
    }
    SEAM(2);
    if (IN(3)) {
        for (int u = bx; u < 4 * (SEQ / 128); u += G) { const int hd = u / (SEQ / 128), qb = u % (SEQ / 128);
            attn_unit<256, 16, false>(lds, H + (size_t)(128 * qb) * N_CI + 3 * CW + 256 * hd, N_CI, KV + 256 * hd, KV + MW + 256 * hd, 2 * MW, 0,
                                      A2 + (size_t)(128 * qb) * K_CO + CW + 256 * hd, K_CO, nullptr, 0.0625f); }
        conv_gate_phase(H, a.conv_mix_w, A2, gtid, nthreads);
    }
    SEAM(3);
    if (IN(4)) {
        pg8::Gemm g{A2, WCO, K_CO, K_CO, K_CO}; pg8::StaticOrder S; S.init(SEQ, DM, G, bx);
        pg8::EpiStore E{Y, DM};
        pg8::gemm_phase<pg8::EpiStore, pg8::StaticOrder, true>(lds, g, S, E);
    }
    SEAM(4);
    if (IN(5)) { for (int m = gw; m < SEQ; m += ngw) norm_res_row<true, false, true>(a.x + (size_t)m * DM, Y + (size_t)m * DM, a.g_mix_post, a.g_ffn_pre, XRES + (size_t)m * DM, XN + (size_t)m * DM); }
    SEAM(5);
    if (IN(6)) {
        pg8::Gemm g{XN, WGU, DM, DM, DM}; pg8::StaticOrder S; S.init(SEQ, N_GU, G, bx);
        pg8::EpiFfn E{ACT, a.conv_ffn_w, HALOG, FIRSTG, FIRSTU, lds + RING_BYTES};
        pg8::gemm_phase<pg8::EpiFfn, pg8::StaticOrder, true>(lds, g, S, E);
        if (DEFER && bx >= 192) cvt_matrix2<0>(a.w_ffn_down + SZ_D, DFF, DM, WD + SZ_D, lds + wave * 9216, (bx - 192) * 8 + wave, (G - 192) * 8, 0, D6_WD1_HI);
    }
    SEAM(6);
    if (IN(7)) ffn_fix_phase(HALOG, FIRSTG, FIRSTU, a.conv_ffn_w, ACT, gtid, nthreads);
    SEAM(7);
    if (IN(8)) {
        pg8::Gemm g{ACT, WD, DFF, DFF, DFF}; pg8::StaticOrder S; S.init(SEQ, DM, G, bx);
        pg8::EpiStore E{Y, DM};
        pg8::gemm_phase<pg8::EpiStore, pg8::StaticOrder, true>(lds, g, S, E);
    }
    SEAM(8);
    if (IN(9)) { for (int m = gw; m < SEQ; m += ngw) norm_res_row<false, false, true>(XRES + (size_t)m * DM, Y + (size_t)m * DM, a.g_ffn_post, a.g_mix_pre + DM, XRES + (size_t)m * DM, XN + (size_t)m * DM); }
    SEAM(9);
    if (IN(10)) {
        pg8::Gemm g{XN, WAI, DM, DM, DM}; pg8::StaticOrder S; S.init(SEQ, N_AI, G, bx);
        pg8::EpiQKV E{QKVL, QM, COS, SIN};
        pg8::gemm_phase<pg8::EpiQKV, pg8::StaticOrder, true>(lds, g, S, E);
        if (DEFER && bx >= 128) { cvt_matrix2<2>(a.w_ffn_gate + SZ_D, DM, DFF, WGU + SZ_GU, lds + wave * 9216, (bx - 128) * 8 + wave, (G - 128) * 8, 0, D10_GATE1);
                                  cvt_matrix2<3>(a.w_ffn_up + SZ_D, DM, DFF, WGU + SZ_GU, lds + wave * 9216, (bx - 128) * 8 + wave, (G - 128) * 8, 0, D10_UP1_HI); }
    }
    SEAM(10);
    if (IN(11)) {
        { const int per = (3 * 16 * 64 + G - 1) / G, u0 = bx * per; int nu = 3 * 16 * 64 - u0; nu = nu > per ? per : nu;
          attn_dil_phase(lds, QKVL, OG, LSE, u0, nu, 0.08838834764831845f); }
        for (int u = bx; u < 4 * (SEQ / 128); u += G) { const int hd = u / (SEQ / 128), qb = u % (SEQ / 128);
            attn_unit<256, 16, false>(lds, QM + (size_t)(128 * qb) * MW + 256 * hd, MW, KV + 256 * hd, KV + MW + 256 * hd, 2 * MW, 0,
                                      A2 + (size_t)(128 * qb) * K_AO + GW + 256 * hd, K_AO, nullptr, 0.0625f); }
    }
    SEAM(11);
    if (IN(12)) merge_phase(OG, LSE, A2, gtid, nthreads);
    SEAM(12);
    if (IN(13)) {
        pg8::Gemm g{A2, WAO, K_AO, K_AO, K_AO}; pg8::StaticOrder S; S.init(SEQ, DM, G, bx);
        pg8::EpiStore E{Y, DM};
        pg8::gemm_phase<pg8::EpiStore, pg8::StaticOrder, true>(lds, g, S, E);
    }
    SEAM(13);
    if (IN(14)) { for (int m = gw; m < SEQ; m += ngw) norm_res_row<false, false, true>(XRES + (size_t)m * DM, Y + (size_t)m * DM, a.g_mix_post + DM, a.g_ffn_pre + DM, XRES + (size_t)m * DM, XN + (size_t)m * DM); }
    SEAM(14);
    if (IN(15)) {
        pg8::Gemm g{XN, WGU + SZ_GU, DM, DM, DM}; pg8::StaticOrder S; S.init(SEQ, N_GU, G, bx);
        pg8::EpiFfn E{ACT, a.conv_ffn_w + 3 * DFF, HALOG, FIRSTG, FIRSTU, lds + RING_BYTES};
        pg8::gemm_phase<pg8::EpiFfn, pg8::StaticOrder, true>(lds, g, S, E);
        if (DEFER && bx >= 192) cvt_matrix2<0>(a.w_ffn_down + SZ_D, DFF, DM, WD + SZ_D, lds + wave * 9216, (bx - 192) * 8 + wave, (G - 192) * 8, D6_WD1_HI, D15_WD1_HI);
    }
    SEAM(15);
    if (IN(16)) ffn_fix_phase(HALOG, FIRSTG, FIRSTU, a.conv_ffn_w + 3 * DFF, ACT, gtid, nthreads);
    SEAM(16);
    if (IN(17)) {
        pg8::Gemm g{ACT, WD + SZ_D, DFF, DFF, DFF}; pg8::StaticOrder S; S.init(SEQ, DM, G, bx);
        pg8::EpiStore E{Y, DM};
        pg8::gemm_phase<pg8::EpiStore, pg8::StaticOrder, true>(lds, g, S, E);
    }
    SEAM(17);
    if (IN(18)) { for (int m = gw; m < SEQ; m += ngw) norm_res_row<false, true, false>(XRES + (size_t)m * DM, Y + (size_t)m * DM, a.g_ffn_post + DM, nullptr, a.out + (size_t)m * DM, nullptr); }

#ifdef PROBE
    xcd_barrier(bar);
#if PROBE == 1
    { LAS float* scr = (LAS float*)(lds + wave * 16384);
      if (bx >= 8) { const int cw_ = (bx - 8) * 8 + wave, ncw = (G - 8) * 8;
            cvt_matrix<0>(a.w_conv_in, DM, N_CI, WCI, 0, scr, cw_, ncw, lane);
            cvt_matrix<0>(a.w_conv_out, K_CO, DM, WCO, 0, scr, cw_, ncw, lane);
            cvt_matrix<2>(a.w_ffn_gate, DM, DFF, WGU, 0, scr, cw_, ncw, lane);
            cvt_matrix<3>(a.w_ffn_up, DM, DFF, WGU, 0, scr, cw_, ncw, lane);
            cvt_matrix<0>(a.w_ffn_down, DFF, DM, WD, 0, scr, cw_, ncw, lane);
            cvt_matrix<1>(a.w_attn_in, DM, N_AI, WAI, 0, scr, cw_, ncw, lane);
            cvt_matrix<0>(a.w_attn_out, K_AO, DM, WAO, 0, scr, cw_, ncw, lane);
            cvt_matrix<2>(a.w_ffn_gate + SZ_D, DM, DFF, WGU + SZ_GU, 0, scr, cw_, ncw, lane);
            cvt_matrix<3>(a.w_ffn_up + SZ_D, DM, DFF, WGU + SZ_GU, 0, scr, cw_, ncw, lane);
            cvt_matrix<0>(a.w_ffn_down + SZ_D, DFF, DM, WD + SZ_D, 0, scr, cw_, ncw, lane); } }
#elif PROBE == 8
    { pg8::Gemm g{ACT, WD, DFF, DFF, DFF}; pg8::StaticOrder S; S.init(SEQ, DM, G, bx);
      pg8::EpiStore E{Y, DM};
      pg8::gemm_phase<pg8::EpiStore, pg8::StaticOrder, true>(lds, g, S, E); }
#elif PROBE == 4
    { pg8::Gemm g{A2, WCO, K_CO, K_CO, K_CO}; pg8::StaticOrder S; S.init(SEQ, DM, G, bx);
      pg8::EpiStore E{Y, DM};
      pg8::gemm_phase<pg8::EpiStore, pg8::StaticOrder, true>(lds, g, S, E); }
#elif PROBE == 40
    { pg8::Gemm g{A2, WCO, K_CO, K_CO, K_CO}; pg8::SameTileOrder S; S.n = 2;
      pg8::EpiStore E{Y, DM};
      pg8::gemm_phase<pg8::EpiStore, pg8::SameTileOrder, true>(lds, g, S, E); }
#elif PROBE == 6
    { pg8::Gemm g{XN, WGU, DM, DM, DM}; pg8::StaticOrder S; S.init(SEQ, N_GU, G, bx);
      pg8::EpiFfn E{ACT, a.conv_ffn_w, HALOG, FIRSTG, FIRSTU, lds + RING_BYTES};
      pg8::gemm_phase<pg8::EpiFfn, pg8::StaticOrder, true>(lds, g, S, E); }
#elif PROBE == 5
    { float* scratch_x = (float*)(ws + WS_S);
      for (int m = gw; m < SEQ; m += ngw) norm_res_row<true, true, true>(a.x + (size_t)m * DM, Y + (size_t)m * DM, a.g_mix_post, a.g_ffn_pre, scratch_x + (size_t)m * DM, XN + (size_t)m * DM); }
#elif PROBE == 3
    { for (int u = bx; u < 4 * (SEQ / 128); u += G) { const int hd = u / (SEQ / 128), qb = u % (SEQ / 128);
            attn_unit<256, 16, false>(lds, H + (size_t)(128 * qb) * N_CI + 3 * CW + 256 * hd, N_CI, KV + 256 * hd, KV + MW + 256 * hd, 2 * MW, 0,
                                      A2 + (size_t)(128 * qb) * K_CO + CW + 256 * hd, K_CO, nullptr, 0.0625f); }
        conv_gate_phase(H, a.conv_mix_w, A2, gtid, nthreads); }
#endif
#endif
#undef IN
#undef SEAM
}

extern "C" void kernel_launch(void* const* d_in, const int* in_sizes, int n_in, void* d_out, int out_size, void* d_ws, size_t ws_size, hipStream_t stream) {
    static int grid = 0;
    if (grid == 0) {
        if (n_in != 18 || in_sizes[0] != SEQ * DM || out_size != SEQ * DM || ws_size < WS_END) { fprintf(stderr, "kernel_launch: unexpected shapes (n_in %d, in0 %d, out %d, ws %zu < %zu?)\n", n_in, n_in > 0 ? in_sizes[0] : -1, out_size, ws_size, (size_t)WS_END); grid = -1; return; }
        int dev = 0, cus = 0;
        if (hipGetDevice(&dev) != hipSuccess || hipDeviceGetAttribute(&cus, hipDeviceAttributeMultiprocessorCount, dev) != hipSuccess) { grid = -1; return; }
        if (hipFuncSetAttribute((const void*)fwd_kernel, hipFuncAttributeMaxDynamicSharedMemorySize, LDS_BYTES) != hipSuccess) { fprintf(stderr, "kernel_launch: hipFuncSetAttribute failed\n"); grid = -1; return; }
        int per_cu = 0;
        if (hipOccupancyMaxActiveBlocksPerMultiprocessor(&per_cu, (const void*)fwd_kernel, 512, LDS_BYTES) != hipSuccess || per_cu < 1) fprintf(stderr, "kernel_launch: occupancy query says %d\n", per_cu);
        (void)hipGetLastError();
        grid = cus;
        if (grid < 16) { fprintf(stderr, "kernel_launch: needs >= 16 CUs\n"); grid = -1; return; }
    }
    if (grid < 0) return;
    (void)hipMemsetAsync((char*)d_ws + WS_CTL, 0, CTL_ZERO_BYTES, stream);
    Args a{};
    a.x = (const float*)d_in[0]; a.mem = (const float*)d_in[1]; a.pos = (const int*)d_in[2]; a.g_mem = (const float*)d_in[3]; a.w_mem_kv = (const float*)d_in[4];
    a.g_mix_pre = (const float*)d_in[5]; a.g_mix_post = (const float*)d_in[6]; a.g_ffn_pre = (const float*)d_in[7]; a.g_ffn_post = (const float*)d_in[8];
    a.w_conv_in = (const float*)d_in[9]; a.conv_mix_w = (const float*)d_in[10]; a.w_conv_out = (const float*)d_in[11]; a.w_attn_in = (const float*)d_in[12]; a.w_attn_out = (const float*)d_in[13];
    a.w_ffn_gate = (const float*)d_in[14]; a.w_ffn_up = (const float*)d_in[15]; a.conv_ffn_w = (const float*)d_in[16]; a.w_ffn_down = (const float*)d_in[17];
    a.out = (float*)d_out; a.ws = (unsigned char*)d_ws;
#if ONE_LAUNCH
    a.ph_lo = 0; a.ph_hi = NPHASE;
    hipLaunchKernelGGL(fwd_kernel, dim3(grid), dim3(512), LDS_BYTES, stream, a);
#else
    for (int p = 0; p < NPHASE; ++p) { a.ph_lo = p; a.ph_hi = p + 1; hipLaunchKernelGGL(fwd_kernel, dim3(grid), dim3(512), LDS_BYTES, stream, a); }
#endif
}
```
